# Optimizing an MI355X kernel written in HIP

```python
import math
import jax, jax.numpy as jnp
from jax import lax
import numpy as np

D_MODEL = 1024
BATCH = 16
SEQ = 2048
DEPTH = 2

HEAD_DIM = 64
NORM_EPS = 1e-6
A_HEADS = 8
A_WIDTH = A_HEADS * HEAD_DIM
LORA_W = 64
LORA_A = 64
LNX_EPS = 64e-5
B_GROUPS = 8
B_GROUP_DIM = 64
B_WIDTH = B_GROUPS * B_GROUP_DIM
CHUNK = 128
GMLP_LN_EPS = 1e-5
EVEN_MIX = A_WIDTH + B_WIDTH
SHIFT_W = 3 * A_WIDTH + LORA_W + LORA_A
EVEN_IN = SHIFT_W + 2 * B_WIDTH + EVEN_MIX
C_HEADS = 16
C_KV_HEADS = 2
C_GROUP = C_HEADS // C_KV_HEADS
WINDOW = 128
ODD_MIX = C_HEADS * HEAD_DIM
KV_W = C_KV_HEADS * HEAD_DIM
ODD_IN = ODD_MIX + 2 * KV_W + ODD_MIX
N_EVEN = (DEPTH + 1) // 2
N_ODD = DEPTH // 2

kernel_name = "hybrid_rwkv7_gmlp_swa_adaln"


def rmsnorm(x, g, eps=NORM_EPS):
    xf = x.astype(jnp.float32)
    r = lax.rsqrt(jnp.mean(xf * xf, axis=-1, keepdims=True) + eps)
    return (xf * r).astype(x.dtype) * g


def layernorm(x, g, b, eps):
    xf = x.astype(jnp.float32)
    mu = jnp.mean(xf, axis=-1, keepdims=True)
    var = jnp.mean(jnp.square(xf - mu), axis=-1, keepdims=True)
    return ((xf - mu) * lax.rsqrt(var + eps)).astype(x.dtype) * g + b


def token_shift(p):
    return jnp.pad(p, ((0, 0), (1, 0), (0, 0)))[:, :-1]


def alibi_slopes(n_heads):
    return jnp.asarray(2.0 ** (-8.0 * np.arange(1, n_heads + 1, dtype=np.float32) / n_heads), jnp.float32)


def rwkv7_time_mix(p, mu, w0, w_up, a0, a_up, k_k, k_a, r_k, lnx_g, lnx_b):
    bsz, t_len, _ = p.shape
    p = p + mu * (token_shift(p) - p)
    r, k, v, w_lo, a_lo = jnp.split(
        p, [A_WIDTH, 2 * A_WIDTH, 3 * A_WIDTH, 3 * A_WIDTH + LORA_W], axis=-1)
    w = -jax.nn.softplus(-(w0 + jnp.tanh(w_lo) @ w_up)) - 0.5
    decay = jnp.exp(-jnp.exp(w.astype(jnp.float32))).astype(p.dtype)
    a = jax.nn.sigmoid(a0 + a_lo @ a_up)

    def heads(t):
        return t.reshape(bsz, t_len, A_HEADS, HEAD_DIM)

    kk = heads(k * k_k).astype(jnp.float32)
    kk = (kk / jnp.maximum(jnp.sqrt(jnp.sum(kk * kk, axis=-1, keepdims=True)), 1e-12)).astype(p.dtype)
    k = k * (1 + (a - 1) * k_a)
    r, k, v, decay, a = heads(r), heads(k), heads(v), heads(decay), heads(a)

    def step(S, inp):
        r_t, w_t, k_t, v_t, kk_t, a_t = inp
        sa = jnp.einsum('bhvk,bhk->bhv', S, -kk_t)
        S = (S * w_t[:, :, None, :]
             + sa[..., None] * (kk_t * a_t)[:, :, None, :]
             + v_t[..., None] * k_t[:, :, None, :])
        y_t = jnp.einsum('bhvk,bhk->bhv', S, r_t)
        return S, y_t

    xs = tuple(jnp.moveaxis(t, 1, 0) for t in (r, decay, k, v, kk, a))
    S0 = jnp.zeros((bsz, A_HEADS, HEAD_DIM, HEAD_DIM), jnp.float32)
    _, y = lax.scan(step, S0, xs)
    y = jnp.moveaxis(y, 0, 1).astype(p.dtype)
    y = layernorm(y, lnx_g.reshape(A_HEADS, HEAD_DIM), lnx_b.reshape(A_HEADS, HEAD_DIM), LNX_EPS)
    y = y + jnp.sum(r * k * r_k, axis=-1, keepdims=True) * v
    return y.reshape(bsz, t_len, A_WIDTH)


def chunked_spatial_gate(u, v, ln_g, ln_b, w_s, b_s):
    bsz, t_len, _ = u.shape
    n_chunks = t_len // CHUNK
    v = layernorm(v.reshape(bsz, t_len, B_GROUPS, B_GROUP_DIM),
                  ln_g.reshape(B_GROUPS, B_GROUP_DIM), ln_b.reshape(B_GROUPS, B_GROUP_DIM), GMLP_LN_EPS)
    v = v.reshape(bsz, n_chunks, CHUNK, B_GROUPS, B_GROUP_DIM)
    causal = jnp.tril(jnp.ones((CHUNK, CHUNK), dtype=bool))
    w = jnp.where(causal[None], w_s, jnp.zeros_like(w_s))
    mixed = jnp.einsum('gts,bcsgd->bctgd', w, v) + b_s.T[None, None, :, :, None]
    return u * mixed.reshape(bsz, t_len, B_WIDTH)


def even_mixer(h, w_in, mu, w0, w_up, a0, a_up, k_k, k_a, r_k, lnx_g, lnx_b,
               sg_ln_g, sg_ln_b, sg_w, sg_b, w_out):
    p = h @ w_in
    p_a, u, v, z = jnp.split(p, [SHIFT_W, SHIFT_W + B_WIDTH, SHIFT_W + 2 * B_WIDTH], axis=-1)
    y_a = rwkv7_time_mix(p_a, mu, w0, w_up, a0, a_up, k_k, k_a, r_k, lnx_g, lnx_b)
    y_b = chunked_spatial_gate(u, v, sg_ln_g, sg_ln_b, sg_w, sg_b)
    y = jnp.concatenate([y_a, y_b], axis=-1) * jax.nn.silu(z)
    return y @ w_out


def swa_mixer(h, w_in, sinks, w_out):
    bsz, t_len, _ = h.shape
    nb = t_len // WINDOW
    p = h @ w_in
    q, k, v, z = jnp.split(p, [ODD_MIX, ODD_MIX + KV_W, ODD_MIX + 2 * KV_W], axis=-1)
    q = q.reshape(bsz, nb, WINDOW, C_KV_HEADS, C_GROUP, HEAD_DIM)

    def band(t):
        t = jnp.pad(t.reshape(bsz, t_len, C_KV_HEADS, HEAD_DIM), ((0, 0), (WINDOW, 0), (0, 0), (0, 0)))
        t = t.reshape(bsz, nb + 1, WINDOW, C_KV_HEADS, HEAD_DIM)
        return jnp.concatenate([t[:, :-1], t[:, 1:]], axis=2)

    k_band, v_band = band(k), band(v)
    scores = jnp.einsum('bnqhgd,bnkhd->bnhgqk', q, k_band).astype(jnp.float32) * (HEAD_DIM ** -0.5)
    qi = jnp.arange(WINDOW)[:, None]
    kj = jnp.arange(2 * WINDOW)[None, :]
    dist = qi + WINDOW - kj
    key_pos = (jnp.arange(nb)[:, None, None] - 1) * WINDOW + kj[None]
    valid = (dist >= 0)[None] & (dist < WINDOW)[None] & (key_pos >= 0)
    slopes = alibi_slopes(C_HEADS).reshape(C_KV_HEADS, C_GROUP)
    scores = scores - slopes[None, None, :, :, None, None] * dist.astype(jnp.float32)
    scores = jnp.where(valid[None, :, None, None], scores, -jnp.inf)
    sink = sinks.reshape(C_KV_HEADS, C_GROUP).astype(jnp.float32)[None, None, :, :, None, None]
    m = jnp.maximum(jnp.max(scores, axis=-1, keepdims=True), sink)
    e = jnp.exp(scores - m)
    probs = e / (jnp.sum(e, axis=-1, keepdims=True) + jnp.exp(sink - m))
    out = jnp.einsum('bnhgqk,bnkhd->bnqhgd', probs.astype(v_band.dtype), v_band)
    y = out.reshape(bsz, t_len, ODD_MIX) * jax.nn.silu(z)
    return y @ w_out


def setup_inputs(seed: int = 0) -> dict:
    key = jax.random.key(seed)
    ks = jax.random.split(key, 32)
    f32 = jnp.float32
    nrm = lambda k, shape, s: (jax.random.normal(k, shape, f32) * s).astype(f32)
    D = D_MODEL
    return {
        "x": nrm(ks[0], (BATCH, SEQ, D), 1.0),
        "c": nrm(ks[1], (BATCH, D), 1.0),
        "ada_w": nrm(ks[2], (DEPTH, D, 3 * D), 0.2 * D ** -0.5),
        "ada_b": nrm(ks[3], (DEPTH, 3 * D), 0.1),
        "norm_g": 1.0 + nrm(ks[4], (DEPTH, D), 0.02),
        "e_w_in": nrm(ks[5], (N_EVEN, D, EVEN_IN), D ** -0.5),
        "e_mu": jax.random.uniform(ks[6], (N_EVEN, SHIFT_W), f32),
        "e_w0": -0.5 + nrm(ks[7], (N_EVEN, A_WIDTH), 0.5),
        "e_w_up": nrm(ks[8], (N_EVEN, LORA_W, A_WIDTH), 0.5 * LORA_W ** -0.5),
        "e_a0": nrm(ks[9], (N_EVEN, A_WIDTH), 0.5),
        "e_a_up": nrm(ks[10], (N_EVEN, LORA_A, A_WIDTH), 0.5 * LORA_A ** -0.5),
        "e_k_k": 0.85 + nrm(ks[11], (N_EVEN, A_WIDTH), 0.05),
        "e_k_a": 1.0 + nrm(ks[12], (N_EVEN, A_WIDTH), 0.05),
        "e_r_k": nrm(ks[13], (N_EVEN, A_HEADS, HEAD_DIM), 0.1),
        "e_lnx_g": 1.0 + nrm(ks[14], (N_EVEN, A_WIDTH), 0.02),
        "e_lnx_b": nrm(ks[15], (N_EVEN, A_WIDTH), 0.02),
        "e_sg_ln_g": 1.0 + nrm(ks[16], (N_EVEN, B_WIDTH), 0.02),
        "e_sg_ln_b": nrm(ks[17], (N_EVEN, B_WIDTH), 0.02),
        "e_sg_w": nrm(ks[18], (N_EVEN, B_GROUPS, CHUNK, CHUNK), CHUNK ** -0.5),
        "e_sg_b": 1.0 + nrm(ks[19], (N_EVEN, B_GROUPS, CHUNK), 0.02),
        "e_w_out": nrm(ks[20], (N_EVEN, EVEN_MIX, D), EVEN_MIX ** -0.5),
        "o_w_in": nrm(ks[21], (N_ODD, D, ODD_IN), D ** -0.5),
        "o_sinks": nrm(ks[22], (N_ODD, C_HEADS), 0.5),
        "o_w_out": nrm(ks[23], (N_ODD, ODD_MIX, D), ODD_MIX ** -0.5),
        "final_g": 1.0 + nrm(ks[24], (D,), 0.02),
    }


def reference(x, c, ada_w, ada_b, norm_g, e_w_in, e_mu, e_w0, e_w_up, e_a0, e_a_up,
              e_k_k, e_k_a, e_r_k, e_lnx_g, e_lnx_b, e_sg_ln_g, e_sg_ln_b, e_sg_w, e_sg_b,
              e_w_out, o_w_in, o_sinks, o_w_out, final_g):
    cond = jax.nn.silu(c)
    for i in range(DEPTH):
        mod = cond @ ada_w[i] + ada_b[i]
        shift, scale, gate = jnp.split(mod[:, None, :], 3, axis=-1)
        h = rmsnorm(x, norm_g[i]) * (1 + scale) + shift
        j = i // 2
        if i % 2 == 0:
            y = even_mixer(h, e_w_in[j], e_mu[j], e_w0[j], e_w_up[j], e_a0[j], e_a_up[j],
                           e_k_k[j], e_k_a[j], e_r_k[j], e_lnx_g[j], e_lnx_b[j],
                           e_sg_ln_g[j], e_sg_ln_b[j], e_sg_w[j], e_sg_b[j], e_w_out[j])
        else:
            y = swa_mixer(h, o_w_in[j], o_sinks[j], o_w_out[j])
        x = x + gate * y
    return rmsnorm(x, final_g)
```

```cpp
#include <hip/hip_runtime.h>
#include <cstdio>
#include <cstdint>
namespace pg8 {
#define PG8_LAS __attribute__((address_space(3)))
typedef unsigned short bf16_t;
typedef short bf16x8 __attribute__((ext_vector_type(8)));
typedef float f32x4 __attribute__((ext_vector_type(4)));
typedef unsigned u32x4 __attribute__((ext_vector_type(4)));
constexpr int BM = 256, BK = 64, HALF = 128, HTB = HALF * BK * 2  , STAGE_BYTES = 8 * HTB, NXCD = 8, WGM = 8;

__host__ __device__ __forceinline__ int lds_byte(int r, int c) { const int st = (r >> 4) * 2 + (c >> 5), rr = r & 15, cc = c & 31, ob = rr * 64 + cc * 2; return st * 1024 + (ob ^ (((ob >> 9) & 1) << 5)); }
__host__ __device__ __forceinline__ void stage_rc(int b, int& R, int& C) { const int st = b / 1024, sb = b % 1024, swz = sb ^ (((sb >> 9) & 1) << 5); R = (st >> 1) * 16 + swz / 64; C = (st & 1) * 32 + (swz % 64) / 2; }
__host__ __device__ __forceinline__ int perm32(int rho) { const int n = rho >> 4, i = rho & 15; return 8 * (i >> 2) + 4 * n + (i & 3); }

struct Unit { int pm, pn; };
struct Gemm { const bf16_t* A; const bf16_t* Bt; int M, N, K; };

struct StaticOrder {
    int nM, nN, nwg, G, c;
    __host__ __device__ void init(int M, int N, int G_, int c_) { nM = M / BM; nN = N / BM; nwg = nM * nN; G = G_; c = c_; }
    __host__ __device__ bool next(int i, Unit& u) const {
        const long L = (long)i * G + c; if (L >= nwg) return false;
        int wgid = (int)L; { const int q = nwg / NXCD, r = nwg % NXCD, xcd = wgid % NXCD, off = wgid / NXCD; wgid = (xcd < r ? xcd * (q + 1) : r * (q + 1) + (xcd - r) * q) + off; }
        const int nig = WGM * nN, gid = wgid / nig, fm = gid * WGM, gsz = (nM - fm) < WGM ? (nM - fm) : WGM;
        u.pm = fm + ((wgid % nig) % gsz); u.pn = (wgid % nig) / gsz; return true;
    }
    __device__ __forceinline__ void a_ready(const Unit&) const {}
    __device__ __forceinline__ void done(const Unit&) const {}
};

__device__ __forceinline__ unsigned cvt_pk_bf16(float lo, float hi) { unsigned r; asm volatile("v_cvt_pk_bf16_f32 %0, %1, %2" : "=v"(r) : "v"(lo), "v"(hi)); return r; }
struct EpiBf16 {
    static constexpr bool PERM = true, AFTER_DRAIN = false;
    bf16_t* O; int ldc;
    __device__ __forceinline__ void operator()(const f32x4 (&acc)[2][2][4][2], const Unit& u, int wr, int wc, int fr, int fq) const {
        const int row0 = u.pm * BM + wr * 64 + fr; const int col0 = u.pn * BM + wc * 32 + 8 * fq;
#pragma unroll
        for (int ai = 0; ai < 2; ++ai)
#pragma unroll
            for (int m = 0; m < 4; ++m) { bf16_t* rowp = O + (size_t)(row0 + ai * HALF + m * 16) * ldc + col0;
#pragma unroll
                for (int bj = 0; bj < 2; ++bj) { const f32x4 v0 = acc[ai][bj][m][0], v1 = acc[ai][bj][m][1];
                    u32x4 w; w.x = cvt_pk_bf16(v0[0], v0[1]); w.y = cvt_pk_bf16(v0[2], v0[3]); w.z = cvt_pk_bf16(v1[0], v1[1]); w.w = cvt_pk_bf16(v1[2], v1[3]);
                    *(u32x4*)(rowp + bj * HALF) = w; } }
    }
};
struct EpiResGate {
    static constexpr bool PERM = false, AFTER_DRAIN = false;
    const float* base; float* out; const float* gate;
    __device__ __forceinline__ void operator()(const f32x4 (&acc)[2][2][4][2], const Unit& u, int wr, int wc, int fr, int fq) const {
        const int col0 = u.pn * BM + wc * 32 + 4 * fq; const int b = (u.pm * BM) >> 11;
        f32x4 gv[2][2];
#pragma unroll
        for (int bj = 0; bj < 2; ++bj)
#pragma unroll
            for (int n = 0; n < 2; ++n) gv[bj][n] = *(const f32x4*)(gate + (size_t)b * 3072 + col0 + bj * HALF + n * 16);
#pragma unroll
        for (int ai = 0; ai < 2; ++ai)
#pragma unroll
            for (int m = 0; m < 4; ++m) { const size_t off = (size_t)(u.pm * BM + ai * HALF + wr * 64 + m * 16 + fr) * 1024 + col0;
#pragma unroll
                for (int bj = 0; bj < 2; ++bj)
#pragma unroll
                    for (int n = 0; n < 2; ++n) { const f32x4 bs = *(const f32x4*)(base + off + bj * HALF + n * 16);
                        *(f32x4*)(out + off + bj * HALF + n * 16) = bs + gv[bj][n] * acc[ai][bj][m][n]; } }
    }
};

template <class Epi, class Sched, bool ALIGN_EPI = false, bool SP2 = false>
__device__ __forceinline__ void gemm_phase(PG8_LAS unsigned char* lds, const Gemm g, const Sched& S, const Epi& E) {
    const int tid = threadIdx.x, wid = __builtin_amdgcn_readfirstlane(tid >> 6), lane = tid & 63, wr = wid >> 2, wc = wid & 3, fr = lane & 15, fq = lane >> 4;
    const int K = g.K, nt = K / BK;
    unsigned voffA[2], voffB[2];
#pragma unroll
    for (int i = 0; i < 2; ++i) { int R, C; stage_rc(tid * 16 + i * 8192, R, C); const int Rb = Epi::PERM ? ((R & ~31) + perm32(R & 31)) : R;
        voffA[i] = (unsigned)(R * K + C) * 2u; voffB[i] = (unsigned)(Rb * K + C) * 2u; }
    const size_t kstep = (size_t)(BK * 2);
    const size_t hstep = (size_t)HALF * K * 2;
    const size_t tstep = 2 * hstep;
    const unsigned ldsw = (unsigned)wid * 1024u;
    const int aoff = lds_byte(wr * 64 + fr, fq * 8), boff = lds_byte(wc * 32 + fr, fq * 8);
#define PG8_SA(b, h) (((b) * 2 + (h)) * HTB)
#define PG8_SB(b, h) ((4 + (b) * 2 + (h)) * HTB)
#define PG8_STAGE(bufoff, gbase, voff) do { _Pragma("unroll") for (int _i = 0; _i < 2; ++_i) \
        __builtin_amdgcn_global_load_lds((const unsigned*)((const char*)(gbase) + (voff)[_i]), (PG8_LAS unsigned*)(lds + (bufoff) + ldsw + _i * 8192), 16, 0, 0); } while (0)
#define PG8_LDA(dst, b, h) do { _Pragma("unroll") for (int m = 0; m < 4; ++m) _Pragma("unroll") for (int k = 0; k < 2; ++k) dst[m][k] = *(const PG8_LAS bf16x8*)(lds + PG8_SA(b, h) + aoff + m * 2048 + k * 1024); } while (0)
#define PG8_LDB(dst, b, h) do { _Pragma("unroll") for (int n = 0; n < 2; ++n) _Pragma("unroll") for (int k = 0; k < 2; ++k) dst[n][k] = *(const PG8_LAS bf16x8*)(lds + PG8_SB(b, h) + boff + n * 2048 + k * 1024); } while (0)
#define PG8_MMA(ai, bj, At, Bt) do { __builtin_amdgcn_s_setprio(1); _Pragma("unroll") for (int m = 0; m < 4; ++m) _Pragma("unroll") for (int n = 0; n < 2; ++n) _Pragma("unroll") for (int k = 0; k < 2; ++k) \
        acc[ai][bj][m][n] = __builtin_amdgcn_mfma_f32_16x16x32_bf16(Bt[n][k], At[m][k], acc[ai][bj][m][n], 0, 0, 0); __builtin_amdgcn_s_setprio(0); } while (0)
#define PG8_WAIT_V(n) asm volatile("s_waitcnt vmcnt(" #n ")" ::: "memory")
#define PG8_WAIT_L(n) asm volatile("s_waitcnt lgkmcnt(" #n ")" ::: "memory")
#define PG8_BAR __builtin_amdgcn_s_barrier()
#define PG8_SCHED __builtin_amdgcn_sched_barrier(0)
    Unit cur, nxt; int ui = 0;
    if (!S.next(0, cur)) return;
    f32x4 acc[2][2][4][2];
#pragma unroll
    for (int a = 0; a < 2; ++a)
#pragma unroll
        for (int b = 0; b < 2; ++b)
#pragma unroll
            for (int m = 0; m < 4; ++m)
#pragma unroll
                for (int n = 0; n < 2; ++n) acc[a][b][m][n] = (f32x4){0.f, 0.f, 0.f, 0.f};
    bf16x8 At[4][2], B0[2][2], B1[2][2];
    const char* cA = (const char*)g.A + (size_t)cur.pm * tstep; const char* cB = (const char*)g.Bt + (size_t)cur.pn * tstep;
    S.a_ready(cur);
    if constexpr (SP2) {
        PG8_STAGE(PG8_SB(0, 0), cB, voffB); PG8_STAGE(PG8_SB(0, 1), cB + hstep, voffB); PG8_STAGE(PG8_SA(0, 0), cA, voffA); PG8_STAGE(PG8_SA(0, 1), cA + hstep, voffA);
        if (wr == 1) PG8_BAR;
        PG8_WAIT_V(2); PG8_BAR;
        PG8_STAGE(PG8_SB(1, 0), cB + kstep, voffB); PG8_STAGE(PG8_SA(1, 0), cA + kstep, voffA); PG8_STAGE(PG8_SB(1, 1), cB + hstep + kstep, voffB);
        PG8_WAIT_V(6); PG8_BAR;
    } else {
        PG8_STAGE(PG8_SB(0, 0), cB, voffB); PG8_STAGE(PG8_SA(0, 0), cA, voffA); PG8_STAGE(PG8_SB(0, 1), cB + hstep, voffB); PG8_STAGE(PG8_SA(0, 1), cA + hstep, voffA);
        if (wr == 1) PG8_BAR;
        PG8_WAIT_V(4); PG8_BAR;
        PG8_STAGE(PG8_SB(1, 0), cB + kstep, voffB); PG8_STAGE(PG8_SA(1, 0), cA + kstep, voffA); PG8_STAGE(PG8_SB(1, 1), cB + hstep + kstep, voffB);
        PG8_WAIT_V(6); PG8_BAR;
    }
    for (;;) {
        const bool has_next = S.next(ui + 1, nxt);
        const char* nA = has_next ? (const char*)g.A + (size_t)nxt.pm * tstep : cA; const char* nB = has_next ? (const char*)g.Bt + (size_t)nxt.pn * tstep : cB;
        for (int t = 0; t < nt; t += 2) {
            const bool last = (t == nt - 2);
            const char* a1 = cA + (size_t)(t + 1) * kstep;
            const char* a2 = last ? nA : cA + (size_t)(t + 2) * kstep; const char* b2 = last ? nB : cB + (size_t)(t + 2) * kstep;
            const char* a3 = a2 + kstep; const char* b3 = b2 + kstep;
            if (last && has_next) S.a_ready(nxt);
            if constexpr (SP2) {
            PG8_LDB(B0, 0, 0); PG8_LDB(B1, 0, 1); PG8_SCHED; PG8_LDA(At, 0, 0); PG8_STAGE(PG8_SA(1, 1), a1 + hstep, voffA);
            PG8_WAIT_V(8); PG8_WAIT_L(0); PG8_BAR; PG8_MMA(0, 0, At, B0); PG8_MMA(0, 1, At, B1); PG8_BAR; PG8_SCHED;
            PG8_LDA(At, 0, 1); PG8_STAGE(PG8_SB(0, 0), b2, voffB); PG8_STAGE(PG8_SB(0, 1), b2 + hstep, voffB); PG8_STAGE(PG8_SA(0, 0), a2, voffA);
            PG8_WAIT_V(8); PG8_WAIT_L(0); PG8_BAR; PG8_MMA(1, 0, At, B0); PG8_MMA(1, 1, At, B1); PG8_BAR; PG8_SCHED;
            PG8_LDB(B0, 1, 0); PG8_LDB(B1, 1, 1); PG8_SCHED; PG8_LDA(At, 1, 0); PG8_STAGE(PG8_SA(0, 1), a2 + hstep, voffA);
            PG8_WAIT_V(8); PG8_WAIT_L(0); PG8_BAR; PG8_MMA(0, 0, At, B0); PG8_MMA(0, 1, At, B1); PG8_BAR; PG8_SCHED;
            PG8_LDA(At, 1, 1); PG8_STAGE(PG8_SB(1, 0), b3, voffB); PG8_STAGE(PG8_SB(1, 1), b3 + hstep, voffB); PG8_STAGE(PG8_SA(1, 0), a3, voffA);
            PG8_WAIT_V(8); PG8_WAIT_L(0); PG8_BAR; PG8_MMA(1, 0, At, B0); PG8_MMA(1, 1, At, B1); PG8_BAR; PG8_SCHED;
            } else {
            PG8_LDB(B0, 0, 0); PG8_SCHED; PG8_LDA(At, 0, 0); PG8_STAGE(PG8_SA(1, 1), a1 + hstep, voffA);
            PG8_WAIT_L(8); PG8_BAR; PG8_WAIT_L(0); PG8_MMA(0, 0, At, B0); PG8_BAR; PG8_SCHED;
            PG8_LDB(B1, 0, 1); PG8_STAGE(PG8_SB(0, 0), b2, voffB);
            PG8_BAR; PG8_WAIT_L(0); PG8_MMA(0, 1, At, B1); PG8_BAR;
            PG8_LDA(At, 0, 1); PG8_STAGE(PG8_SA(0, 0), a2, voffA);
            PG8_BAR; PG8_WAIT_L(0); PG8_MMA(1, 0, At, B0); PG8_BAR; PG8_SCHED;
            PG8_STAGE(PG8_SB(0, 1), b2 + hstep, voffB);
            PG8_WAIT_V(6); PG8_BAR; PG8_MMA(1, 1, At, B1); PG8_BAR;
            PG8_LDB(B0, 1, 0); PG8_SCHED; PG8_LDA(At, 1, 0); PG8_STAGE(PG8_SA(0, 1), a2 + hstep, voffA);
            PG8_WAIT_L(8); PG8_BAR; PG8_WAIT_L(0); PG8_MMA(0, 0, At, B0); PG8_BAR; PG8_SCHED;
            PG8_LDB(B1, 1, 1); PG8_STAGE(PG8_SB(1, 0), b3, voffB);
            PG8_BAR; PG8_WAIT_L(0); PG8_MMA(0, 1, At, B1); PG8_BAR;
            PG8_LDA(At, 1, 1); PG8_STAGE(PG8_SA(1, 0), a3, voffA);
            PG8_BAR; PG8_WAIT_L(0); PG8_MMA(1, 0, At, B0); PG8_BAR; PG8_SCHED;
            PG8_STAGE(PG8_SB(1, 1), b3 + hstep, voffB);
            PG8_WAIT_V(6); PG8_BAR; PG8_MMA(1, 1, At, B1); PG8_BAR;
            }
        }
        if constexpr (ALIGN_EPI) { if (wr == 0) PG8_BAR; }
        if constexpr (!Epi::AFTER_DRAIN) { E(acc, cur, wr, wc, fr, fq); S.done(cur); }
        if (!has_next) break;
#pragma unroll
        for (int a = 0; a < 2; ++a)
#pragma unroll
            for (int b = 0; b < 2; ++b)
#pragma unroll
                for (int m = 0; m < 4; ++m)
#pragma unroll
                    for (int n = 0; n < 2; ++n) acc[a][b][m][n] = (f32x4){0.f, 0.f, 0.f, 0.f};
        cur = nxt; cA = nA; cB = nB; ++ui;
        if constexpr (ALIGN_EPI) { if (wr == 1) PG8_BAR; }
    }
    PG8_WAIT_V(0);
    if constexpr (!ALIGN_EPI) { if (wr == 0) PG8_BAR; }
    PG8_BAR;
    if constexpr (Epi::AFTER_DRAIN) { E.fused(acc, cur, wr, wc, fr, fq, lds, wid, lane); S.done(cur); }
#undef PG8_SA
#undef PG8_SB
#undef PG8_STAGE
#undef PG8_LDA
#undef PG8_LDB
#undef PG8_MMA
#undef PG8_WAIT_V
#undef PG8_WAIT_L
#undef PG8_BAR
#undef PG8_SCHED
}
}

#ifndef PG8_SP2
#define PG8_SP2 true
#endif
#ifndef PG8_ALIGN
#define PG8_ALIGN true
#endif
#define GAS __attribute__((address_space(1)))
#define LAS __attribute__((address_space(3)))
typedef unsigned short bf16;
typedef unsigned v4u __attribute__((ext_vector_type(4)));
typedef float f32x4 __attribute__((ext_vector_type(4)));
typedef short bf16x8 __attribute__((ext_vector_type(8)));
typedef GAS unsigned gu32;
typedef GAS unsigned long long gu64;
#define RLX_AGENT __ATOMIC_RELAXED, __HIP_MEMORY_SCOPE_AGENT
#define LDS_WAIT() asm volatile("s_waitcnt lgkmcnt(0)" ::: "memory")
#define VM_WAIT() asm volatile("s_waitcnt vmcnt(0)" ::: "memory")
__device__ __forceinline__ unsigned long long rt() { return __builtin_amdgcn_s_memrealtime(); }
__device__ __forceinline__ unsigned f2bf(float f) { unsigned u = __builtin_bit_cast(unsigned, f); return (u + 0x7fffu + ((u >> 16) & 1u)) >> 16; }
__device__ __forceinline__ unsigned pk2(float lo, float hi) { return f2bf(lo) | (f2bf(hi) << 16); }

#define XB_TMO      128
#define XB_XCNT(j)  (256  + 64 * (j))
#define XB_XSUB(j)  (1280 + 64 * (j))
#define XB_XGEN(j)  (2304 + 64 * (j))
#define XB_TOP      3328
#define XB_TOPGEN   3392
#define XCD_BAR_WORDS 3456
#define XB_SPIN_CAP (1u << 22)

__device__ __forceinline__ unsigned xb_ld(unsigned* p)              { return __hip_atomic_load(p, __ATOMIC_RELAXED, __HIP_MEMORY_SCOPE_AGENT); }
__device__ __forceinline__ unsigned xb_add(unsigned* p, unsigned v) { return __hip_atomic_fetch_add(p, v, __ATOMIC_RELAXED, __HIP_MEMORY_SCOPE_AGENT); }
__device__ __forceinline__ unsigned xb_xcc_id() { return (unsigned)__builtin_amdgcn_s_getreg((3 << 11) | 20) & 0xFu; }
#define XB_SPIN(cond, bar) do { unsigned _sp = 0; while (cond) { __builtin_amdgcn_s_sleep(1); \
    if ((++_sp & 255u) == 0u) { if (xb_ld(&(bar)[XB_TMO])) break; if (_sp > XB_SPIN_CAP) { atomicAdd(&(bar)[XB_TMO], 1u); break; } } } } while (0)

struct XcdBarrier {
    unsigned* bar; unsigned x;
    volatile LAS unsigned* st;
};

__device__ __forceinline__ XcdBarrier xcd_barrier_post(unsigned* bar, volatile LAS unsigned* st) {
    XcdBarrier b; b.bar = bar; b.x = xb_xcc_id(); b.st = st;
    if (threadIdx.x == 0) (void)xb_add(&bar[XB_XCNT(b.x)], 1u);
    return b;
}
__device__ __forceinline__ void xcd_barrier_complete(unsigned* bar, unsigned x, unsigned& nloc, unsigned& nx) {
    const unsigned G = gridDim.x * gridDim.y * gridDim.z;
    unsigned sum, cnt, mine, sp = 0u;
    for (;;) {
        sum = 0u; cnt = 0u; mine = 0u;
#pragma unroll
        for (unsigned j = 0; j < 16; ++j) { const unsigned c = xb_ld(&bar[XB_XCNT(j)]); sum += c; cnt += (c > 0u) ? 1u : 0u; mine = (j == x) ? c : mine; }
        if (sum == G) break;
        __builtin_amdgcn_s_sleep(1);
        if ((++sp & 255u) == 0u) { if (xb_ld(&bar[XB_TMO])) break; if (sp > XB_SPIN_CAP) { atomicAdd(&bar[XB_TMO], 1u); break; } }
    }
    nloc = mine > 0u ? mine : 1u; nx = cnt > 0u ? cnt : 1u;
}

__device__ __forceinline__ void xcd_barrier(const XcdBarrier& b) {
    asm volatile("s_waitcnt vmcnt(0)" ::: "memory");
    __syncthreads();
    if (threadIdx.x == 0) {
        unsigned* bar = b.bar;
        __builtin_amdgcn_s_waitcnt(0);
        unsigned nloc = b.st[0], nx = b.st[1];
        if (nloc == 0u) { xcd_barrier_complete(bar, b.x, nloc, nx); b.st[0] = nloc; b.st[1] = nx; }
        const unsigned old = xb_add(&bar[XB_XSUB(b.x)], 1u);
        const unsigned gen = old / nloc;
        if (old + 1u == (gen + 1u) * nloc) {
            __builtin_amdgcn_fence(__ATOMIC_RELEASE, "agent");
            asm volatile("s_waitcnt vmcnt(0)" ::: "memory");
            const unsigned og = xb_add(&bar[XB_TOP], 1u);
            const unsigned tg = og / nx;
            if (og + 1u == (tg + 1u) * nx) xb_add(&bar[XB_TOPGEN], 1u);
            else XB_SPIN(xb_ld(&bar[XB_TOPGEN]) == tg, bar);
            __builtin_amdgcn_fence(__ATOMIC_ACQUIRE, "agent");
            xb_add(&bar[XB_XGEN(b.x)], 1u);
            asm volatile("s_waitcnt vmcnt(0)" ::: "memory");
        } else {
            XB_SPIN(xb_ld(&bar[XB_XGEN(b.x)]) == gen, bar);
            __builtin_amdgcn_fence(__ATOMIC_ACQUIRE, "agent");
            asm volatile("s_waitcnt vmcnt(0)" ::: "memory");
        }
    }
    __syncthreads();
}


constexpr int NWAVES = 8;
constexpr int BATCH = 16, SEQ = 2048, D = 1024, M = BATCH * SEQ;
constexpr int EVEN_IN = 3712, EVEN_PAD = 3840, ODD_IN = 2304;
constexpr int C_R = 0, C_K = 512, C_V = 1024, C_WLO = 1536, C_ALO = 1600, C_U = 1664, C_VG = 2176, C_Z0 = 2688;
constexpr int C_Q = 0, C_KC = 1024, C_VC = 1152, C_Z1 = 1280;
enum { I_X = 0, I_C, I_ADAW, I_ADAB, I_NORMG, I_EWIN, I_EMU, I_EW0, I_EWUP, I_EA0, I_EAUP, I_EKK, I_EKA, I_ERK, I_ELNXG, I_ELNXB, I_ESGLNG, I_ESGLNB, I_ESGW, I_ESGB, I_EWOUT, I_OWIN, I_OSINKS, I_OWOUT, I_FINALG, N_IN };

constexpr size_t MiB = 1u << 20;
constexpr size_t WS_CTL = 0, CTL_ZERO_BYTES = 64 * 1024;
constexpr size_t WS_MOD = 1 * MiB;
constexpr size_t WS_WIN0 = 2 * MiB, WS_WOUT0 = 10 * MiB, WS_WIN1 = 12 * MiB, WS_WOUT1 = 17 * MiB;
constexpr size_t WS_XN = 32 * MiB, WS_MIX = 96 * MiB, WS_P = 160 * MiB, WS_END = 400 * MiB;
constexpr int CW_BAR = 4096;

constexpr int RING_BYTES = 131072, LDSCTL_OFF = RING_BYTES, MISC_OFF = LDSCTL_OFF + 320, LDS_BYTES = 147456;

__device__ __forceinline__ float bf2f(unsigned short h) { return __builtin_bit_cast(float, (unsigned)h << 16); }
__device__ __forceinline__ float bflo(unsigned w) { return __builtin_bit_cast(float, w << 16); }
__device__ __forceinline__ float bfhi(unsigned w) { return __builtin_bit_cast(float, w & 0xffff0000u); }
__device__ __forceinline__ float wave_sum(float v) {
#pragma unroll
    for (int o = 1; o < 64; o <<= 1) v += __shfl_xor(v, o);
    return v;
}
__device__ __forceinline__ float siluf(float x) { return x / (1.f + __expf(-x)); }

struct Args { const float* in[N_IN]; float* out; unsigned char* ws; int ph_lo, ph_hi; };

__device__ __forceinline__ void p0_transpose_item(const float* W, int K, int N, bf16* WT, LAS float* scr, int item, int lane) {
    const int nblk = N / 32, kb = item / nblk, nb = item % nblk, k0 = 64 * kb, n0 = 32 * nb;
#pragma unroll 8
    for (int i = 0; i < 32; ++i) { const int kk = 2 * i + (lane >> 5); scr[kk * 33 + (lane & 31)] = W[(size_t)(k0 + kk) * N + n0 + (lane & 31)]; }
    LDS_WAIT(); asm volatile("" ::: "memory");
    const int c = lane & 7;
#pragma unroll
    for (int j = 0; j < 4; ++j) { const int n = (lane >> 3) + 8 * j; const LAS float* s = scr + (8 * c) * 33 + n;
        v4u o; o.x = pk2(s[0 * 33], s[1 * 33]); o.y = pk2(s[2 * 33], s[3 * 33]); o.z = pk2(s[4 * 33], s[5 * 33]); o.w = pk2(s[6 * 33], s[7 * 33]);
        *(GAS v4u*)(WT + (size_t)(n0 + n) * K + k0 + 8 * c) = o; }
    LDS_WAIT(); asm volatile("" ::: "memory");
}
__device__ __forceinline__ void phase0(const Args& a, LAS unsigned char* lds, int tid, int lane, int wave, int vcu, int G) {
    unsigned char* ws = a.ws;
    if (vcu < 96) {
        LAS float* condT = (LAS float*)lds;
        LAS float* part = (LAS float*)(lds + 65536);
        const float* c = a.in[I_C];
        for (int idx = tid; idx < 16384; idx += 512) { const int b = idx >> 10, k = idx & 1023; condT[k * 16 + b] = siluf(c[idx]); }
        __syncthreads();
        for (int it = vcu; it < 96; it += G) {
            const int l = it / 48, n0 = (it % 48) * 64;
            const float* W = a.in[I_ADAW] + (size_t)l * 1024 * 3072 + n0 + lane;
            float acc[16];
#pragma unroll
            for (int b = 0; b < 16; ++b) acc[b] = 0.f;
            const int kbeg = wave * 128;
#pragma unroll 4
            for (int k = kbeg; k < kbeg + 128; ++k) {
                const float w = W[(size_t)k * 3072];
                const LAS f32x4* cv = (const LAS f32x4*)(condT + k * 16);
                const f32x4 c0 = cv[0], c1 = cv[1], c2 = cv[2], c3 = cv[3];
                acc[0] += c0[0] * w; acc[1] += c0[1] * w; acc[2] += c0[2] * w; acc[3] += c0[3] * w;
                acc[4] += c1[0] * w; acc[5] += c1[1] * w; acc[6] += c1[2] * w; acc[7] += c1[3] * w;
                acc[8] += c2[0] * w; acc[9] += c2[1] * w; acc[10] += c2[2] * w; acc[11] += c2[3] * w;
                acc[12] += c3[0] * w; acc[13] += c3[1] * w; acc[14] += c3[2] * w; acc[15] += c3[3] * w;
            }
#pragma unroll
            for (int b = 0; b < 16; ++b) part[(wave * 16 + b) * 64 + lane] = acc[b];
            __syncthreads();
            float* mod = (float*)(ws + WS_MOD);
#pragma unroll
            for (int q = 0; q < 2; ++q) { const int b = (tid >> 6) + 8 * q; float s = 0.f;
#pragma unroll
                for (int w8 = 0; w8 < 8; ++w8) s += part[(w8 * 16 + b) * 64 + lane];
                mod[(size_t)(l * 16 + b) * 3072 + n0 + lane] = s + a.in[I_ADAB][l * 3072 + n0 + lane]; }
            __syncthreads();
        }
    }
    __syncthreads();
    LAS float* scr = (LAS float*)(lds + wave * 16384);
    const int gw = vcu * NWAVES + wave, NGW = G * NWAVES;
    constexpr int I0 = (D / 64) * (EVEN_IN / 32), I1 = (D / 64) * (D / 32), I2 = (D / 64) * (ODD_IN / 32), I3 = I1, IZ = EVEN_PAD - EVEN_IN;
    for (int it = gw; it < I0 + I1 + I2 + I3 + IZ; it += NGW) {
        int r = it;
        if (r < I0) { p0_transpose_item(a.in[I_EWIN], D, EVEN_IN, (bf16*)(ws + WS_WIN0), scr, r, lane); continue; } r -= I0;
        if (r < I1) { p0_transpose_item(a.in[I_EWOUT], D, D, (bf16*)(ws + WS_WOUT0), scr, r, lane); continue; } r -= I1;
        if (r < I2) { p0_transpose_item(a.in[I_OWIN], D, ODD_IN, (bf16*)(ws + WS_WIN1), scr, r, lane); continue; } r -= I2;
        if (r < I3) { p0_transpose_item(a.in[I_OWOUT], D, D, (bf16*)(ws + WS_WOUT1), scr, r, lane); continue; } r -= I3;
        { GAS v4u* o = (GAS v4u*)((bf16*)(ws + WS_WIN0) + (size_t)(EVEN_IN + r) * D); const v4u z = {0u, 0u, 0u, 0u}; o[lane] = z; o[lane + 64] = z; }
    }
}

__device__ __forceinline__ void phase_adaln_rows(const float* xin, const float* g, const float* modl, bf16* XN, int lane, int wave, int vcu, int G) {
    const int gw = vcu * NWAVES + wave, NGW = G * NWAVES;
    for (int r0 = gw * 16; r0 < M; r0 += NGW * 16) {
        const int b = r0 >> 11;
        f32x4 gs[4], sh[4];
#pragma unroll
        for (int j = 0; j < 4; ++j) { const int c = 4 * lane + 256 * j;
            const f32x4 gg = *(const f32x4*)(g + c), sc = *(const f32x4*)(modl + (size_t)b * 3072 + 1024 + c);
            gs[j] = gg * (sc + 1.0f); sh[j] = *(const f32x4*)(modl + (size_t)b * 3072 + c); }
        for (int r = r0; r < r0 + 16; ++r) {
            const GAS f32x4* xr = (const GAS f32x4*)(xin + (size_t)r * D) + lane;
            f32x4 v[4]; float s = 0.f;
#pragma unroll
            for (int j = 0; j < 4; ++j) { v[j] = xr[64 * j]; s += (v[j].x * v[j].x + v[j].y * v[j].y) + (v[j].z * v[j].z + v[j].w * v[j].w); }
            const float rs = 1.0f / sqrtf(wave_sum(s) * (1.f / D) + 1e-6f);
            GAS unsigned long long* o8 = (GAS unsigned long long*)(XN + (size_t)r * D) + lane;
#pragma unroll
            for (int j = 0; j < 4; ++j) { const f32x4 o = v[j] * rs * gs[j] + sh[j];
                o8[64 * j] = (unsigned long long)pk2(o.x, o.y) | ((unsigned long long)pk2(o.z, o.w) << 32); }
        }
    }
}
__device__ __forceinline__ void phase_final_rows(float* xio, const float* g, int lane, int wave, int vcu, int G) {
    const int gw = vcu * NWAVES + wave, NGW = G * NWAVES;
    f32x4 gs[4];
#pragma unroll
    for (int j = 0; j < 4; ++j) gs[j] = *(const f32x4*)(g + 4 * lane + 256 * j);
    for (int r = gw; r < M; r += NGW) {
        GAS f32x4* xr = (GAS f32x4*)(xio + (size_t)r * D) + lane;
        f32x4 v[4]; float s = 0.f;
#pragma unroll
        for (int j = 0; j < 4; ++j) { v[j] = xr[64 * j]; s += (v[j].x * v[j].x + v[j].y * v[j].y) + (v[j].z * v[j].z + v[j].w * v[j].w); }
        const float rs = 1.0f / sqrtf(wave_sum(s) * (1.f / D) + 1e-6f);
#pragma unroll
        for (int j = 0; j < 4; ++j) xr[64 * j] = v[j] * rs * gs[j];
    }
}

__device__ __forceinline__ void phase_rwkv(const Args& a, LAS unsigned char* lds, int tid, int lane, int wave, int vcu, int G) {
    const bf16* P = (const bf16*)(a.ws + WS_P); bf16* MIX = (bf16*)(a.ws + WS_MIX);
    LAS float* WUP = (LAS float*)lds;
    LAS float* AUP = WUP + 4096;
    LAS float* TW = AUP + 4096;
    LAS float* AL = TW + 2048;
    LAS float* Rr = AL + 2048;
    LAS float* KR = Rr + 2048;
    LAS float* Vv = KR + 2048;
    LAS float* Wd = Vv + 2048;
    LAS float* KK = Wd + 2048;
    LAS float* Bb = KK + 2048;
    LAS float* Yy = Bb + 2048;
    LAS float* BON = Yy + 2048;
    for (int unit = vcu; unit < BATCH * 8; unit += G) {
        const int b = unit >> 3, h = unit & 7;
        __syncthreads();
        for (int idx = tid; idx < 4096; idx += 512) { const int m = idx >> 6, j = idx & 63; WUP[idx] = a.in[I_EWUP][m * 512 + h * 64 + j]; AUP[idx] = a.in[I_EAUP][m * 512 + h * 64 + j]; }
        float S[8];
#pragma unroll
        for (int j = 0; j < 8; ++j) S[j] = 0.f;
        const int hj = h * 64 + lane;
        const float w0 = a.in[I_EW0][hj], a0 = a.in[I_EA0][hj], k_k = a.in[I_EKK][hj], k_a = a.in[I_EKA][hj], r_k = a.in[I_ERK][hj], lng = a.in[I_ELNXG][hj], lnb = a.in[I_ELNXB][hj];
        for (int ck = 0; ck < SEQ / 32; ++ck) {
            const int t0 = ck * 32;
            { const int i = tid >> 4, sub = tid & 15; const int t = t0 + i; const bf16* pc = P + (size_t)(b * SEQ + t) * EVEN_PAD; const bf16* pp = pc - EVEN_PAD; const bool hasp = t > 0;
#pragma unroll
              for (int grp = 0; grp < 5; ++grp) {
                  const int col = (grp == 0 ? C_R + h * 64 : grp == 1 ? C_K + h * 64 : grp == 2 ? C_V + h * 64 : grp == 3 ? C_WLO : C_ALO) + 4 * sub;
                  const uint2 cu = *(const uint2*)(pc + col); uint2 pu = {0u, 0u}; if (hasp) pu = *(const uint2*)(pp + col);
                  const f32x4 mu = *(const f32x4*)(a.in[I_EMU] + col);
                  float cv[4] = {bflo(cu.x), bfhi(cu.x), bflo(cu.y), bfhi(cu.y)}, pv[4] = {bflo(pu.x), bfhi(pu.x), bflo(pu.y), bfhi(pu.y)};
                  f32x4 xs;
#pragma unroll
                  for (int e = 0; e < 4; ++e) xs[e] = cv[e] + mu[e] * (pv[e] - cv[e]);
                  if (grp == 3) { xs[0] = tanhf(xs[0]); xs[1] = tanhf(xs[1]); xs[2] = tanhf(xs[2]); xs[3] = tanhf(xs[3]); }
                  LAS float* dst = (grp == 0 ? Rr : grp == 1 ? KR : grp == 2 ? Vv : grp == 3 ? TW : AL) + i * 64 + 4 * sub;
                  *(LAS f32x4*)dst = xs;
              } }
            __syncthreads();
            { float accw[4] = {0.f, 0.f, 0.f, 0.f}, acca[4] = {0.f, 0.f, 0.f, 0.f};
              for (int m4 = 0; m4 < 16; ++m4) {
                  f32x4 tw[4], al[4];
#pragma unroll
                  for (int q = 0; q < 4; ++q) { tw[q] = *(const LAS f32x4*)(TW + (wave + 8 * q) * 64 + 4 * m4); al[q] = *(const LAS f32x4*)(AL + (wave + 8 * q) * 64 + 4 * m4); }
#pragma unroll
                  for (int e = 0; e < 4; ++e) { const float wu = WUP[(4 * m4 + e) * 64 + lane], au = AUP[(4 * m4 + e) * 64 + lane];
#pragma unroll
                      for (int q = 0; q < 4; ++q) { accw[q] += tw[q][e] * wu; acca[q] += al[q][e] * au; } }
              }
#pragma unroll
              for (int q = 0; q < 4; ++q) { const int i = wave + 8 * q;
                  const float wv = w0 + accw[q];
                  const float nx = -wv; const float sp = fmaxf(nx, 0.f) + log1pf(__expf(-fabsf(nx)));
                  const float wl = -sp - 0.5f; const float decay = __expf(-__expf(wl));
                  const float av = 1.f / (1.f + __expf(-(a0 + acca[q])));
                  const float kraw = KR[i * 64 + lane]; const float kkv = kraw * k_k;
                  const float ss = wave_sum(kkv * kkv); const float kk = kkv / fmaxf(sqrtf(ss), 1e-12f);
                  const float kp = kraw * (1.f + (av - 1.f) * k_a);
                  const float bon = wave_sum(Rr[i * 64 + lane] * kp * r_k);
                  Wd[i * 64 + lane] = decay; KR[i * 64 + lane] = kp; KK[i * 64 + lane] = kk; Bb[i * 64 + lane] = kk * av; if (lane == 0) BON[i] = bon; } }
            __syncthreads();
            { const int row = wave * 8 + (lane >> 3), c8 = (lane & 7) * 8;
              for (int i = 0; i < 32; ++i) {
                  const f32x4 k0 = *(const LAS f32x4*)(KK + i * 64 + c8), k1 = *(const LAS f32x4*)(KK + i * 64 + c8 + 4);
                  const f32x4 w0v = *(const LAS f32x4*)(Wd + i * 64 + c8), w1v = *(const LAS f32x4*)(Wd + i * 64 + c8 + 4);
                  const f32x4 b0 = *(const LAS f32x4*)(Bb + i * 64 + c8), b1 = *(const LAS f32x4*)(Bb + i * 64 + c8 + 4);
                  const f32x4 p0 = *(const LAS f32x4*)(KR + i * 64 + c8), p1 = *(const LAS f32x4*)(KR + i * 64 + c8 + 4);
                  const f32x4 r0 = *(const LAS f32x4*)(Rr + i * 64 + c8), r1 = *(const LAS f32x4*)(Rr + i * 64 + c8 + 4);
                  const float vv = Vv[i * 64 + row];
                  float sa = (S[0] * k0[0] + S[1] * k0[1]) + (S[2] * k0[2] + S[3] * k0[3]) + (S[4] * k1[0] + S[5] * k1[1]) + (S[6] * k1[2] + S[7] * k1[3]);
                  sa += __shfl_xor(sa, 1); sa += __shfl_xor(sa, 2); sa += __shfl_xor(sa, 4); sa = -sa;
                  S[0] = S[0] * w0v[0] + sa * b0[0] + vv * p0[0]; S[1] = S[1] * w0v[1] + sa * b0[1] + vv * p0[1];
                  S[2] = S[2] * w0v[2] + sa * b0[2] + vv * p0[2]; S[3] = S[3] * w0v[3] + sa * b0[3] + vv * p0[3];
                  S[4] = S[4] * w1v[0] + sa * b1[0] + vv * p1[0]; S[5] = S[5] * w1v[1] + sa * b1[1] + vv * p1[1];
                  S[6] = S[6] * w1v[2] + sa * b1[2] + vv * p1[2]; S[7] = S[7] * w1v[3] + sa * b1[3] + vv * p1[3];
                  float y = (S[0] * r0[0] + S[1] * r0[1]) + (S[2] * r0[2] + S[3] * r0[3]) + (S[4] * r1[0] + S[5] * r1[1]) + (S[6] * r1[2] + S[7] * r1[3]);
                  y += __shfl_xor(y, 1); y += __shfl_xor(y, 2); y += __shfl_xor(y, 4);
                  if ((lane & 7) == 0) Yy[i * 64 + row] = y;
              } }
            __syncthreads();
#pragma unroll
            for (int q = 0; q < 4; ++q) { const int i = wave * 4 + q; const size_t rowg = (size_t)(b * SEQ + t0 + i);
                const float y = Yy[i * 64 + lane]; const float mean = wave_sum(y) * (1.f / 64.f); const float d = y - mean; const float var = wave_sum(d * d) * (1.f / 64.f);
                const float o = d * (1.0f / sqrtf(var + 64e-5f)) * lng + lnb + BON[i] * Vv[i * 64 + lane];
                const float z = bf2f(P[rowg * EVEN_PAD + C_Z0 + hj]);
                MIX[rowg * D + hj] = (bf16)f2bf(o * siluf(z)); }
            __syncthreads();
        }
    }
}
__device__ __forceinline__ void phase_gmlp(const Args& a, LAS unsigned char* lds, int tid, int lane, int wave, int vcu, int G) {
    const bf16* P = (const bf16*)(a.ws + WS_P); bf16* MIX = (bf16*)(a.ws + WS_MIX);
    LAS float* WS = (LAS float*)lds;
    LAS float* VLN = (LAS float*)(lds + 128 * 129 * 4);
    int gload = -1;
    for (int u = vcu; u < BATCH * 16 * 8; u += G) {
        const int b = u >> 7, ck = (u >> 3) & 15, g = u & 7;
        __syncthreads();
        if (g != gload) { for (int idx = tid; idx < 16384; idx += 512) WS[(idx >> 7) * 129 + (idx & 127)] = a.in[I_ESGW][(size_t)g * 16384 + idx]; gload = g; }
        const int i = tid >> 2, sub = tid & 3; const size_t rowg = (size_t)(b * SEQ + ck * 128 + i);
        { const v4u q0 = *(const v4u*)(P + rowg * EVEN_PAD + C_VG + g * 64 + sub * 16), q1 = *(const v4u*)(P + rowg * EVEN_PAD + C_VG + g * 64 + sub * 16 + 8);
          float v[16] = {bflo(q0.x), bfhi(q0.x), bflo(q0.y), bfhi(q0.y), bflo(q0.z), bfhi(q0.z), bflo(q0.w), bfhi(q0.w), bflo(q1.x), bfhi(q1.x), bflo(q1.y), bfhi(q1.y), bflo(q1.z), bfhi(q1.z), bflo(q1.w), bfhi(q1.w)};
          float s = 0.f;
#pragma unroll
          for (int e = 0; e < 16; ++e) s += v[e];
          s += __shfl_xor(s, 1); s += __shfl_xor(s, 2); const float mean = s * (1.f / 64.f); float q = 0.f;
#pragma unroll
          for (int e = 0; e < 16; ++e) { v[e] -= mean; q += v[e] * v[e]; }
          q += __shfl_xor(q, 1); q += __shfl_xor(q, 2); const float rstd = 1.0f / sqrtf(q * (1.f / 64.f) + 1e-5f);
#pragma unroll
          for (int e = 0; e < 16; ++e) VLN[i * 64 + sub * 16 + e] = v[e] * rstd * a.in[I_ESGLNG][g * 64 + sub * 16 + e] + a.in[I_ESGLNB][g * 64 + sub * 16 + e]; }
        __syncthreads();
        float acc[16];
#pragma unroll
        for (int e = 0; e < 16; ++e) acc[e] = 0.f;
        const int smax = wave * 16 + 16;
        for (int s = 0; s < smax; ++s) {
            const float w = (s <= i) ? WS[i * 129 + s] : 0.f;
            const f32x4 v0 = *(const LAS f32x4*)(VLN + s * 64 + sub * 16), v1 = *(const LAS f32x4*)(VLN + s * 64 + sub * 16 + 4), v2 = *(const LAS f32x4*)(VLN + s * 64 + sub * 16 + 8), v3 = *(const LAS f32x4*)(VLN + s * 64 + sub * 16 + 12);
#pragma unroll
            for (int e = 0; e < 4; ++e) { acc[e] += w * v0[e]; acc[4 + e] += w * v1[e]; acc[8 + e] += w * v2[e]; acc[12 + e] += w * v3[e]; }
        }
        const float bs = a.in[I_ESGB][g * 128 + i];
        const v4u u0 = *(const v4u*)(P + rowg * EVEN_PAD + C_U + g * 64 + sub * 16), u1 = *(const v4u*)(P + rowg * EVEN_PAD + C_U + g * 64 + sub * 16 + 8);
        const v4u z0 = *(const v4u*)(P + rowg * EVEN_PAD + C_Z0 + 512 + g * 64 + sub * 16), z1 = *(const v4u*)(P + rowg * EVEN_PAD + C_Z0 + 512 + g * 64 + sub * 16 + 8);
        const float uu[16] = {bflo(u0.x), bfhi(u0.x), bflo(u0.y), bfhi(u0.y), bflo(u0.z), bfhi(u0.z), bflo(u0.w), bfhi(u0.w), bflo(u1.x), bfhi(u1.x), bflo(u1.y), bfhi(u1.y), bflo(u1.z), bfhi(u1.z), bflo(u1.w), bfhi(u1.w)};
        const float zz[16] = {bflo(z0.x), bfhi(z0.x), bflo(z0.y), bfhi(z0.y), bflo(z0.z), bfhi(z0.z), bflo(z0.w), bfhi(z0.w), bflo(z1.x), bfhi(z1.x), bflo(z1.y), bfhi(z1.y), bflo(z1.z), bfhi(z1.z), bflo(z1.w), bfhi(z1.w)};
        float o[16];
#pragma unroll
        for (int e = 0; e < 16; ++e) o[e] = uu[e] * (acc[e] + bs) * siluf(zz[e]);
        v4u w0, w1; w0.x = pk2(o[0], o[1]); w0.y = pk2(o[2], o[3]); w0.z = pk2(o[4], o[5]); w0.w = pk2(o[6], o[7]); w1.x = pk2(o[8], o[9]); w1.y = pk2(o[10], o[11]); w1.z = pk2(o[12], o[13]); w1.w = pk2(o[14], o[15]);
        *(v4u*)(MIX + rowg * D + 512 + g * 64 + sub * 16) = w0; *(v4u*)(MIX + rowg * D + 512 + g * 64 + sub * 16 + 8) = w1;
    }
}

__device__ __forceinline__ void phase_swa(const Args& a, LAS unsigned char* lds, int tid, int lane, int wave, int vcu, int G) {
    const bf16* P = (const bf16*)(a.ws + WS_P); bf16* MIX = (bf16*)(a.ws + WS_MIX);
    LAS unsigned* KB = (LAS unsigned*)lds;
    LAS unsigned* VB = KB + 256 * 33;
    for (int u = vcu; u < BATCH * 16 * 2; u += G) {
        const int b = u >> 5, n = (u >> 1) & 15, kvh = u & 1;
        __syncthreads();
        { const int kr = tid >> 1, half = tid & 1; const int tk = n * 128 - 128 + kr;
          v4u kq[4], vq[4];
#pragma unroll
          for (int e = 0; e < 4; ++e) { kq[e] = (v4u){0u, 0u, 0u, 0u}; vq[e] = kq[e]; }
          if (tk >= 0) { const bf16* pr = P + (size_t)(b * SEQ + tk) * ODD_IN;
#pragma unroll
              for (int e = 0; e < 4; ++e) { kq[e] = *(const v4u*)(pr + C_KC + kvh * 64 + half * 32 + e * 8); vq[e] = *(const v4u*)(pr + C_VC + kvh * 64 + half * 32 + e * 8); } }
#pragma unroll
          for (int e = 0; e < 4; ++e) { LAS unsigned* kd = KB + kr * 33 + half * 16 + e * 4; kd[0] = kq[e].x; kd[1] = kq[e].y; kd[2] = kq[e].z; kd[3] = kq[e].w;
              LAS unsigned* vd = VB + kr * 33 + half * 16 + e * 4; vd[0] = vq[e].x; vd[1] = vq[e].y; vd[2] = vq[e].z; vd[3] = vq[e].w; } }
        __syncthreads();
        for (int pass = 0; pass < 2; ++pass) {
            const int gq = (tid >> 7) + 4 * pass, qi = tid & 127, h = kvh * 8 + gq; const size_t rowg = (size_t)(b * SEQ + n * 128 + qi);
            float q[64], o[64];
#pragma unroll
            for (int e = 0; e < 8; ++e) { const v4u w = *(const v4u*)(P + rowg * ODD_IN + C_Q + h * 64 + e * 8);
                q[8 * e + 0] = bflo(w.x) * 0.125f; q[8 * e + 1] = bfhi(w.x) * 0.125f; q[8 * e + 2] = bflo(w.y) * 0.125f; q[8 * e + 3] = bfhi(w.y) * 0.125f;
                q[8 * e + 4] = bflo(w.z) * 0.125f; q[8 * e + 5] = bfhi(w.z) * 0.125f; q[8 * e + 6] = bflo(w.w) * 0.125f; q[8 * e + 7] = bfhi(w.w) * 0.125f; }
#pragma unroll
            for (int e = 0; e < 64; ++e) o[e] = 0.f;
            const float slope = exp2f(-0.5f * (float)(h + 1));
            float mrun = a.in[I_OSINKS][h], lrun = 1.f;
            for (int j = 0; j < 128; ++j) {
                const int kr = qi + 1 + j; const bool valid = (n > 0) || (kr >= 128);
                const LAS unsigned* kp = KB + kr * 33;
                float s0 = 0.f, s1 = 0.f;
#pragma unroll
                for (int e = 0; e < 32; ++e) { const unsigned w = kp[e]; s0 += q[2 * e] * bflo(w); s1 += q[2 * e + 1] * bfhi(w); }
                const float s = (s0 + s1) - slope * (float)(127 - j);
                const float mn = valid ? fmaxf(mrun, s) : mrun;
                const float alpha = __expf(mrun - mn); const float p = valid ? __expf(s - mn) : 0.f;
                lrun = lrun * alpha + p; mrun = mn;
                const LAS unsigned* vp = VB + kr * 33;
#pragma unroll
                for (int e = 0; e < 32; ++e) { const unsigned w = vp[e]; o[2 * e] = o[2 * e] * alpha + p * bflo(w); o[2 * e + 1] = o[2 * e + 1] * alpha + p * bfhi(w); }
            }
            const float il = 1.f / lrun;
#pragma unroll
            for (int e = 0; e < 8; ++e) { const v4u zw = *(const v4u*)(P + rowg * ODD_IN + C_Z1 + h * 64 + e * 8);
                v4u w; w.x = pk2(o[8 * e + 0] * il * siluf(bflo(zw.x)), o[8 * e + 1] * il * siluf(bfhi(zw.x))); w.y = pk2(o[8 * e + 2] * il * siluf(bflo(zw.y)), o[8 * e + 3] * il * siluf(bfhi(zw.y)));
                w.z = pk2(o[8 * e + 4] * il * siluf(bflo(zw.z)), o[8 * e + 5] * il * siluf(bfhi(zw.z))); w.w = pk2(o[8 * e + 6] * il * siluf(bflo(zw.w)), o[8 * e + 7] * il * siluf(bfhi(zw.w)));
                *(v4u*)(MIX + rowg * D + h * 64 + e * 8) = w; }
        }
    }
}

__global__ void __launch_bounds__(NWAVES * 64, 2) mk_fwd(Args args) {
    extern __shared__ __attribute__((aligned(16))) unsigned char lds_raw[];
    LAS unsigned char* lds = (LAS unsigned char*)lds_raw;
    volatile LAS unsigned* MISC = (volatile LAS unsigned*)(lds + MISC_OFF);
    const int tid = threadIdx.x, lane = tid & 63, wave = __builtin_amdgcn_readfirstlane(tid >> 6);
    const int G = gridDim.x; const int bx = blockIdx.x; const int vcu = (G % 8 == 0) ? (bx % 8) * (G / 8) + bx / 8 : bx;
    unsigned char* ws = args.ws;
    gu32* ctl = (gu32*)(ws + WS_CTL);
    for (int u = tid; u < (LDS_BYTES - LDSCTL_OFF) / 4; u += NWAVES * 64) ((LAS unsigned*)(lds + LDSCTL_OFF))[u] = 0u;
    __syncthreads();
    XcdBarrier bar = xcd_barrier_post((unsigned*)(ctl + CW_BAR), MISC + 8);
    const int lo = args.ph_lo, hi = args.ph_hi;
#define IN(k) (lo <= (k) && (k) < hi)
#define GRID_BAR() xcd_barrier(bar)
    float* mod = (float*)(ws + WS_MOD);
    bf16* XN = (bf16*)(ws + WS_XN); bf16* MIX = (bf16*)(ws + WS_MIX); bf16* P = (bf16*)(ws + WS_P);

    if (IN(0)) { phase0(args, lds, tid, lane, wave, vcu, G); GRID_BAR(); }
    if (IN(1)) { phase_adaln_rows(args.in[I_X], args.in[I_NORMG], mod, XN, lane, wave, vcu, G); GRID_BAR(); }
    if (IN(2)) {
        pg8::Gemm g{XN, (const bf16*)(ws + WS_WIN0), M, EVEN_PAD, D}; pg8::StaticOrder S; S.init(M, EVEN_PAD, G, (int)blockIdx.x);
        pg8::EpiBf16 E{P, EVEN_PAD};
        pg8::gemm_phase<pg8::EpiBf16, pg8::StaticOrder, PG8_ALIGN, PG8_SP2>(lds, g, S, E);
        GRID_BAR();
    }
    if (IN(3)) { phase_rwkv(args, lds, tid, lane, wave, vcu, G); phase_gmlp(args, lds, tid, lane, wave, vcu, G); GRID_BAR(); }
    if (IN(4)) {
        pg8::Gemm g{MIX, (const bf16*)(ws + WS_WOUT0), M, D, D}; pg8::StaticOrder S; S.init(M, D, G, (int)blockIdx.x);
        pg8::EpiResGate E{args.in[I_X], args.out, mod + 2048};
        pg8::gemm_phase<pg8::EpiResGate, pg8::StaticOrder, PG8_ALIGN, PG8_SP2>(lds, g, S, E);
        GRID_BAR();
    }
    if (IN(5)) { phase_adaln_rows(args.out, args.in[I_NORMG] + D, mod + 16 * 3072, XN, lane, wave, vcu, G); GRID_BAR(); }
    if (IN(6)) {
        pg8::Gemm g{XN, (const bf16*)(ws + WS_WIN1), M, ODD_IN, D}; pg8::StaticOrder S; S.init(M, ODD_IN, G, (int)blockIdx.x);
        pg8::EpiBf16 E{P, ODD_IN};
        pg8::gemm_phase<pg8::EpiBf16, pg8::StaticOrder, PG8_ALIGN, PG8_SP2>(lds, g, S, E);
        GRID_BAR();
    }
    if (IN(7)) { phase_swa(args, lds, tid, lane, wave, vcu, G); GRID_BAR(); }
    if (IN(8)) {
        pg8::Gemm g{MIX, (const bf16*)(ws + WS_WOUT1), M, D, D}; pg8::StaticOrder S; S.init(M, D, G, (int)blockIdx.x);
        pg8::EpiResGate E{args.out, args.out, mod + 16 * 3072 + 2048};
        pg8::gemm_phase<pg8::EpiResGate, pg8::StaticOrder, PG8_ALIGN, PG8_SP2>(lds, g, S, E);
        GRID_BAR();
    }
    if (IN(9)) { phase_final_rows(args.out, args.in[I_FINALG], lane, wave, vcu, G); }
#undef IN
#undef GRID_BAR
}

extern "C" void kernel_launch(void* const* d_in, const int* in_sizes, int n_in, void* d_out, int out_size, void* d_ws, size_t ws_size, hipStream_t stream) {
    static int grid = 0;
    if (grid == 0) {
        if (n_in != N_IN || in_sizes[0] != M * D || out_size != M * D || ws_size < WS_END) { fprintf(stderr, "kernel_launch: unexpected shapes (n_in %d, in0 %d, out %d, ws %zu); nothing launched\n", n_in, n_in > 0 ? in_sizes[0] : -1, out_size, ws_size); grid = -1; return; }
        int dev = 0, cus = 0, per_cu = 0;
        if (hipGetDevice(&dev) != hipSuccess || hipDeviceGetAttribute(&cus, hipDeviceAttributeMultiprocessorCount, dev) != hipSuccess) { grid = -1; return; }
        if (hipFuncSetAttribute((const void*)mk_fwd, hipFuncAttributeMaxDynamicSharedMemorySize, LDS_BYTES) != hipSuccess) { fprintf(stderr, "kernel_launch: hipFuncSetAttribute failed\n"); grid = -1; return; }
        if (hipOccupancyMaxActiveBlocksPerMultiprocessor(&per_cu, (const void*)mk_fwd, NWAVES * 64, LDS_BYTES) != hipSuccess || per_cu < 1) fprintf(stderr, "kernel_launch: note: occupancy query reports %d\n", per_cu);
        (void)hipGetLastError();
        grid = cus;
    }
    if (grid < 0) return;
    if (hipMemsetAsync((char*)d_ws + WS_CTL, 0, CTL_ZERO_BYTES, stream) != hipSuccess) { fprintf(stderr, "kernel_launch: memset failed\n"); return; }
    Args a{};
    for (int i = 0; i < N_IN; ++i) a.in[i] = (const float*)d_in[i];
    a.out = (float*)d_out; a.ws = (unsigned char*)d_ws; a.ph_lo = 0; a.ph_hi = 10;
    hipLaunchKernelGGL(mk_fwd, dim3(grid), dim3(NWAVES * 64), LDS_BYTES, stream, a);
}
```

```cpp
#include <hip/hip_runtime.h>
#include <cstdio>
#include <cstdint>
namespace pg8 {
#define PG8_LAS __attribute__((address_space(3)))
typedef unsigned short bf16_t;
typedef short bf16x8 __attribute__((ext_vector_type(8)));
typedef float f32x4 __attribute__((ext_vector_type(4)));
typedef unsigned u32x4 __attribute__((ext_vector_type(4)));
constexpr int BM = 256, BK = 64, HALF = 128, HTB = HALF * BK * 2  , STAGE_BYTES = 8 * HTB, NXCD = 8, WGM = 8;

__host__ __device__ __forceinline__ int lds_byte(int r, int c) { const int st = (r >> 4) * 2 + (c >> 5), rr = r & 15, cc = c & 31, ob = rr * 64 + cc * 2; return st * 1024 + (ob ^ (((ob >> 9) & 1) << 5)); }
__host__ __device__ __forceinline__ void stage_rc(int b, int& R, int& C) { const int st = b / 1024, sb = b % 1024, swz = sb ^ (((sb >> 9) & 1) << 5); R = (st >> 1) * 16 + swz / 64; C = (st & 1) * 32 + (swz % 64) / 2; }
__host__ __device__ __forceinline__ int perm32(int rho) { const int n = rho >> 4, i = rho & 15; return 8 * (i >> 2) + 4 * n + (i & 3); }

struct Unit { int pm, pn; };
struct Gemm { const bf16_t* A; const bf16_t* Bt; int M, N, K; };

struct StaticOrder {
    int nM, nN, nwg, G, c;
    __host__ __device__ void init(int M, int N, int G_, int c_) { nM = M / BM; nN = N / BM; nwg = nM * nN; G = G_; c = c_; }
    __host__ __device__ bool next(int i, Unit& u) const {
        const long L = (long)i * G + c; if (L >= nwg) return false;
        int wgid = (int)L; { const int q = nwg / NXCD, r = nwg % NXCD, xcd = wgid % NXCD, off = wgid / NXCD; wgid = (xcd < r ? xcd * (q + 1) : r * (q + 1) + (xcd - r) * q) + off; }
        const int nig = WGM * nN, gid = wgid / nig, fm = gid * WGM, gsz = (nM - fm) < WGM ? (nM - fm) : WGM;
        u.pm = fm + ((wgid % nig) % gsz); u.pn = (wgid % nig) / gsz; return true;
    }
    __device__ __forceinline__ void a_ready(const Unit&) const {}
    __device__ __forceinline__ void done(const Unit&) const {}
};

__device__ __forceinline__ unsigned cvt_pk_bf16(float lo, float hi) { unsigned r; asm volatile("v_cvt_pk_bf16_f32 %0, %1, %2" : "=v"(r) : "v"(lo), "v"(hi)); return r; }
struct EpiBf16 {
    static constexpr bool PERM = true, AFTER_DRAIN = false;
    bf16_t* O; int ldc;
    __device__ __forceinline__ void operator()(const f32x4 (&acc)[2][2][4][2], const Unit& u, int wr, int wc, int fr, int fq) const {
        const int row0 = u.pm * BM + wr * 64 + fr; const int col0 = u.pn * BM + wc * 32 + 8 * fq;
#pragma unroll
        for (int ai = 0; ai < 2; ++ai)
#pragma unroll
            for (int m = 0; m < 4; ++m) { bf16_t* rowp = O + (size_t)(row0 + ai * HALF + m * 16) * ldc + col0;
#pragma unroll
                for (int bj = 0; bj < 2; ++bj) { const f32x4 v0 = acc[ai][bj][m][0], v1 = acc[ai][bj][m][1];
                    u32x4 w; w.x = cvt_pk_bf16(v0[0], v0[1]); w.y = cvt_pk_bf16(v0[2], v0[3]); w.z = cvt_pk_bf16(v1[0], v1[1]); w.w = cvt_pk_bf16(v1[2], v1[3]);
                    *(u32x4*)(rowp + bj * HALF) = w; } }
    }
};
struct EpiResGate {
    static constexpr bool PERM = false, AFTER_DRAIN = false;
    const float* base; float* out; const float* gate;
    __device__ __forceinline__ void operator()(const f32x4 (&acc)[2][2][4][2], const Unit& u, int wr, int wc, int fr, int fq) const {
        const int col0 = u.pn * BM + wc * 32 + 4 * fq; const int b = (u.pm * BM) >> 11;
        f32x4 gv[2][2];
#pragma unroll
        for (int bj = 0; bj < 2; ++bj)
#pragma unroll
            for (int n = 0; n < 2; ++n) gv[bj][n] = *(const f32x4*)(gate + (size_t)b * 3072 + col0 + bj * HALF + n * 16);
#pragma unroll
        for (int ai = 0; ai < 2; ++ai)
#pragma unroll
            for (int m = 0; m < 4; ++m) { const size_t off = (size_t)(u.pm * BM + ai * HALF + wr * 64 + m * 16 + fr) * 1024 + col0;
#pragma unroll
                for (int bj = 0; bj < 2; ++bj)
#pragma unroll
                    for (int n = 0; n < 2; ++n) { const f32x4 bs = *(const f32x4*)(base + off + bj * HALF + n * 16);
                        *(f32x4*)(out + off + bj * HALF + n * 16) = bs + gv[bj][n] * acc[ai][bj][m][n]; } }
    }
};

template <class Epi, class Sched, bool ALIGN_EPI = false, bool SP2 = false>
__device__ __forceinline__ void gemm_phase(PG8_LAS unsigned char* lds, const Gemm g, const Sched& S, const Epi& E) {
    const int tid = threadIdx.x, wid = __builtin_amdgcn_readfirstlane(tid >> 6), lane = tid & 63, wr = wid >> 2, wc = wid & 3, fr = lane & 15, fq = lane >> 4;
    const int K = g.K, nt = K / BK;
    unsigned voffA[2], voffB[2];
#pragma unroll
    for (int i = 0; i < 2; ++i) { int R, C; stage_rc(tid * 16 + i * 8192, R, C); const int Rb = Epi::PERM ? ((R & ~31) + perm32(R & 31)) : R;
        voffA[i] = (unsigned)(R * K + C) * 2u; voffB[i] = (unsigned)(Rb * K + C) * 2u; }
    const size_t kstep = (size_t)(BK * 2);
    const size_t hstep = (size_t)HALF * K * 2;
    const size_t tstep = 2 * hstep;
    const unsigned ldsw = (unsigned)wid * 1024u;
    const int aoff = lds_byte(wr * 64 + fr, fq * 8), boff = lds_byte(wc * 32 + fr, fq * 8);
#define PG8_SA(b, h) (((b) * 2 + (h)) * HTB)
#define PG8_SB(b, h) ((4 + (b) * 2 + (h)) * HTB)
#define PG8_STAGE(bufoff, gbase, voff) do { _Pragma("unroll") for (int _i = 0; _i < 2; ++_i) \
        __builtin_amdgcn_global_load_lds((const unsigned*)((const char*)(gbase) + (voff)[_i]), (PG8_LAS unsigned*)(lds + (bufoff) + ldsw + _i * 8192), 16, 0, 0); } while (0)
#define PG8_LDA(dst, b, h) do { _Pragma("unroll") for (int m = 0; m < 4; ++m) _Pragma("unroll") for (int k = 0; k < 2; ++k) dst[m][k] = *(const PG8_LAS bf16x8*)(lds + PG8_SA(b, h) + aoff + m * 2048 + k * 1024); } while (0)
#define PG8_LDB(dst, b, h) do { _Pragma("unroll") for (int n = 0; n < 2; ++n) _Pragma("unroll") for (int k = 0; k < 2; ++k) dst[n][k] = *(const PG8_LAS bf16x8*)(lds + PG8_SB(b, h) + boff + n * 2048 + k * 1024); } while (0)
#define PG8_MMA(ai, bj, At, Bt) do { __builtin_amdgcn_s_setprio(1); _Pragma("unroll") for (int m = 0; m < 4; ++m) _Pragma("unroll") for (int n = 0; n < 2; ++n) _Pragma("unroll") for (int k = 0; k < 2; ++k) \
        acc[ai][bj][m][n] = __builtin_amdgcn_mfma_f32_16x16x32_bf16(Bt[n][k], At[m][k], acc[ai][bj][m][n], 0, 0, 0); __builtin_amdgcn_s_setprio(0); } while (0)
#define PG8_WAIT_V(n) asm volatile("s_waitcnt vmcnt(" #n ")" ::: "memory")
#define PG8_WAIT_L(n) asm volatile("s_waitcnt lgkmcnt(" #n ")" ::: "memory")
#define PG8_BAR __builtin_amdgcn_s_barrier()
#define PG8_SCHED __builtin_amdgcn_sched_barrier(0)
    Unit cur, nxt; int ui = 0;
    if (!S.next(0, cur)) return;
    f32x4 acc[2][2][4][2];
#pragma unroll
    for (int a = 0; a < 2; ++a)
#pragma unroll
        for (int b = 0; b < 2; ++b)
#pragma unroll
            for (int m = 0; m < 4; ++m)
#pragma unroll
                for (int n = 0; n < 2; ++n) acc[a][b][m][n] = (f32x4){0.f, 0.f, 0.f, 0.f};
    bf16x8 At[4][2], B0[2][2], B1[2][2];
    const char* cA = (const char*)g.A + (size_t)cur.pm * tstep; const char* cB = (const char*)g.Bt + (size_t)cur.pn * tstep;
    S.a_ready(cur);
    if constexpr (SP2) {
        PG8_STAGE(PG8_SB(0, 0), cB, voffB); PG8_STAGE(PG8_SB(0, 1), cB + hstep, voffB); PG8_STAGE(PG8_SA(0, 0), cA, voffA); PG8_STAGE(PG8_SA(0, 1), cA + hstep, voffA);
        if (wr == 1) PG8_BAR;
        PG8_WAIT_V(2); PG8_BAR;
        PG8_STAGE(PG8_SB(1, 0), cB + kstep, voffB); PG8_STAGE(PG8_SA(1, 0), cA + kstep, voffA); PG8_STAGE(PG8_SB(1, 1), cB + hstep + kstep, voffB);
        PG8_WAIT_V(6); PG8_BAR;
    } else {
        PG8_STAGE(PG8_SB(0, 0), cB, voffB); PG8_STAGE(PG8_SA(0, 0), cA, voffA); PG8_STAGE(PG8_SB(0, 1), cB + hstep, voffB); PG8_STAGE(PG8_SA(0, 1), cA + hstep, voffA);
        if (wr == 1) PG8_BAR;
        PG8_WAIT_V(4); PG8_BAR;
        PG8_STAGE(PG8_SB(1, 0), cB + kstep, voffB); PG8_STAGE(PG8_SA(1, 0), cA + kstep, voffA); PG8_STAGE(PG8_SB(1, 1), cB + hstep + kstep, voffB);
        PG8_WAIT_V(6); PG8_BAR;
    }
    for (;;) {
        const bool has_next = S.next(ui + 1, nxt);
        const char* nA = has_next ? (const char*)g.A + (size_t)nxt.pm * tstep : cA; const char* nB = has_next ? (const char*)g.Bt + (size_t)nxt.pn * tstep : cB;
        for (int t = 0; t < nt; t += 2) {
            const bool last = (t == nt - 2);
            const char* a1 = cA + (size_t)(t + 1) * kstep;
            const char* a2 = last ? nA : cA + (size_t)(t + 2) * kstep; const char* b2 = last ? nB : cB + (size_t)(t + 2) * kstep;
            const char* a3 = a2 + kstep; const char* b3 = b2 + kstep;
            if (last && has_next) S.a_ready(nxt);
            if constexpr (SP2) {
            PG8_LDB(B0, 0, 0); PG8_LDB(B1, 0, 1); PG8_SCHED; PG8_LDA(At, 0, 0); PG8_STAGE(PG8_SA(1, 1), a1 + hstep, voffA);
            PG8_WAIT_V(8); PG8_WAIT_L(0); PG8_BAR; PG8_MMA(0, 0, At, B0); PG8_MMA(0, 1, At, B1); PG8_BAR; PG8_SCHED;
            PG8_LDA(At, 0, 1); PG8_STAGE(PG8_SB(0, 0), b2, voffB); PG8_STAGE(PG8_SB(0, 1), b2 + hstep, voffB); PG8_STAGE(PG8_SA(0, 0), a2, voffA);
            PG8_WAIT_V(8); PG8_WAIT_L(0); PG8_BAR; PG8_MMA(1, 0, At, B0); PG8_MMA(1, 1, At, B1); PG8_BAR; PG8_SCHED;
            PG8_LDB(B0, 1, 0); PG8_LDB(B1, 1, 1); PG8_SCHED; PG8_LDA(At, 1, 0); PG8_STAGE(PG8_SA(0, 1), a2 + hstep, voffA);
            PG8_WAIT_V(8); PG8_WAIT_L(0); PG8_BAR; PG8_MMA(0, 0, At, B0); PG8_MMA(0, 1, At, B1); PG8_BAR; PG8_SCHED;
            PG8_LDA(At, 1, 1); PG8_STAGE(PG8_SB(1, 0), b3, voffB); PG8_STAGE(PG8_SB(1, 1), b3 + hstep, voffB); PG8_STAGE(PG8_SA(1, 0), a3, voffA);
            PG8_WAIT_V(8); PG8_WAIT_L(0); PG8_BAR; PG8_MMA(1, 0, At, B0); PG8_MMA(1, 1, At, B1); PG8_BAR; PG8_SCHED;
            } else {
            PG8_LDB(B0, 0, 0); PG8_SCHED; PG8_LDA(At, 0, 0); PG8_STAGE(PG8_SA(1, 1), a1 + hstep, voffA);
            PG8_WAIT_L(8); PG8_BAR; PG8_WAIT_L(0); PG8_MMA(0, 0, At, B0); PG8_BAR; PG8_SCHED;
            PG8_LDB(B1, 0, 1); PG8_STAGE(PG8_SB(0, 0), b2, voffB);
            PG8_BAR; PG8_WAIT_L(0); PG8_MMA(0, 1, At, B1); PG8_BAR;
            PG8_LDA(At, 0, 1); PG8_STAGE(PG8_SA(0, 0), a2, voffA);
            PG8_BAR; PG8_WAIT_L(0); PG8_MMA(1, 0, At, B0); PG8_BAR; PG8_SCHED;
            PG8_STAGE(PG8_SB(0, 1), b2 + hstep, voffB);
            PG8_WAIT_V(6); PG8_BAR; PG8_MMA(1, 1, At, B1); PG8_BAR;
            PG8_LDB(B0, 1, 0); PG8_SCHED; PG8_LDA(At, 1, 0); PG8_STAGE(PG8_SA(0, 1), a2 + hstep, voffA);
            PG8_WAIT_L(8); PG8_BAR; PG8_WAIT_L(0); PG8_MMA(0, 0, At, B0); PG8_BAR; PG8_SCHED;
            PG8_LDB(B1, 1, 1); PG8_STAGE(PG8_SB(1, 0), b3, voffB);
            PG8_BAR; PG8_WAIT_L(0); PG8_MMA(0, 1, At, B1); PG8_BAR;
            PG8_LDA(At, 1, 1); PG8_STAGE(PG8_SA(1, 0), a3, voffA);
            PG8_BAR; PG8_WAIT_L(0); PG8_MMA(1, 0, At, B0); PG8_BAR; PG8_SCHED;
            PG8_STAGE(PG8_SB(1, 1), b3 + hstep, voffB);
            PG8_WAIT_V(6); PG8_BAR; PG8_MMA(1, 1, At, B1); PG8_BAR;
            }
        }
        if constexpr (ALIGN_EPI) { if (wr == 0) PG8_BAR; }
        if constexpr (!Epi::AFTER_DRAIN) { E(acc, cur, wr, wc, fr, fq); S.done(cur); }
        if (!has_next) break;
#pragma unroll
        for (int a = 0; a < 2; ++a)
#pragma unroll
            for (int b = 0; b < 2; ++b)
#pragma unroll
                for (int m = 0; m < 4; ++m)
#pragma unroll
                    for (int n = 0; n < 2; ++n) acc[a][b][m][n] = (f32x4){0.f, 0.f, 0.f, 0.f};
        cur = nxt; cA = nA; cB = nB; ++ui;
        if constexpr (ALIGN_EPI) { if (wr == 1) PG8_BAR; }
    }
    PG8_WAIT_V(0);
    if constexpr (!ALIGN_EPI) { if (wr == 0) PG8_BAR; }
    PG8_BAR;
    if constexpr (Epi::AFTER_DRAIN) { E.fused(acc, cur, wr, wc, fr, fq, lds, wid, lane); S.done(cur); }
#undef PG8_SA
#undef PG8_SB
#undef PG8_STAGE
#undef PG8_LDA
#undef PG8_LDB
#undef PG8_MMA
#undef PG8_WAIT_V
#undef PG8_WAIT_L
#undef PG8_BAR
#undef PG8_SCHED
}
}

#ifndef PG8_SP2
#define PG8_SP2 true
#endif
#ifndef PG8_ALIGN
#define PG8_ALIGN true
#endif
#define GAS __attribute__((address_space(1)))
#define LAS __attribute__((address_space(3)))
typedef unsigned short bf16;
typedef unsigned v4u __attribute__((ext_vector_type(4)));
typedef float f32x4 __attribute__((ext_vector_type(4)));
typedef short bf16x8 __attribute__((ext_vector_type(8)));
typedef GAS unsigned gu32;
typedef GAS unsigned long long gu64;
#define RLX_AGENT __ATOMIC_RELAXED, __HIP_MEMORY_SCOPE_AGENT
#define LDS_WAIT() asm volatile("s_waitcnt lgkmcnt(0)" ::: "memory")
#define VM_WAIT() asm volatile("s_waitcnt vmcnt(0)" ::: "memory")
__device__ __forceinline__ unsigned long long rt() { return __builtin_amdgcn_s_memrealtime(); }
__device__ __forceinline__ unsigned f2bf(float f) { unsigned u = __builtin_bit_cast(unsigned, f); return (u + 0x7fffu + ((u >> 16) & 1u)) >> 16; }
__device__ __forceinline__ unsigned pk2(float lo, float hi) { return f2bf(lo) | (f2bf(hi) << 16); }

#define XB_TMO      128
#define XB_XCNT(j)  (256  + 64 * (j))
#define XB_XSUB(j)  (1280 + 64 * (j))
#define XB_XGEN(j)  (2304 + 64 * (j))
#define XB_TOP      3328
#define XB_TOPGEN   3392
#define XCD_BAR_WORDS 3456
#define XB_SPIN_CAP (1u << 22)

__device__ __forceinline__ unsigned xb_ld(unsigned* p)              { return __hip_atomic_load(p, __ATOMIC_RELAXED, __HIP_MEMORY_SCOPE_AGENT); }
__device__ __forceinline__ unsigned xb_add(unsigned* p, unsigned v) { return __hip_atomic_fetch_add(p, v, __ATOMIC_RELAXED, __HIP_MEMORY_SCOPE_AGENT); }
__device__ __forceinline__ unsigned xb_xcc_id() { return (unsigned)__builtin_amdgcn_s_getreg((3 << 11) | 20) & 0xFu; }
#define XB_SPIN(cond, bar) do { unsigned _sp = 0; while (cond) { __builtin_amdgcn_s_sleep(1); \
    if ((++_sp & 255u) == 0u) { if (xb_ld(&(bar)[XB_TMO])) break; if (_sp > XB_SPIN_CAP) { atomicAdd(&(bar)[XB_TMO], 1u); break; } } } } while (0)

struct XcdBarrier {
    unsigned* bar; unsigned x;
    volatile LAS unsigned* st;
};

__device__ __forceinline__ XcdBarrier xcd_barrier_post(unsigned* bar, volatile LAS unsigned* st) {
    XcdBarrier b; b.bar = bar; b.x = xb_xcc_id(); b.st = st;
    if (threadIdx.x == 0) (void)xb_add(&bar[XB_XCNT(b.x)], 1u);
    return b;
}
__device__ __forceinline__ void xcd_barrier_complete(unsigned* bar, unsigned x, unsigned& nloc, unsigned& nx) {
    const unsigned G = gridDim.x * gridDim.y * gridDim.z;
    unsigned sum, cnt, mine, sp = 0u;
    for (;;) {
        sum = 0u; cnt = 0u; mine = 0u;
#pragma unroll
        for (unsigned j = 0; j < 16; ++j) { const unsigned c = xb_ld(&bar[XB_XCNT(j)]); sum += c; cnt += (c > 0u) ? 1u : 0u; mine = (j == x) ? c : mine; }
        if (sum == G) break;
        __builtin_amdgcn_s_sleep(1);
        if ((++sp & 255u) == 0u) { if (xb_ld(&bar[XB_TMO])) break; if (sp > XB_SPIN_CAP) { atomicAdd(&bar[XB_TMO], 1u); break; } }
    }
    nloc = mine > 0u ? mine : 1u; nx = cnt > 0u ? cnt : 1u;
}

__device__ __forceinline__ void xcd_barrier(const XcdBarrier& b) {
    asm volatile("s_waitcnt vmcnt(0)" ::: "memory");
    __syncthreads();
    if (threadIdx.x == 0) {
        unsigned* bar = b.bar;
        __builtin_amdgcn_s_waitcnt(0);
        unsigned nloc = b.st[0], nx = b.st[1];
        if (nloc == 0u) { xcd_barrier_complete(bar, b.x, nloc, nx); b.st[0] = nloc; b.st[1] = nx; }
        const unsigned old = xb_add(&bar[XB_XSUB(b.x)], 1u);
        const unsigned gen = old / nloc;
        if (old + 1u == (gen + 1u) * nloc) {
            __builtin_amdgcn_fence(__ATOMIC_RELEASE, "agent");
            asm volatile("s_waitcnt vmcnt(0)" ::: "memory");
            const unsigned og = xb_add(&bar[XB_TOP], 1u);
            const unsigned tg = og / nx;
            if (og + 1u == (tg + 1u) * nx) xb_add(&bar[XB_TOPGEN], 1u);
            else XB_SPIN(xb_ld(&bar[XB_TOPGEN]) == tg, bar);
            __builtin_amdgcn_fence(__ATOMIC_ACQUIRE, "agent");
            xb_add(&bar[XB_XGEN(b.x)], 1u);
            asm volatile("s_waitcnt vmcnt(0)" ::: "memory");
        } else {
            XB_SPIN(xb_ld(&bar[XB_XGEN(b.x)]) == gen, bar);
            __builtin_amdgcn_fence(__ATOMIC_ACQUIRE, "agent");
            asm volatile("s_waitcnt vmcnt(0)" ::: "memory");
        }
    }
    __syncthreads();
}


constexpr int NWAVES = 8;
constexpr int BATCH = 16, SEQ = 2048, D = 1024, M = BATCH * SEQ;
constexpr int EVEN_IN = 3712, EVEN_PAD = 3840, ODD_IN = 2304;
constexpr int C_R = 0, C_K = 512, C_V = 1024, C_WLO = 1536, C_ALO = 1600, C_U = 1664, C_VG = 2176, C_Z0 = 2688;
constexpr int C_Q = 0, C_KC = 1024, C_VC = 1152, C_Z1 = 1280;
enum { I_X = 0, I_C, I_ADAW, I_ADAB, I_NORMG, I_EWIN, I_EMU, I_EW0, I_EWUP, I_EA0, I_EAUP, I_EKK, I_EKA, I_ERK, I_ELNXG, I_ELNXB, I_ESGLNG, I_ESGLNB, I_ESGW, I_ESGB, I_EWOUT, I_OWIN, I_OSINKS, I_OWOUT, I_FINALG, N_IN };

constexpr size_t MiB = 1u << 20;
constexpr size_t WS_CTL = 0, CTL_ZERO_BYTES = 64 * 1024;
constexpr size_t WS_MOD = 1 * MiB;
constexpr size_t WS_WIN0 = 2 * MiB, WS_WOUT0 = 10 * MiB, WS_WIN1 = 12 * MiB, WS_WOUT1 = 17 * MiB;
constexpr size_t WS_XN = 32 * MiB, WS_MIX = 96 * MiB, WS_P = 160 * MiB, WS_YRAW = 400 * MiB, WS_BON = 464 * MiB, WS_END = 466 * MiB;
constexpr int CW_BAR = 4096;

constexpr int RING_BYTES = 131072, LDSCTL_OFF = RING_BYTES, MISC_OFF = LDSCTL_OFF + 320, LDS_BYTES = 147456;

__device__ __forceinline__ float bf2f(unsigned short h) { return __builtin_bit_cast(float, (unsigned)h << 16); }
__device__ __forceinline__ float bflo(unsigned w) { return __builtin_bit_cast(float, w << 16); }
__device__ __forceinline__ float bfhi(unsigned w) { return __builtin_bit_cast(float, w & 0xffff0000u); }
__device__ __forceinline__ float wave_sum(float v) {
#pragma unroll
    for (int o = 1; o < 64; o <<= 1) v += __shfl_xor(v, o);
    return v;
}
__device__ __forceinline__ float siluf(float x) { return x / (1.f + __expf(-x)); }

struct Args { const float* in[N_IN]; float* out; unsigned char* ws; int ph_lo, ph_hi; };

__device__ __forceinline__ void p0_transpose_item(const float* W, int K, int N, bf16* WT, LAS float* scr, int item, int lane) {
    const int nblk = N / 32, kb = item / nblk, nb = item % nblk, k0 = 64 * kb, n0 = 32 * nb;
#pragma unroll 8
    for (int i = 0; i < 32; ++i) { const int kk = 2 * i + (lane >> 5); scr[kk * 33 + (lane & 31)] = W[(size_t)(k0 + kk) * N + n0 + (lane & 31)]; }
    LDS_WAIT(); asm volatile("" ::: "memory");
    const int c = lane & 7;
#pragma unroll
    for (int j = 0; j < 4; ++j) { const int n = (lane >> 3) + 8 * j; const LAS float* s = scr + (8 * c) * 33 + n;
        v4u o; o.x = pk2(s[0 * 33], s[1 * 33]); o.y = pk2(s[2 * 33], s[3 * 33]); o.z = pk2(s[4 * 33], s[5 * 33]); o.w = pk2(s[6 * 33], s[7 * 33]);
        *(GAS v4u*)(WT + (size_t)(n0 + n) * K + k0 + 8 * c) = o; }
    LDS_WAIT(); asm volatile("" ::: "memory");
}
__device__ __forceinline__ void phase0(const Args& a, LAS unsigned char* lds, int tid, int lane, int wave, int vcu, int G) {
    unsigned char* ws = a.ws;
    if (vcu < 96) {
        LAS float* condT = (LAS float*)lds;
        LAS float* part = (LAS float*)(lds + 65536);
        const float* c = a.in[I_C];
        for (int idx = tid; idx < 16384; idx += 512) { const int b = idx >> 10, k = idx & 1023; condT[k * 16 + b] = siluf(c[idx]); }
        __syncthreads();
        for (int it = vcu; it < 96; it += G) {
            const int l = it / 48, n0 = (it % 48) * 64;
            const float* W = a.in[I_ADAW] + (size_t)l * 1024 * 3072 + n0 + lane;
            float acc[16];
#pragma unroll
            for (int b = 0; b < 16; ++b) acc[b] = 0.f;
            const int kbeg = wave * 128;
#pragma unroll 4
            for (int k = kbeg; k < kbeg + 128; ++k) {
                const float w = W[(size_t)k * 3072];
                const LAS f32x4* cv = (const LAS f32x4*)(condT + k * 16);
                const f32x4 c0 = cv[0], c1 = cv[1], c2 = cv[2], c3 = cv[3];
                acc[0] += c0[0] * w; acc[1] += c0[1] * w; acc[2] += c0[2] * w; acc[3] += c0[3] * w;
                acc[4] += c1[0] * w; acc[5] += c1[1] * w; acc[6] += c1[2] * w; acc[7] += c1[3] * w;
                acc[8] += c2[0] * w; acc[9] += c2[1] * w; acc[10] += c2[2] * w; acc[11] += c2[3] * w;
                acc[12] += c3[0] * w; acc[13] += c3[1] * w; acc[14] += c3[2] * w; acc[15] += c3[3] * w;
            }
#pragma unroll
            for (int b = 0; b < 16; ++b) part[(wave * 16 + b) * 64 + lane] = acc[b];
            __syncthreads();
            float* mod = (float*)(ws + WS_MOD);
#pragma unroll
            for (int q = 0; q < 2; ++q) { const int b = (tid >> 6) + 8 * q; float s = 0.f;
#pragma unroll
                for (int w8 = 0; w8 < 8; ++w8) s += part[(w8 * 16 + b) * 64 + lane];
                mod[(size_t)(l * 16 + b) * 3072 + n0 + lane] = s + a.in[I_ADAB][l * 3072 + n0 + lane]; }
            __syncthreads();
        }
    }
    __syncthreads();
    LAS float* scr = (LAS float*)(lds + wave * 16384);
    const int gw = vcu * NWAVES + wave, NGW = G * NWAVES;
    constexpr int I0 = (D / 64) * (EVEN_IN / 32), I1 = (D / 64) * (D / 32), I2 = (D / 64) * (ODD_IN / 32), I3 = I1, IZ = EVEN_PAD - EVEN_IN;
    for (int it = gw; it < I0 + I1 + I2 + I3 + IZ; it += NGW) {
        int r = it;
        if (r < I0) { p0_transpose_item(a.in[I_EWIN], D, EVEN_IN, (bf16*)(ws + WS_WIN0), scr, r, lane); continue; } r -= I0;
        if (r < I1) { p0_transpose_item(a.in[I_EWOUT], D, D, (bf16*)(ws + WS_WOUT0), scr, r, lane); continue; } r -= I1;
        if (r < I2) { p0_transpose_item(a.in[I_OWIN], D, ODD_IN, (bf16*)(ws + WS_WIN1), scr, r, lane); continue; } r -= I2;
        if (r < I3) { p0_transpose_item(a.in[I_OWOUT], D, D, (bf16*)(ws + WS_WOUT1), scr, r, lane); continue; } r -= I3;
        { GAS v4u* o = (GAS v4u*)((bf16*)(ws + WS_WIN0) + (size_t)(EVEN_IN + r) * D); const v4u z = {0u, 0u, 0u, 0u}; o[lane] = z; o[lane + 64] = z; }
    }
}

__device__ __forceinline__ void phase_adaln_rows(const float* xin, const float* g, const float* modl, bf16* XN, int lane, int wave, int vcu, int G) {
    const int gw = vcu * NWAVES + wave, NGW = G * NWAVES;
    for (int r0 = gw * 16; r0 < M; r0 += NGW * 16) {
        const int b = r0 >> 11;
        f32x4 gs[4], sh[4];
#pragma unroll
        for (int j = 0; j < 4; ++j) { const int c = 4 * lane + 256 * j;
            const f32x4 gg = *(const f32x4*)(g + c), sc = *(const f32x4*)(modl + (size_t)b * 3072 + 1024 + c);
            gs[j] = gg * (sc + 1.0f); sh[j] = *(const f32x4*)(modl + (size_t)b * 3072 + c); }
        for (int r = r0; r < r0 + 16; ++r) {
            const GAS f32x4* xr = (const GAS f32x4*)(xin + (size_t)r * D) + lane;
            f32x4 v[4]; float s = 0.f;
#pragma unroll
            for (int j = 0; j < 4; ++j) { v[j] = xr[64 * j]; s += (v[j].x * v[j].x + v[j].y * v[j].y) + (v[j].z * v[j].z + v[j].w * v[j].w); }
            const float rs = 1.0f / sqrtf(wave_sum(s) * (1.f / D) + 1e-6f);
            GAS unsigned long long* o8 = (GAS unsigned long long*)(XN + (size_t)r * D) + lane;
#pragma unroll
            for (int j = 0; j < 4; ++j) { const f32x4 o = v[j] * rs * gs[j] + sh[j];
                o8[64 * j] = (unsigned long long)pk2(o.x, o.y) | ((unsigned long long)pk2(o.z, o.w) << 32); }
        }
    }
}
__device__ __forceinline__ void phase_final_rows(float* xio, const float* g, int lane, int wave, int vcu, int G) {
    const int gw = vcu * NWAVES + wave, NGW = G * NWAVES;
    f32x4 gs[4];
#pragma unroll
    for (int j = 0; j < 4; ++j) gs[j] = *(const f32x4*)(g + 4 * lane + 256 * j);
    for (int r = gw; r < M; r += NGW) {
        GAS f32x4* xr = (GAS f32x4*)(xio + (size_t)r * D) + lane;
        f32x4 v[4]; float s = 0.f;
#pragma unroll
        for (int j = 0; j < 4; ++j) { v[j] = xr[64 * j]; s += (v[j].x * v[j].x + v[j].y * v[j].y) + (v[j].z * v[j].z + v[j].w * v[j].w); }
        const float rs = 1.0f / sqrtf(wave_sum(s) * (1.f / D) + 1e-6f);
#pragma unroll
        for (int j = 0; j < 4; ++j) xr[64 * j] = v[j] * rs * gs[j];
    }
}

__device__ __forceinline__ void phase_rwkv(const Args& a, LAS unsigned char* lds, int tid, int lane, int wave, int vcu, int G) {
    const bf16* P = (const bf16*)(a.ws + WS_P); bf16* MIX = (bf16*)(a.ws + WS_MIX);
    LAS float* WUP = (LAS float*)lds;
    LAS float* AUP = WUP + 4096;
    LAS float* TW = AUP + 4096;
    LAS float* AL = TW + 2048;
    LAS float* Rr = AL + 2048;
    LAS float* KR = Rr + 2048;
    LAS float* Vv = KR + 2048;
    LAS float* Wd = Vv + 2048;
    LAS float* KK = Wd + 2048;
    LAS float* Bb = KK + 2048;
    LAS float* Yy = Bb + 2048;
    LAS float* BON = Yy + 2048;
    for (int unit = vcu; unit < BATCH * 8; unit += G) {
        const int b = unit >> 3, h = unit & 7;
        __syncthreads();
        for (int idx = tid; idx < 4096; idx += 512) { const int m = idx >> 6, j = idx & 63; WUP[idx] = a.in[I_EWUP][m * 512 + h * 64 + j]; AUP[idx] = a.in[I_EAUP][m * 512 + h * 64 + j]; }
        float S[8];
#pragma unroll
        for (int j = 0; j < 8; ++j) S[j] = 0.f;
        const int hj = h * 64 + lane;
        const float w0 = a.in[I_EW0][hj], a0 = a.in[I_EA0][hj], k_k = a.in[I_EKK][hj], k_a = a.in[I_EKA][hj], r_k = a.in[I_ERK][hj], lng = a.in[I_ELNXG][hj], lnb = a.in[I_ELNXB][hj];
        for (int ck = 0; ck < SEQ / 32; ++ck) {
            const int t0 = ck * 32;
            { const int i = tid >> 4, sub = tid & 15; const int t = t0 + i; const bf16* pc = P + (size_t)(b * SEQ + t) * EVEN_PAD; const bf16* pp = pc - EVEN_PAD; const bool hasp = t > 0;
#pragma unroll
              for (int grp = 0; grp < 5; ++grp) {
                  const int col = (grp == 0 ? C_R + h * 64 : grp == 1 ? C_K + h * 64 : grp == 2 ? C_V + h * 64 : grp == 3 ? C_WLO : C_ALO) + 4 * sub;
                  const uint2 cu = *(const uint2*)(pc + col); uint2 pu = {0u, 0u}; if (hasp) pu = *(const uint2*)(pp + col);
                  const f32x4 mu = *(const f32x4*)(a.in[I_EMU] + col);
                  float cv[4] = {bflo(cu.x), bfhi(cu.x), bflo(cu.y), bfhi(cu.y)}, pv[4] = {bflo(pu.x), bfhi(pu.x), bflo(pu.y), bfhi(pu.y)};
                  f32x4 xs;
#pragma unroll
                  for (int e = 0; e < 4; ++e) xs[e] = cv[e] + mu[e] * (pv[e] - cv[e]);
                  if (grp == 3) { xs[0] = tanhf(xs[0]); xs[1] = tanhf(xs[1]); xs[2] = tanhf(xs[2]); xs[3] = tanhf(xs[3]); }
                  LAS float* dst = (grp == 0 ? Rr : grp == 1 ? KR : grp == 2 ? Vv : grp == 3 ? TW : AL) + i * 64 + 4 * sub;
                  *(LAS f32x4*)dst = xs;
              } }
            __syncthreads();
            { float accw[4] = {0.f, 0.f, 0.f, 0.f}, acca[4] = {0.f, 0.f, 0.f, 0.f};
              for (int m4 = 0; m4 < 16; ++m4) {
                  f32x4 tw[4], al[4];
#pragma unroll
                  for (int q = 0; q < 4; ++q) { tw[q] = *(const LAS f32x4*)(TW + (wave + 8 * q) * 64 + 4 * m4); al[q] = *(const LAS f32x4*)(AL + (wave + 8 * q) * 64 + 4 * m4); }
#pragma unroll
                  for (int e = 0; e < 4; ++e) { const float wu = WUP[(4 * m4 + e) * 64 + lane], au = AUP[(4 * m4 + e) * 64 + lane];
#pragma unroll
                      for (int q = 0; q < 4; ++q) { accw[q] += tw[q][e] * wu; acca[q] += al[q][e] * au; } }
              }
#pragma unroll
              for (int q = 0; q < 4; ++q) { const int i = wave + 8 * q;
                  const float wv = w0 + accw[q];
                  const float nx = -wv; const float sp = fmaxf(nx, 0.f) + log1pf(__expf(-fabsf(nx)));
                  const float wl = -sp - 0.5f; const float decay = __expf(-__expf(wl));
                  const float av = 1.f / (1.f + __expf(-(a0 + acca[q])));
                  const float kraw = KR[i * 64 + lane]; const float kkv = kraw * k_k;
                  const float ss = wave_sum(kkv * kkv); const float kk = kkv / fmaxf(sqrtf(ss), 1e-12f);
                  const float kp = kraw * (1.f + (av - 1.f) * k_a);
                  const float bon = wave_sum(Rr[i * 64 + lane] * kp * r_k);
                  Wd[i * 64 + lane] = decay; KR[i * 64 + lane] = kp; KK[i * 64 + lane] = kk; Bb[i * 64 + lane] = kk * av; if (lane == 0) BON[i] = bon; } }
            __syncthreads();
            { const int row = wave * 8 + (lane >> 3), c8 = (lane & 7) * 8;
              for (int i = 0; i < 32; ++i) {
                  const f32x4 k0 = *(const LAS f32x4*)(KK + i * 64 + c8), k1 = *(const LAS f32x4*)(KK + i * 64 + c8 + 4);
                  const f32x4 w0v = *(const LAS f32x4*)(Wd + i * 64 + c8), w1v = *(const LAS f32x4*)(Wd + i * 64 + c8 + 4);
                  const f32x4 b0 = *(const LAS f32x4*)(Bb + i * 64 + c8), b1 = *(const LAS f32x4*)(Bb + i * 64 + c8 + 4);
                  const f32x4 p0 = *(const LAS f32x4*)(KR + i * 64 + c8), p1 = *(const LAS f32x4*)(KR + i * 64 + c8 + 4);
                  const f32x4 r0 = *(const LAS f32x4*)(Rr + i * 64 + c8), r1 = *(const LAS f32x4*)(Rr + i * 64 + c8 + 4);
                  const float vv = Vv[i * 64 + row];
                  float sa = (S[0] * k0[0] + S[1] * k0[1]) + (S[2] * k0[2] + S[3] * k0[3]) + (S[4] * k1[0] + S[5] * k1[1]) + (S[6] * k1[2] + S[7] * k1[3]);
                  sa += __shfl_xor(sa, 1); sa += __shfl_xor(sa, 2); sa += __shfl_xor(sa, 4); sa = -sa;
                  S[0] = S[0] * w0v[0] + sa * b0[0] + vv * p0[0]; S[1] = S[1] * w0v[1] + sa * b0[1] + vv * p0[1];
                  S[2] = S[2] * w0v[2] + sa * b0[2] + vv * p0[2]; S[3] = S[3] * w0v[3] + sa * b0[3] + vv * p0[3];
                  S[4] = S[4] * w1v[0] + sa * b1[0] + vv * p1[0]; S[5] = S[5] * w1v[1] + sa * b1[1] + vv * p1[1];
                  S[6] = S[6] * w1v[2] + sa * b1[2] + vv * p1[2]; S[7] = S[7] * w1v[3] + sa * b1[3] + vv * p1[3];
                  float y = (S[0] * r0[0] + S[1] * r0[1]) + (S[2] * r0[2] + S[3] * r0[3]) + (S[4] * r1[0] + S[5] * r1[1]) + (S[6] * r1[2] + S[7] * r1[3]);
                  y += __shfl_xor(y, 1); y += __shfl_xor(y, 2); y += __shfl_xor(y, 4);
                  if ((lane & 7) == 0) Yy[i * 64 + row] = y;
              } }
            __syncthreads();
#pragma unroll
            for (int q = 0; q < 4; ++q) { const int i = wave * 4 + q; const size_t rowg = (size_t)(b * SEQ + t0 + i);
                const float y = Yy[i * 64 + lane]; const float mean = wave_sum(y) * (1.f / 64.f); const float d = y - mean; const float var = wave_sum(d * d) * (1.f / 64.f);
                const float o = d * (1.0f / sqrtf(var + 64e-5f)) * lng + lnb + BON[i] * Vv[i * 64 + lane];
                const float z = bf2f(P[rowg * EVEN_PAD + C_Z0 + hj]);
                MIX[rowg * D + hj] = (bf16)f2bf(o * siluf(z)); }
            __syncthreads();
        }
    }
}

typedef unsigned u32x2 __attribute__((ext_vector_type(2)));
#define DPP_ADD(x, ctrl) x += __builtin_bit_cast(float, __builtin_amdgcn_update_dpp(0, __builtin_bit_cast(int, x), ctrl, 0xF, 0xF, true))
__device__ __forceinline__ float row_sum16(float x) { DPP_ADD(x, 0xB1); DPP_ADD(x, 0x4E); DPP_ADD(x, 0x124); DPP_ADD(x, 0x128); return x; }
__device__ __forceinline__ void split_bf(float x, unsigned& hi, unsigned& lo) { hi = f2bf(x); lo = f2bf(x - __builtin_bit_cast(float, hi << 16)); }
__device__ __forceinline__ float wave_sum_fast(float x) { x = row_sum16(x);
    const int xi = __builtin_bit_cast(int, x);
    return (__builtin_bit_cast(float, __builtin_amdgcn_readlane(xi, 0)) + __builtin_bit_cast(float, __builtin_amdgcn_readlane(xi, 16))) + (__builtin_bit_cast(float, __builtin_amdgcn_readlane(xi, 32)) + __builtin_bit_cast(float, __builtin_amdgcn_readlane(xi, 48))); }
__device__ __forceinline__ float fast_tanh(float x) { const float t = __expf(2.f * x); return 1.f - 2.f * __builtin_amdgcn_rcpf(t + 1.f); }
__device__ __forceinline__ void phase_rwkv2(const Args& a, LAS unsigned char* lds, int tid, int lane, int wave, int vcu, int G) {
    const bf16* P = (const bf16*)(a.ws + WS_P); float* YRAW = (float*)(a.ws + WS_YRAW); float* BONG = (float*)(a.ws + WS_BON);
    LAS float* Rr = (LAS float*)lds;
    LAS float* KR = Rr + 2048;
    LAS float* KK = KR + 2048;
    LAS float* Wd = KK + 2048;
    LAS float* Bb = Wd + 2048;
    LAS float* Vv = (LAS float*)(lds + 40960);
    LAS float* Yy = (LAS float*)(lds + 45056);
    LAS bf16* TWh = (LAS bf16*)(lds + 49152);
    LAS bf16* TWl = TWh + 32 * 72;
    LAS bf16* ALh = TWl + 32 * 72;
    LAS bf16* ALl = ALh + 32 * 72;
    LAS bf16* WUh = (LAS bf16*)(lds + 67584);
    LAS bf16* WUl = WUh + 64 * 72;
    LAS bf16* AUh = WUl + 64 * 72;
    LAS bf16* AUl = AUh + 64 * 72;
    for (int unit = vcu; unit < BATCH * 16; unit += G) {
        const int bh = unit >> 1, half = unit & 1, b = bh >> 3, h = bh & 7;
        __syncthreads();
        for (int idx = tid; idx < 4096; idx += 512) { const int m = idx >> 6, j = idx & 63; unsigned hi, lo;
            split_bf(a.in[I_EWUP][m * 512 + h * 64 + j], hi, lo); WUh[j * 72 + m] = (bf16)hi; WUl[j * 72 + m] = (bf16)lo;
            split_bf(a.in[I_EAUP][m * 512 + h * 64 + j], hi, lo); AUh[j * 72 + m] = (bf16)hi; AUl[j * 72 + m] = (bf16)lo; }
        float S[4] = {0.f, 0.f, 0.f, 0.f};
        const int hj = h * 64 + lane;
        const float w0 = a.in[I_EW0][hj], a0 = a.in[I_EA0][hj], k_k = a.in[I_EKK][hj], k_a = a.in[I_EKA][hj], r_k = a.in[I_ERK][hj];
        const int c4 = (lane & 15) * 4, rowl = wave * 4 + (lane >> 4);
        const int i1 = tid >> 4, sub = tid & 15;
        const int col0 = C_R + h * 64 + 4 * sub, col1 = C_K + h * 64 + 4 * sub, col2 = C_V + h * 64 + 4 * sub, col3 = C_WLO + 4 * sub, col4 = C_ALO + 4 * sub;
        const f32x4 mu0 = *(const f32x4*)(a.in[I_EMU] + col0), mu1 = *(const f32x4*)(a.in[I_EMU] + col1), mu2 = *(const f32x4*)(a.in[I_EMU] + col2), mu3 = *(const f32x4*)(a.in[I_EMU] + col3), mu4 = *(const f32x4*)(a.in[I_EMU] + col4);
        const bf16* prow = P + (size_t)(b * SEQ + i1) * EVEN_PAD;
        u32x2 c0v, c1v, c2v, c3v, c4v, p0v, p1v, p2v, p3v, p4v;
#define RW_PREFETCH(t0_) do { const bf16* pc_ = prow + (size_t)(t0_) * EVEN_PAD; \
            c0v = *(const u32x2*)(pc_ + col0); c1v = *(const u32x2*)(pc_ + col1); c2v = *(const u32x2*)(pc_ + col2); c3v = *(const u32x2*)(pc_ + col3); c4v = *(const u32x2*)(pc_ + col4); \
            if ((t0_) + i1 > 0) { const bf16* pp_ = pc_ - EVEN_PAD; p0v = *(const u32x2*)(pp_ + col0); p1v = *(const u32x2*)(pp_ + col1); p2v = *(const u32x2*)(pp_ + col2); p3v = *(const u32x2*)(pp_ + col3); p4v = *(const u32x2*)(pp_ + col4); } \
            else { p0v = (u32x2){0u, 0u}; p1v = p0v; p2v = p0v; p3v = p0v; p4v = p0v; } } while (0)
#define RW_XS(cv_, pv_, mu_) ({ f32x4 x_; const float a0_ = bflo(cv_.x), a1_ = bfhi(cv_.x), a2_ = bflo(cv_.y), a3_ = bfhi(cv_.y); \
            x_[0] = a0_ + mu_[0] * (bflo(pv_.x) - a0_); x_[1] = a1_ + mu_[1] * (bfhi(pv_.x) - a1_); x_[2] = a2_ + mu_[2] * (bflo(pv_.y) - a2_); x_[3] = a3_ + mu_[3] * (bfhi(pv_.y) - a3_); x_; })
        RW_PREFETCH(0);
        for (int ck = 0; ck < SEQ / 32; ++ck) {
            const int t0 = ck * 32;
            { *(LAS f32x4*)(Rr + i1 * 64 + 4 * sub) = RW_XS(c0v, p0v, mu0);
              *(LAS f32x4*)(KR + i1 * 64 + 4 * sub) = RW_XS(c1v, p1v, mu1);
              { const f32x4 xv = RW_XS(c2v, p2v, mu2); if ((sub >> 3) == half) *(LAS f32x4*)(Vv + i1 * 32 + 4 * (sub & 7)) = xv; }
              { f32x4 xs = RW_XS(c3v, p3v, mu3); xs[0] = fast_tanh(xs[0]); xs[1] = fast_tanh(xs[1]); xs[2] = fast_tanh(xs[2]); xs[3] = fast_tanh(xs[3]);
                unsigned h0, l0, h1, l1, h2, l2, h3, l3; split_bf(xs[0], h0, l0); split_bf(xs[1], h1, l1); split_bf(xs[2], h2, l2); split_bf(xs[3], h3, l3);
                u32x2 hv, lv; hv.x = h0 | (h1 << 16); hv.y = h2 | (h3 << 16); lv.x = l0 | (l1 << 16); lv.y = l2 | (l3 << 16);
                *(LAS u32x2*)(TWh + i1 * 72 + 4 * sub) = hv; *(LAS u32x2*)(TWl + i1 * 72 + 4 * sub) = lv; }
              { const f32x4 xs = RW_XS(c4v, p4v, mu4);
                unsigned h0, l0, h1, l1, h2, l2, h3, l3; split_bf(xs[0], h0, l0); split_bf(xs[1], h1, l1); split_bf(xs[2], h2, l2); split_bf(xs[3], h3, l3);
                u32x2 hv, lv; hv.x = h0 | (h1 << 16); hv.y = h2 | (h3 << 16); lv.x = l0 | (l1 << 16); lv.y = l2 | (l3 << 16);
                *(LAS u32x2*)(ALh + i1 * 72 + 4 * sub) = hv; *(LAS u32x2*)(ALl + i1 * 72 + 4 * sub) = lv; } }
            if (ck + 1 < SEQ / 32) RW_PREFETCH(t0 + 32);
            __syncthreads();
            { const int mi = wave >> 2, ni = wave & 3, fr = lane & 15, fq = lane >> 4;
              f32x4 accw = {0.f, 0.f, 0.f, 0.f}, acca = {0.f, 0.f, 0.f, 0.f};
#pragma unroll
              for (int ks = 0; ks < 2; ++ks) { const int ao = (16 * mi + fr) * 72 + 32 * ks + 8 * fq, bo = (16 * ni + fr) * 72 + 32 * ks + 8 * fq;
                  const bf16x8 ah = *(const LAS bf16x8*)(TWh + ao), al = *(const LAS bf16x8*)(TWl + ao), bh_ = *(const LAS bf16x8*)(WUh + bo), bl = *(const LAS bf16x8*)(WUl + bo);
                  accw = __builtin_amdgcn_mfma_f32_16x16x32_bf16(ah, bh_, accw, 0, 0, 0); accw = __builtin_amdgcn_mfma_f32_16x16x32_bf16(ah, bl, accw, 0, 0, 0); accw = __builtin_amdgcn_mfma_f32_16x16x32_bf16(al, bh_, accw, 0, 0, 0);
                  const bf16x8 ch = *(const LAS bf16x8*)(ALh + ao), cl = *(const LAS bf16x8*)(ALl + ao), dh = *(const LAS bf16x8*)(AUh + bo), dl = *(const LAS bf16x8*)(AUl + bo);
                  acca = __builtin_amdgcn_mfma_f32_16x16x32_bf16(ch, dh, acca, 0, 0, 0); acca = __builtin_amdgcn_mfma_f32_16x16x32_bf16(ch, dl, acca, 0, 0, 0); acca = __builtin_amdgcn_mfma_f32_16x16x32_bf16(cl, dh, acca, 0, 0, 0); }
#pragma unroll
              for (int rg = 0; rg < 4; ++rg) { Wd[(16 * mi + 4 * fq + rg) * 64 + 16 * ni + fr] = accw[rg]; Bb[(16 * mi + 4 * fq + rg) * 64 + 16 * ni + fr] = acca[rg]; } }
            __syncthreads();
#pragma unroll
            for (int q = 0; q < 4; ++q) { const int i = wave + 8 * q;
                const float nx = -(w0 + Wd[i * 64 + lane]); const float sp = fmaxf(nx, 0.f) + __logf(1.f + __expf(-fabsf(nx)));
                const float decay = __expf(-__expf(-sp - 0.5f));
                const float av = __builtin_amdgcn_rcpf(1.f + __expf(-(a0 + Bb[i * 64 + lane])));
                const float kraw = KR[i * 64 + lane]; const float kkv = kraw * k_k;
                const float ss = wave_sum_fast(kkv * kkv); const float kk = kkv * __builtin_amdgcn_rsqf(fmaxf(ss, 1e-24f));
                const float kp = kraw * (1.f + (av - 1.f) * k_a);
                const float bon = wave_sum_fast(Rr[i * 64 + lane] * kp * r_k);
                Wd[i * 64 + lane] = decay; KR[i * 64 + lane] = kp; KK[i * 64 + lane] = kk; Bb[i * 64 + lane] = kk * av;
                if (half == 0 && lane == 0) BONG[(size_t)(b * SEQ + t0 + i) * 8 + h] = bon; }
            __syncthreads();
            { f32x4 kk4 = *(const LAS f32x4*)(KK + c4), w4 = *(const LAS f32x4*)(Wd + c4), b4 = *(const LAS f32x4*)(Bb + c4), k4 = *(const LAS f32x4*)(KR + c4), r4 = *(const LAS f32x4*)(Rr + c4);
              float vv = Vv[rowl];
#pragma unroll 4
              for (int i = 0; i < 32; ++i) {
                const int in = (i + 1) & 31;
                const f32x4 nkk = *(const LAS f32x4*)(KK + in * 64 + c4), nw = *(const LAS f32x4*)(Wd + in * 64 + c4), nb = *(const LAS f32x4*)(Bb + in * 64 + c4), nk = *(const LAS f32x4*)(KR + in * 64 + c4), nr = *(const LAS f32x4*)(Rr + in * 64 + c4);
                const float nv = Vv[in * 32 + rowl];
                float sa = (S[0] * kk4[0] + S[1] * kk4[1]) + (S[2] * kk4[2] + S[3] * kk4[3]);
                const float p0 = S[0] * w4[0] + vv * k4[0], p1 = S[1] * w4[1] + vv * k4[1], p2 = S[2] * w4[2] + vv * k4[2], p3 = S[3] * w4[3] + vv * k4[3];
                sa = -row_sum16(sa);
                S[0] = sa * b4[0] + p0; S[1] = sa * b4[1] + p1; S[2] = sa * b4[2] + p2; S[3] = sa * b4[3] + p3;
                float y = (S[0] * r4[0] + S[1] * r4[1]) + (S[2] * r4[2] + S[3] * r4[3]);
                y = row_sum16(y);
                Yy[i * 32 + rowl] = y;
                kk4 = nkk; w4 = nw; b4 = nb; k4 = nk; r4 = nr; vv = nv;
              } }
            __syncthreads();
            for (int idx = tid; idx < 1024; idx += 512) { const int i = idx >> 5, rl = idx & 31; YRAW[(size_t)(b * SEQ + t0 + i) * 512 + h * 64 + half * 32 + rl] = Yy[idx]; }
        }
#undef RW_PREFETCH
#undef RW_XS
    }
}
__device__ __forceinline__ void phase_finish(const Args& a, int lane, int wave, int vcu, int G) {
    const bf16* P = (const bf16*)(a.ws + WS_P); bf16* MIX = (bf16*)(a.ws + WS_MIX); const float* YRAW = (const float*)(a.ws + WS_YRAW); const float* BONG = (const float*)(a.ws + WS_BON);
    const int gw = vcu * NWAVES + wave, NGW = G * NWAVES; const int c0 = 8 * lane;
    const f32x4 g0 = *(const f32x4*)(a.in[I_ELNXG] + c0), g1 = *(const f32x4*)(a.in[I_ELNXG] + c0 + 4), e0 = *(const f32x4*)(a.in[I_ELNXB] + c0), e1 = *(const f32x4*)(a.in[I_ELNXB] + c0 + 4);
    const f32x4 m0 = *(const f32x4*)(a.in[I_EMU] + C_V + c0), m1 = *(const f32x4*)(a.in[I_EMU] + C_V + c0 + 4);
    for (int row = gw; row < M; row += NGW) {
        const f32x4 y0 = *(const f32x4*)(YRAW + (size_t)row * 512 + c0), y1 = *(const f32x4*)(YRAW + (size_t)row * 512 + c0 + 4);
        float y[8] = {y0[0], y0[1], y0[2], y0[3], y1[0], y1[1], y1[2], y1[3]};
        float s = 0.f;
#pragma unroll
        for (int e = 0; e < 8; ++e) s += y[e];
        s += __shfl_xor(s, 1); s += __shfl_xor(s, 2); s += __shfl_xor(s, 4); const float mean = s * (1.f / 64.f); float q = 0.f;
#pragma unroll
        for (int e = 0; e < 8; ++e) { y[e] -= mean; q += y[e] * y[e]; }
        q += __shfl_xor(q, 1); q += __shfl_xor(q, 2); q += __shfl_xor(q, 4); const float rstd = 1.0f / sqrtf(q * (1.f / 64.f) + 64e-5f);
        const bf16* pc = P + (size_t)row * EVEN_PAD; const v4u cu = *(const v4u*)(pc + C_V + c0); v4u pu = {0u, 0u, 0u, 0u}; if ((row & (SEQ - 1)) != 0) pu = *(const v4u*)(pc - EVEN_PAD + C_V + c0);
        const v4u zu = *(const v4u*)(pc + C_Z0 + c0);
        const float cv[8] = {bflo(cu.x), bfhi(cu.x), bflo(cu.y), bfhi(cu.y), bflo(cu.z), bfhi(cu.z), bflo(cu.w), bfhi(cu.w)};
        const float pv[8] = {bflo(pu.x), bfhi(pu.x), bflo(pu.y), bfhi(pu.y), bflo(pu.z), bfhi(pu.z), bflo(pu.w), bfhi(pu.w)};
        const float zz[8] = {bflo(zu.x), bfhi(zu.x), bflo(zu.y), bfhi(zu.y), bflo(zu.z), bfhi(zu.z), bflo(zu.w), bfhi(zu.w)};
        const float mu[8] = {m0[0], m0[1], m0[2], m0[3], m1[0], m1[1], m1[2], m1[3]}, gg[8] = {g0[0], g0[1], g0[2], g0[3], g1[0], g1[1], g1[2], g1[3]}, ee[8] = {e0[0], e0[1], e0[2], e0[3], e1[0], e1[1], e1[2], e1[3]};
        const float bon = BONG[(size_t)row * 8 + (lane >> 3)];
        float o[8];
#pragma unroll
        for (int e = 0; e < 8; ++e) { const float v = cv[e] + mu[e] * (pv[e] - cv[e]); o[e] = (y[e] * rstd * gg[e] + ee[e] + bon * v) * siluf(zz[e]); }
        v4u w; w.x = pk2(o[0], o[1]); w.y = pk2(o[2], o[3]); w.z = pk2(o[4], o[5]); w.w = pk2(o[6], o[7]);
        *(v4u*)(MIX + (size_t)row * D + c0) = w;
    }
}
__device__ __forceinline__ void phase_gmlp(const Args& a, LAS unsigned char* lds, int tid, int lane, int wave, int vcu, int G) {
    const bf16* P = (const bf16*)(a.ws + WS_P); bf16* MIX = (bf16*)(a.ws + WS_MIX);
    LAS float* WS = (LAS float*)lds;
    LAS float* VLN = (LAS float*)(lds + 128 * 129 * 4);
    int gload = -1;
    for (int u = vcu; u < BATCH * 16 * 8; u += G) {
        const int b = u >> 7, ck = (u >> 3) & 15, g = u & 7;
        __syncthreads();
        if (g != gload) { for (int idx = tid; idx < 16384; idx += 512) WS[(idx >> 7) * 129 + (idx & 127)] = a.in[I_ESGW][(size_t)g * 16384 + idx]; gload = g; }
        const int i = tid >> 2, sub = tid & 3; const size_t rowg = (size_t)(b * SEQ + ck * 128 + i);
        { const v4u q0 = *(const v4u*)(P + rowg * EVEN_PAD + C_VG + g * 64 + sub * 16), q1 = *(const v4u*)(P + rowg * EVEN_PAD + C_VG + g * 64 + sub * 16 + 8);
          float v[16] = {bflo(q0.x), bfhi(q0.x), bflo(q0.y), bfhi(q0.y), bflo(q0.z), bfhi(q0.z), bflo(q0.w), bfhi(q0.w), bflo(q1.x), bfhi(q1.x), bflo(q1.y), bfhi(q1.y), bflo(q1.z), bfhi(q1.z), bflo(q1.w), bfhi(q1.w)};
          float s = 0.f;
#pragma unroll
          for (int e = 0; e < 16; ++e) s += v[e];
          s += __shfl_xor(s, 1); s += __shfl_xor(s, 2); const float mean = s * (1.f / 64.f); float q = 0.f;
#pragma unroll
          for (int e = 0; e < 16; ++e) { v[e] -= mean; q += v[e] * v[e]; }
          q += __shfl_xor(q, 1); q += __shfl_xor(q, 2); const float rstd = 1.0f / sqrtf(q * (1.f / 64.f) + 1e-5f);
#pragma unroll
          for (int e = 0; e < 16; ++e) VLN[i * 64 + sub * 16 + e] = v[e] * rstd * a.in[I_ESGLNG][g * 64 + sub * 16 + e] + a.in[I_ESGLNB][g * 64 + sub * 16 + e]; }
        __syncthreads();
        float acc[16];
#pragma unroll
        for (int e = 0; e < 16; ++e) acc[e] = 0.f;
        const int smax = wave * 16 + 16;
        for (int s = 0; s < smax; ++s) {
            const float w = (s <= i) ? WS[i * 129 + s] : 0.f;
            const f32x4 v0 = *(const LAS f32x4*)(VLN + s * 64 + sub * 16), v1 = *(const LAS f32x4*)(VLN + s * 64 + sub * 16 + 4), v2 = *(const LAS f32x4*)(VLN + s * 64 + sub * 16 + 8), v3 = *(const LAS f32x4*)(VLN + s * 64 + sub * 16 + 12);
#pragma unroll
            for (int e = 0; e < 4; ++e) { acc[e] += w * v0[e]; acc[4 + e] += w * v1[e]; acc[8 + e] += w * v2[e]; acc[12 + e] += w * v3[e]; }
        }
        const float bs = a.in[I_ESGB][g * 128 + i];
        const v4u u0 = *(const v4u*)(P + rowg * EVEN_PAD + C_U + g * 64 + sub * 16), u1 = *(const v4u*)(P + rowg * EVEN_PAD + C_U + g * 64 + sub * 16 + 8);
        const v4u z0 = *(const v4u*)(P + rowg * EVEN_PAD + C_Z0 + 512 + g * 64 + sub * 16), z1 = *(const v4u*)(P + rowg * EVEN_PAD + C_Z0 + 512 + g * 64 + sub * 16 + 8);
        const float uu[16] = {bflo(u0.x), bfhi(u0.x), bflo(u0.y), bfhi(u0.y), bflo(u0.z), bfhi(u0.z), bflo(u0.w), bfhi(u0.w), bflo(u1.x), bfhi(u1.x), bflo(u1.y), bfhi(u1.y), bflo(u1.z), bfhi(u1.z), bflo(u1.w), bfhi(u1.w)};
        const float zz[16] = {bflo(z0.x), bfhi(z0.x), bflo(z0.y), bfhi(z0.y), bflo(z0.z), bfhi(z0.z), bflo(z0.w), bfhi(z0.w), bflo(z1.x), bfhi(z1.x), bflo(z1.y), bfhi(z1.y), bflo(z1.z), bfhi(z1.z), bflo(z1.w), bfhi(z1.w)};
        float o[16];
#pragma unroll
        for (int e = 0; e < 16; ++e) o[e] = uu[e] * (acc[e] + bs) * siluf(zz[e]);
        v4u w0, w1; w0.x = pk2(o[0], o[1]); w0.y = pk2(o[2], o[3]); w0.z = pk2(o[4], o[5]); w0.w = pk2(o[6], o[7]); w1.x = pk2(o[8], o[9]); w1.y = pk2(o[10], o[11]); w1.z = pk2(o[12], o[13]); w1.w = pk2(o[14], o[15]);
        *(v4u*)(MIX + rowg * D + 512 + g * 64 + sub * 16) = w0; *(v4u*)(MIX + rowg * D + 512 + g * 64 + sub * 16 + 8) = w1;
    }
}

__device__ __forceinline__ void phase_swa(const Args& a, LAS unsigned char* lds, int tid, int lane, int wave, int vcu, int G) {
    const bf16* P = (const bf16*)(a.ws + WS_P); bf16* MIX = (bf16*)(a.ws + WS_MIX);
    LAS unsigned* KB = (LAS unsigned*)lds;
    LAS unsigned* VB = KB + 256 * 33;
    for (int u = vcu; u < BATCH * 16 * 2; u += G) {
        const int b = u >> 5, n = (u >> 1) & 15, kvh = u & 1;
        __syncthreads();
        { const int kr = tid >> 1, half = tid & 1; const int tk = n * 128 - 128 + kr;
          v4u kq[4], vq[4];
#pragma unroll
          for (int e = 0; e < 4; ++e) { kq[e] = (v4u){0u, 0u, 0u, 0u}; vq[e] = kq[e]; }
          if (tk >= 0) { const bf16* pr = P + (size_t)(b * SEQ + tk) * ODD_IN;
#pragma unroll
              for (int e = 0; e < 4; ++e) { kq[e] = *(const v4u*)(pr + C_KC + kvh * 64 + half * 32 + e * 8); vq[e] = *(const v4u*)(pr + C_VC + kvh * 64 + half * 32 + e * 8); } }
#pragma unroll
          for (int e = 0; e < 4; ++e) { LAS unsigned* kd = KB + kr * 33 + half * 16 + e * 4; kd[0] = kq[e].x; kd[1] = kq[e].y; kd[2] = kq[e].z; kd[3] = kq[e].w;
              LAS unsigned* vd = VB + kr * 33 + half * 16 + e * 4; vd[0] = vq[e].x; vd[1] = vq[e].y; vd[2] = vq[e].z; vd[3] = vq[e].w; } }
        __syncthreads();
        for (int pass = 0; pass < 2; ++pass) {
            const int gq = (tid >> 7) + 4 * pass, qi = tid & 127, h = kvh * 8 + gq; const size_t rowg = (size_t)(b * SEQ + n * 128 + qi);
            float q[64], o[64];
#pragma unroll
            for (int e = 0; e < 8; ++e) { const v4u w = *(const v4u*)(P + rowg * ODD_IN + C_Q + h * 64 + e * 8);
                q[8 * e + 0] = bflo(w.x) * 0.125f; q[8 * e + 1] = bfhi(w.x) * 0.125f; q[8 * e + 2] = bflo(w.y) * 0.125f; q[8 * e + 3] = bfhi(w.y) * 0.125f;
                q[8 * e + 4] = bflo(w.z) * 0.125f; q[8 * e + 5] = bfhi(w.z) * 0.125f; q[8 * e + 6] = bflo(w.w) * 0.125f; q[8 * e + 7] = bfhi(w.w) * 0.125f; }
#pragma unroll
            for (int e = 0; e < 64; ++e) o[e] = 0.f;
            const float slope = exp2f(-0.5f * (float)(h + 1));
            float mrun = a.in[I_OSINKS][h], lrun = 1.f;
            for (int j = 0; j < 128; ++j) {
                const int kr = qi + 1 + j; const bool valid = (n > 0) || (kr >= 128);
                const LAS unsigned* kp = KB + kr * 33;
                float s0 = 0.f, s1 = 0.f;
#pragma unroll
                for (int e = 0; e < 32; ++e) { const unsigned w = kp[e]; s0 += q[2 * e] * bflo(w); s1 += q[2 * e + 1] * bfhi(w); }
                const float s = (s0 + s1) - slope * (float)(127 - j);
                const float mn = valid ? fmaxf(mrun, s) : mrun;
                const float alpha = __expf(mrun - mn); const float p = valid ? __expf(s - mn) : 0.f;
                lrun = lrun * alpha + p; mrun = mn;
                const LAS unsigned* vp = VB + kr * 33;
#pragma unroll
                for (int e = 0; e < 32; ++e) { const unsigned w = vp[e]; o[2 * e] = o[2 * e] * alpha + p * bflo(w); o[2 * e + 1] = o[2 * e + 1] * alpha + p * bfhi(w); }
            }
            const float il = 1.f / lrun;
#pragma unroll
            for (int e = 0; e < 8; ++e) { const v4u zw = *(const v4u*)(P + rowg * ODD_IN + C_Z1 + h * 64 + e * 8);
                v4u w; w.x = pk2(o[8 * e + 0] * il * siluf(bflo(zw.x)), o[8 * e + 1] * il * siluf(bfhi(zw.x))); w.y = pk2(o[8 * e + 2] * il * siluf(bflo(zw.y)), o[8 * e + 3] * il * siluf(bfhi(zw.y)));
                w.z = pk2(o[8 * e + 4] * il * siluf(bflo(zw.z)), o[8 * e + 5] * il * siluf(bfhi(zw.z))); w.w = pk2(o[8 * e + 6] * il * siluf(bflo(zw.w)), o[8 * e + 7] * il * siluf(bfhi(zw.w)));
                *(v4u*)(MIX + rowg * D + h * 64 + e * 8) = w; }
        }
    }
}

__global__ void __launch_bounds__(NWAVES * 64, 2) mk_fwd(Args args) {
    extern __shared__ __attribute__((aligned(16))) unsigned char lds_raw[];
    LAS unsigned char* lds = (LAS unsigned char*)lds_raw;
    volatile LAS unsigned* MISC = (volatile LAS unsigned*)(lds + MISC_OFF);
    const int tid = threadIdx.x, lane = tid & 63, wave = __builtin_amdgcn_readfirstlane(tid >> 6);
    const int G = gridDim.x; const int bx = blockIdx.x; const int vcu = (G % 8 == 0) ? (bx % 8) * (G / 8) + bx / 8 : bx;
    unsigned char* ws = args.ws;
    gu32* ctl = (gu32*)(ws + WS_CTL);
    for (int u = tid; u < (LDS_BYTES - LDSCTL_OFF) / 4; u += NWAVES * 64) ((LAS unsigned*)(lds + LDSCTL_OFF))[u] = 0u;
    __syncthreads();
    XcdBarrier bar = xcd_barrier_post((unsigned*)(ctl + CW_BAR), MISC + 8);
    const int lo = args.ph_lo, hi = args.ph_hi;
#define IN(k) (lo <= (k) && (k) < hi)
#define GRID_BAR() xcd_barrier(bar)
    float* mod = (float*)(ws + WS_MOD);
    bf16* XN = (bf16*)(ws + WS_XN); bf16* MIX = (bf16*)(ws + WS_MIX); bf16* P = (bf16*)(ws + WS_P);

    if (IN(0)) { phase0(args, lds, tid, lane, wave, vcu, G); GRID_BAR(); }
    if (IN(1)) { phase_adaln_rows(args.in[I_X], args.in[I_NORMG], mod, XN, lane, wave, vcu, G); GRID_BAR(); }
    if (IN(2)) {
        pg8::Gemm g{XN, (const bf16*)(ws + WS_WIN0), M, EVEN_PAD, D}; pg8::StaticOrder S; S.init(M, EVEN_PAD, G, (int)blockIdx.x);
        pg8::EpiBf16 E{P, EVEN_PAD};
        pg8::gemm_phase<pg8::EpiBf16, pg8::StaticOrder, PG8_ALIGN, PG8_SP2>(lds, g, S, E);
        GRID_BAR();
    }
    if (IN(3)) { phase_rwkv2(args, lds, tid, lane, wave, vcu, G); phase_gmlp(args, lds, tid, lane, wave, vcu, G); GRID_BAR(); phase_finish(args, lane, wave, vcu, G); GRID_BAR(); }
    if (IN(4)) {
        pg8::Gemm g{MIX, (const bf16*)(ws + WS_WOUT0), M, D, D}; pg8::StaticOrder S; S.init(M, D, G, (int)blockIdx.x);
        pg8::EpiResGate E{args.in[I_X], args.out, mod + 2048};
        pg8::gemm_phase<pg8::EpiResGate, pg8::StaticOrder, PG8_ALIGN, PG8_SP2>(lds, g, S, E);
        GRID_BAR();
    }
    if (IN(5)) { phase_adaln_rows(args.out, args.in[I_NORMG] + D, mod + 16 * 3072, XN, lane, wave, vcu, G); GRID_BAR(); }
    if (IN(6)) {
        pg8::Gemm g{XN, (const bf16*)(ws + WS_WIN1), M, ODD_IN, D}; pg8::StaticOrder S; S.init(M, ODD_IN, G, (int)blockIdx.x);
        pg8::EpiBf16 E{P, ODD_IN};
        pg8::gemm_phase<pg8::EpiBf16, pg8::StaticOrder, PG8_ALIGN, PG8_SP2>(lds, g, S, E);
        GRID_BAR();
    }
    if (IN(7)) { phase_swa(args, lds, tid, lane, wave, vcu, G); GRID_BAR(); }
    if (IN(8)) {
        pg8::Gemm g{MIX, (const bf16*)(ws + WS_WOUT1), M, D, D}; pg8::StaticOrder S; S.init(M, D, G, (int)blockIdx.x);
        pg8::EpiResGate E{args.out, args.out, mod + 16 * 3072 + 2048};
        pg8::gemm_phase<pg8::EpiResGate, pg8::StaticOrder, PG8_ALIGN, PG8_SP2>(lds, g, S, E);
        GRID_BAR();
    }
    if (IN(9)) { phase_final_rows(args.out, args.in[I_FINALG], lane, wave, vcu, G); }
#undef IN
#undef GRID_BAR
}

extern "C" void kernel_launch(void* const* d_in, const int* in_sizes, int n_in, void* d_out, int out_size, void* d_ws, size_t ws_size, hipStream_t stream) {
    static int grid = 0;
    if (grid == 0) {
        if (n_in != N_IN || in_sizes[0] != M * D || out_size != M * D || ws_size < WS_END) { fprintf(stderr, "kernel_launch: unexpected shapes (n_in %d, in0 %d, out %d, ws %zu); nothing launched\n", n_in, n_in > 0 ? in_sizes[0] : -1, out_size, ws_size); grid = -1; return; }
        int dev = 0, cus = 0, per_cu = 0;
        if (hipGetDevice(&dev) != hipSuccess || hipDeviceGetAttribute(&cus, hipDeviceAttributeMultiprocessorCount, dev) != hipSuccess) { grid = -1; return; }
        if (hipFuncSetAttribute((const void*)mk_fwd, hipFuncAttributeMaxDynamicSharedMemorySize, LDS_BYTES) != hipSuccess) { fprintf(stderr, "kernel_launch: hipFuncSetAttribute failed\n"); grid = -1; return; }
        if (hipOccupancyMaxActiveBlocksPerMultiprocessor(&per_cu, (const void*)mk_fwd, NWAVES * 64, LDS_BYTES) != hipSuccess || per_cu < 1) fprintf(stderr, "kernel_launch: note: occupancy query reports %d\n", per_cu);
        (void)hipGetLastError();
        grid = cus;
    }
    if (grid < 0) return;
    if (hipMemsetAsync((char*)d_ws + WS_CTL, 0, CTL_ZERO_BYTES, stream) != hipSuccess) { fprintf(stderr, "kernel_launch: memset failed\n"); return; }
    Args a{};
    for (int i = 0; i < N_IN; ++i) a.in[i] = (const float*)d_in[i];
    a.out = (float*)d_out; a.ws = (unsigned char*)d_ws; a.ph_lo = 0; a.ph_hi = 10;
    hipLaunchKernelGGL(mk_fwd, dim3(grid), dim3(NWAVES * 64), LDS_BYTES, stream, a);
}
```

```cpp
#include <hip/hip_runtime.h>
#include <cstdio>
#include <cstdint>
namespace pg8 {
#define PG8_LAS __attribute__((address_space(3)))
typedef unsigned short bf16_t;
typedef short bf16x8 __attribute__((ext_vector_type(8)));
typedef float f32x4 __attribute__((ext_vector_type(4)));
typedef unsigned u32x4 __attribute__((ext_vector_type(4)));
constexpr int BM = 256, BK = 64, HALF = 128, HTB = HALF * BK * 2  , STAGE_BYTES = 8 * HTB, NXCD = 8, WGM = 8;

__host__ __device__ __forceinline__ int lds_byte(int r, int c) { const int st = (r >> 4) * 2 + (c >> 5), rr = r & 15, cc = c & 31, ob = rr * 64 + cc * 2; return st * 1024 + (ob ^ (((ob >> 9) & 1) << 5)); }
__host__ __device__ __forceinline__ void stage_rc(int b, int& R, int& C) { const int st = b / 1024, sb = b % 1024, swz = sb ^ (((sb >> 9) & 1) << 5); R = (st >> 1) * 16 + swz / 64; C = (st & 1) * 32 + (swz % 64) / 2; }
__host__ __device__ __forceinline__ int perm32(int rho) { const int n = rho >> 4, i = rho & 15; return 8 * (i >> 2) + 4 * n + (i & 3); }

struct Unit { int pm, pn; };
struct Gemm { const bf16_t* A; const bf16_t* Bt; int M, N, K; };

struct StaticOrder {
    int nM, nN, nwg, G, c;
    __host__ __device__ void init(int M, int N, int G_, int c_) { nM = M / BM; nN = N / BM; nwg = nM * nN; G = G_; c = c_; }
    __host__ __device__ bool next(int i, Unit& u) const {
        const long L = (long)i * G + c; if (L >= nwg) return false;
        int wgid = (int)L; { const int q = nwg / NXCD, r = nwg % NXCD, xcd = wgid % NXCD, off = wgid / NXCD; wgid = (xcd < r ? xcd * (q + 1) : r * (q + 1) + (xcd - r) * q) + off; }
        const int nig = WGM * nN, gid = wgid / nig, fm = gid * WGM, gsz = (nM - fm) < WGM ? (nM - fm) : WGM;
        u.pm = fm + ((wgid % nig) % gsz); u.pn = (wgid % nig) / gsz; return true;
    }
    __device__ __forceinline__ void a_ready(const Unit&) const {}
    __device__ __forceinline__ void done(const Unit&) const {}
};

__device__ __forceinline__ unsigned cvt_pk_bf16(float lo, float hi) { unsigned r; asm volatile("v_cvt_pk_bf16_f32 %0, %1, %2" : "=v"(r) : "v"(lo), "v"(hi)); return r; }
struct EpiBf16 {
    static constexpr bool PERM = true, AFTER_DRAIN = false;
    bf16_t* O; int ldc;
    __device__ __forceinline__ void operator()(const f32x4 (&acc)[2][2][4][2], const Unit& u, int wr, int wc, int fr, int fq) const {
        const int row0 = u.pm * BM + wr * 64 + fr; const int col0 = u.pn * BM + wc * 32 + 8 * fq;
#pragma unroll
        for (int ai = 0; ai < 2; ++ai)
#pragma unroll
            for (int m = 0; m < 4; ++m) { bf16_t* rowp = O + (size_t)(row0 + ai * HALF + m * 16) * ldc + col0;
#pragma unroll
                for (int bj = 0; bj < 2; ++bj) { const f32x4 v0 = acc[ai][bj][m][0], v1 = acc[ai][bj][m][1];
                    u32x4 w; w.x = cvt_pk_bf16(v0[0], v0[1]); w.y = cvt_pk_bf16(v0[2], v0[3]); w.z = cvt_pk_bf16(v1[0], v1[1]); w.w = cvt_pk_bf16(v1[2], v1[3]);
                    *(u32x4*)(rowp + bj * HALF) = w; } }
    }
};
struct EpiResGate {
    static constexpr bool PERM = false, AFTER_DRAIN = false;
    const float* base; float* out; const float* gate;
    __device__ __forceinline__ void operator()(const f32x4 (&acc)[2][2][4][2], const Unit& u, int wr, int wc, int fr, int fq) const {
        const int col0 = u.pn * BM + wc * 32 + 4 * fq; const int b = (u.pm * BM) >> 11;
        f32x4 gv[2][2];
#pragma unroll
        for (int bj = 0; bj < 2; ++bj)
#pragma unroll
            for (int n = 0; n < 2; ++n) gv[bj][n] = *(const f32x4*)(gate + (size_t)b * 3072 + col0 + bj * HALF + n * 16);
#pragma unroll
        for (int ai = 0; ai < 2; ++ai)
#pragma unroll
            for (int m = 0; m < 4; ++m) { const size_t off = (size_t)(u.pm * BM + ai * HALF + wr * 64 + m * 16 + fr) * 1024 + col0;
#pragma unroll
                for (int bj = 0; bj < 2; ++bj)
#pragma unroll
                    for (int n = 0; n < 2; ++n) { const f32x4 bs = *(const f32x4*)(base + off + bj * HALF + n * 16);
                        *(f32x4*)(out + off + bj * HALF + n * 16) = bs + gv[bj][n] * acc[ai][bj][m][n]; } }
    }
};

template <class Epi, class Sched, bool ALIGN_EPI = false, bool SP2 = false>
__device__ __forceinline__ void gemm_phase(PG8_LAS unsigned char* lds, const Gemm g, const Sched& S, const Epi& E) {
    const int tid = threadIdx.x, wid = __builtin_amdgcn_readfirstlane(tid >> 6), lane = tid & 63, wr = wid >> 2, wc = wid & 3, fr = lane & 15, fq = lane >> 4;
    const int K = g.K, nt = K / BK;
    unsigned voffA[2], voffB[2];
#pragma unroll
    for (int i = 0; i < 2; ++i) { int R, C; stage_rc(tid * 16 + i * 8192, R, C); const int Rb = Epi::PERM ? ((R & ~31) + perm32(R & 31)) : R;
        voffA[i] = (unsigned)(R * K + C) * 2u; voffB[i] = (unsigned)(Rb * K + C) * 2u; }
    const size_t kstep = (size_t)(BK * 2);
    const size_t hstep = (size_t)HALF * K * 2;
    const size_t tstep = 2 * hstep;
    const unsigned ldsw = (unsigned)wid * 1024u;
    const int aoff = lds_byte(wr * 64 + fr, fq * 8), boff = lds_byte(wc * 32 + fr, fq * 8);
#define PG8_SA(b, h) (((b) * 2 + (h)) * HTB)
#define PG8_SB(b, h) ((4 + (b) * 2 + (h)) * HTB)
#define PG8_STAGE(bufoff, gbase, voff) do { _Pragma("unroll") for (int _i = 0; _i < 2; ++_i) \
        __builtin_amdgcn_global_load_lds((const unsigned*)((const char*)(gbase) + (voff)[_i]), (PG8_LAS unsigned*)(lds + (bufoff) + ldsw + _i * 8192), 16, 0, 0); } while (0)
#define PG8_LDA(dst, b, h) do { _Pragma("unroll") for (int m = 0; m < 4; ++m) _Pragma("unroll") for (int k = 0; k < 2; ++k) dst[m][k] = *(const PG8_LAS bf16x8*)(lds + PG8_SA(b, h) + aoff + m * 2048 + k * 1024); } while (0)
#define PG8_LDB(dst, b, h) do { _Pragma("unroll") for (int n = 0; n < 2; ++n) _Pragma("unroll") for (int k = 0; k < 2; ++k) dst[n][k] = *(const PG8_LAS bf16x8*)(lds + PG8_SB(b, h) + boff + n * 2048 + k * 1024); } while (0)
#define PG8_MMA(ai, bj, At, Bt) do { __builtin_amdgcn_s_setprio(1); _Pragma("unroll") for (int m = 0; m < 4; ++m) _Pragma("unroll") for (int n = 0; n < 2; ++n) _Pragma("unroll") for (int k = 0; k < 2; ++k) \
        acc[ai][bj][m][n] = __builtin_amdgcn_mfma_f32_16x16x32_bf16(Bt[n][k], At[m][k], acc[ai][bj][m][n], 0, 0, 0); __builtin_amdgcn_s_setprio(0); } while (0)
#define PG8_WAIT_V(n) asm volatile("s_waitcnt vmcnt(" #n ")" ::: "memory")
#define PG8_WAIT_L(n) asm volatile("s_waitcnt lgkmcnt(" #n ")" ::: "memory")
#define PG8_BAR __builtin_amdgcn_s_barrier()
#define PG8_SCHED __builtin_amdgcn_sched_barrier(0)
    Unit cur, nxt; int ui = 0;
    if (!S.next(0, cur)) return;
    f32x4 acc[2][2][4][2];
#pragma unroll
    for (int a = 0; a < 2; ++a)
#pragma unroll
        for (int b = 0; b < 2; ++b)
#pragma unroll
            for (int m = 0; m < 4; ++m)
#pragma unroll
                for (int n = 0; n < 2; ++n) acc[a][b][m][n] = (f32x4){0.f, 0.f, 0.f, 0.f};
    bf16x8 At[4][2], B0[2][2], B1[2][2];
    const char* cA = (const char*)g.A + (size_t)cur.pm * tstep; const char* cB = (const char*)g.Bt + (size_t)cur.pn * tstep;
    S.a_ready(cur);
    if constexpr (SP2) {
        PG8_STAGE(PG8_SB(0, 0), cB, voffB); PG8_STAGE(PG8_SB(0, 1), cB + hstep, voffB); PG8_STAGE(PG8_SA(0, 0), cA, voffA); PG8_STAGE(PG8_SA(0, 1), cA + hstep, voffA);
        if (wr == 1) PG8_BAR;
        PG8_WAIT_V(2); PG8_BAR;
        PG8_STAGE(PG8_SB(1, 0), cB + kstep, voffB); PG8_STAGE(PG8_SA(1, 0), cA + kstep, voffA); PG8_STAGE(PG8_SB(1, 1), cB + hstep + kstep, voffB);
        PG8_WAIT_V(6); PG8_BAR;
    } else {
        PG8_STAGE(PG8_SB(0, 0), cB, voffB); PG8_STAGE(PG8_SA(0, 0), cA, voffA); PG8_STAGE(PG8_SB(0, 1), cB + hstep, voffB); PG8_STAGE(PG8_SA(0, 1), cA + hstep, voffA);
        if (wr == 1) PG8_BAR;
        PG8_WAIT_V(4); PG8_BAR;
        PG8_STAGE(PG8_SB(1, 0), cB + kstep, voffB); PG8_STAGE(PG8_SA(1, 0), cA + kstep, voffA); PG8_STAGE(PG8_SB(1, 1), cB + hstep + kstep, voffB);
        PG8_WAIT_V(6); PG8_BAR;
    }
    for (;;) {
        const bool has_next = S.next(ui + 1, nxt);
        const char* nA = has_next ? (const char*)g.A + (size_t)nxt.pm * tstep : cA; const char* nB = has_next ? (const char*)g.Bt + (size_t)nxt.pn * tstep : cB;
        for (int t = 0; t < nt; t += 2) {
            const bool last = (t == nt - 2);
            const char* a1 = cA + (size_t)(t + 1) * kstep;
            const char* a2 = last ? nA : cA + (size_t)(t + 2) * kstep; const char* b2 = last ? nB : cB + (size_t)(t + 2) * kstep;
            const char* a3 = a2 + kstep; const char* b3 = b2 + kstep;
            if (last && has_next) S.a_ready(nxt);
            if constexpr (SP2) {
            PG8_LDB(B0, 0, 0); PG8_LDB(B1, 0, 1); PG8_SCHED; PG8_LDA(At, 0, 0); PG8_STAGE(PG8_SA(1, 1), a1 + hstep, voffA);
            PG8_WAIT_V(8); PG8_WAIT_L(0); PG8_BAR; PG8_MMA(0, 0, At, B0); PG8_MMA(0, 1, At, B1); PG8_BAR; PG8_SCHED;
            PG8_LDA(At, 0, 1); PG8_STAGE(PG8_SB(0, 0), b2, voffB); PG8_STAGE(PG8_SB(0, 1), b2 + hstep, voffB); PG8_STAGE(PG8_SA(0, 0), a2, voffA);
            PG8_WAIT_V(8); PG8_WAIT_L(0); PG8_BAR; PG8_MMA(1, 0, At, B0); PG8_MMA(1, 1, At, B1); PG8_BAR; PG8_SCHED;
            PG8_LDB(B0, 1, 0); PG8_LDB(B1, 1, 1); PG8_SCHED; PG8_LDA(At, 1, 0); PG8_STAGE(PG8_SA(0, 1), a2 + hstep, voffA);
            PG8_WAIT_V(8); PG8_WAIT_L(0); PG8_BAR; PG8_MMA(0, 0, At, B0); PG8_MMA(0, 1, At, B1); PG8_BAR; PG8_SCHED;
            PG8_LDA(At, 1, 1); PG8_STAGE(PG8_SB(1, 0), b3, voffB); PG8_STAGE(PG8_SB(1, 1), b3 + hstep, voffB); PG8_STAGE(PG8_SA(1, 0), a3, voffA);
            PG8_WAIT_V(8); PG8_WAIT_L(0); PG8_BAR; PG8_MMA(1, 0, At, B0); PG8_MMA(1, 1, At, B1); PG8_BAR; PG8_SCHED;
            } else {
            PG8_LDB(B0, 0, 0); PG8_SCHED; PG8_LDA(At, 0, 0); PG8_STAGE(PG8_SA(1, 1), a1 + hstep, voffA);
            PG8_WAIT_L(8); PG8_BAR; PG8_WAIT_L(0); PG8_MMA(0, 0, At, B0); PG8_BAR; PG8_SCHED;
            PG8_LDB(B1, 0, 1); PG8_STAGE(PG8_SB(0, 0), b2, voffB);
            PG8_BAR; PG8_WAIT_L(0); PG8_MMA(0, 1, At, B1); PG8_BAR;
            PG8_LDA(At, 0, 1); PG8_STAGE(PG8_SA(0, 0), a2, voffA);
            PG8_BAR; PG8_WAIT_L(0); PG8_MMA(1, 0, At, B0); PG8_BAR; PG8_SCHED;
            PG8_STAGE(PG8_SB(0, 1), b2 + hstep, voffB);
            PG8_WAIT_V(6); PG8_BAR; PG8_MMA(1, 1, At, B1); PG8_BAR;
            PG8_LDB(B0, 1, 0); PG8_SCHED; PG8_LDA(At, 1, 0); PG8_STAGE(PG8_SA(0, 1), a2 + hstep, voffA);
            PG8_WAIT_L(8); PG8_BAR; PG8_WAIT_L(0); PG8_MMA(0, 0, At, B0); PG8_BAR; PG8_SCHED;
            PG8_LDB(B1, 1, 1); PG8_STAGE(PG8_SB(1, 0), b3, voffB);
            PG8_BAR; PG8_WAIT_L(0); PG8_MMA(0, 1, At, B1); PG8_BAR;
            PG8_LDA(At, 1, 1); PG8_STAGE(PG8_SA(1, 0), a3, voffA);
            PG8_BAR; PG8_WAIT_L(0); PG8_MMA(1, 0, At, B0); PG8_BAR; PG8_SCHED;
            PG8_STAGE(PG8_SB(1, 1), b3 + hstep, voffB);
            PG8_WAIT_V(6); PG8_BAR; PG8_MMA(1, 1, At, B1); PG8_BAR;
            }
        }
        if constexpr (ALIGN_EPI) { if (wr == 0) PG8_BAR; }
        if constexpr (!Epi::AFTER_DRAIN) { E(acc, cur, wr, wc, fr, fq); S.done(cur); }
        if (!has_next) break;
#pragma unroll
        for (int a = 0; a < 2; ++a)
#pragma unroll
            for (int b = 0; b < 2; ++b)
#pragma unroll
                for (int m = 0; m < 4; ++m)
#pragma unroll
                    for (int n = 0; n < 2; ++n) acc[a][b][m][n] = (f32x4){0.f, 0.f, 0.f, 0.f};
        cur = nxt; cA = nA; cB = nB; ++ui;
        if constexpr (ALIGN_EPI) { if (wr == 1) PG8_BAR; }
    }
    PG8_WAIT_V(0);
    if constexpr (!ALIGN_EPI) { if (wr == 0) PG8_BAR; }
    PG8_BAR;
    if constexpr (Epi::AFTER_DRAIN) { E.fused(acc, cur, wr, wc, fr, fq, lds, wid, lane); S.done(cur); }
#undef PG8_SA
#undef PG8_SB
#undef PG8_STAGE
#undef PG8_LDA
#undef PG8_LDB
#undef PG8_MMA
#undef PG8_WAIT_V
#undef PG8_WAIT_L
#undef PG8_BAR
#undef PG8_SCHED
}
}

#ifndef PG8_SP2
#define PG8_SP2 true
#endif
#ifndef PG8_ALIGN
#define PG8_ALIGN true
#endif
#define GAS __attribute__((address_space(1)))
#define LAS __attribute__((address_space(3)))
typedef unsigned short bf16;
typedef unsigned v4u __attribute__((ext_vector_type(4)));
typedef float f32x4 __attribute__((ext_vector_type(4)));
typedef short bf16x8 __attribute__((ext_vector_type(8)));
typedef GAS unsigned gu32;
typedef GAS unsigned long long gu64;
#define RLX_AGENT __ATOMIC_RELAXED, __HIP_MEMORY_SCOPE_AGENT
#define LDS_WAIT() asm volatile("s_waitcnt lgkmcnt(0)" ::: "memory")
#define VM_WAIT() asm volatile("s_waitcnt vmcnt(0)" ::: "memory")
__device__ __forceinline__ unsigned long long rt() { return __builtin_amdgcn_s_memrealtime(); }
__device__ __forceinline__ unsigned f2bf(float f) { unsigned u = __builtin_bit_cast(unsigned, f); return (u + 0x7fffu + ((u >> 16) & 1u)) >> 16; }
__device__ __forceinline__ unsigned pk2(float lo, float hi) { return f2bf(lo) | (f2bf(hi) << 16); }

#define XB_TMO      128
#define XB_XCNT(j)  (256  + 64 * (j))
#define XB_XSUB(j)  (1280 + 64 * (j))
#define XB_XGEN(j)  (2304 + 64 * (j))
#define XB_TOP      3328
#define XB_TOPGEN   3392
#define XCD_BAR_WORDS 3456
#define XB_SPIN_CAP (1u << 22)

__device__ __forceinline__ unsigned xb_ld(unsigned* p)              { return __hip_atomic_load(p, __ATOMIC_RELAXED, __HIP_MEMORY_SCOPE_AGENT); }
__device__ __forceinline__ unsigned xb_add(unsigned* p, unsigned v) { return __hip_atomic_fetch_add(p, v, __ATOMIC_RELAXED, __HIP_MEMORY_SCOPE_AGENT); }
__device__ __forceinline__ unsigned xb_xcc_id() { return (unsigned)__builtin_amdgcn_s_getreg((3 << 11) | 20) & 0xFu; }
#define XB_SPIN(cond, bar) do { unsigned _sp = 0; while (cond) { __builtin_amdgcn_s_sleep(1); \
    if ((++_sp & 255u) == 0u) { if (xb_ld(&(bar)[XB_TMO])) break; if (_sp > XB_SPIN_CAP) { atomicAdd(&(bar)[XB_TMO], 1u); break; } } } } while (0)

struct XcdBarrier {
    unsigned* bar; unsigned x;
    volatile LAS unsigned* st;
};

__device__ __forceinline__ XcdBarrier xcd_barrier_post(unsigned* bar, volatile LAS unsigned* st) {
    XcdBarrier b; b.bar = bar; b.x = xb_xcc_id(); b.st = st;
    if (threadIdx.x == 0) (void)xb_add(&bar[XB_XCNT(b.x)], 1u);
    return b;
}
__device__ __forceinline__ void xcd_barrier_complete(unsigned* bar, unsigned x, unsigned& nloc, unsigned& nx) {
    const unsigned G = gridDim.x * gridDim.y * gridDim.z;
    unsigned sum, cnt, mine, sp = 0u;
    for (;;) {
        sum = 0u; cnt = 0u; mine = 0u;
#pragma unroll
        for (unsigned j = 0; j < 16; ++j) { const unsigned c = xb_ld(&bar[XB_XCNT(j)]); sum += c; cnt += (c > 0u) ? 1u : 0u; mine = (j == x) ? c : mine; }
        if (sum == G) break;
        __builtin_amdgcn_s_sleep(1);
        if ((++sp & 255u) == 0u) { if (xb_ld(&bar[XB_TMO])) break; if (sp > XB_SPIN_CAP) { atomicAdd(&bar[XB_TMO], 1u); break; } }
    }
    nloc = mine > 0u ? mine : 1u; nx = cnt > 0u ? cnt : 1u;
}

__device__ __forceinline__ void xcd_barrier(const XcdBarrier& b) {
    asm volatile("s_waitcnt vmcnt(0)" ::: "memory");
    __syncthreads();
    if (threadIdx.x == 0) {
        unsigned* bar = b.bar;
        __builtin_amdgcn_s_waitcnt(0);
        unsigned nloc = b.st[0], nx = b.st[1];
        if (nloc == 0u) { xcd_barrier_complete(bar, b.x, nloc, nx); b.st[0] = nloc; b.st[1] = nx; }
        const unsigned old = xb_add(&bar[XB_XSUB(b.x)], 1u);
        const unsigned gen = old / nloc;
        if (old + 1u == (gen + 1u) * nloc) {
            __builtin_amdgcn_fence(__ATOMIC_RELEASE, "agent");
            asm volatile("s_waitcnt vmcnt(0)" ::: "memory");
            const unsigned og = xb_add(&bar[XB_TOP], 1u);
            const unsigned tg = og / nx;
            if (og + 1u == (tg + 1u) * nx) xb_add(&bar[XB_TOPGEN], 1u);
            else XB_SPIN(xb_ld(&bar[XB_TOPGEN]) == tg, bar);
            __builtin_amdgcn_fence(__ATOMIC_ACQUIRE, "agent");
            xb_add(&bar[XB_XGEN(b.x)], 1u);
            asm volatile("s_waitcnt vmcnt(0)" ::: "memory");
        } else {
            XB_SPIN(xb_ld(&bar[XB_XGEN(b.x)]) == gen, bar);
            __builtin_amdgcn_fence(__ATOMIC_ACQUIRE, "agent");
            asm volatile("s_waitcnt vmcnt(0)" ::: "memory");
        }
    }
    __syncthreads();
}


constexpr int NWAVES = 8;
constexpr int BATCH = 16, SEQ = 2048, D = 1024, M = BATCH * SEQ;
constexpr int EVEN_IN = 3712, EVEN_PAD = 3840, ODD_IN = 2304;
constexpr int C_R = 0, C_K = 512, C_V = 1024, C_WLO = 1536, C_ALO = 1600, C_U = 1664, C_VG = 2176, C_Z0 = 2688;
constexpr int C_Q = 0, C_KC = 1024, C_VC = 1152, C_Z1 = 1280;
enum { I_X = 0, I_C, I_ADAW, I_ADAB, I_NORMG, I_EWIN, I_EMU, I_EW0, I_EWUP, I_EA0, I_EAUP, I_EKK, I_EKA, I_ERK, I_ELNXG, I_ELNXB, I_ESGLNG, I_ESGLNB, I_ESGW, I_ESGB, I_EWOUT, I_OWIN, I_OSINKS, I_OWOUT, I_FINALG, N_IN };

constexpr size_t MiB = 1u << 20;
constexpr size_t WS_CTL = 0, CTL_ZERO_BYTES = 64 * 1024;
constexpr size_t WS_MOD = 1 * MiB;
constexpr size_t WS_WIN0 = 2 * MiB, WS_WOUT0 = 10 * MiB, WS_WIN1 = 12 * MiB, WS_WOUT1 = 17 * MiB;
constexpr size_t WS_XN = 32 * MiB, WS_MIX = 96 * MiB, WS_P = 160 * MiB, WS_YRAW = 400 * MiB, WS_BON = 464 * MiB, WS_END = 466 * MiB;
constexpr int CW_BAR = 4096;

constexpr int RING_BYTES = 131072, LDSCTL_OFF = RING_BYTES, MISC_OFF = LDSCTL_OFF + 320, LDS_BYTES = 147456;

__device__ __forceinline__ float bf2f(unsigned short h) { return __builtin_bit_cast(float, (unsigned)h << 16); }
__device__ __forceinline__ float bflo(unsigned w) { return __builtin_bit_cast(float, w << 16); }
__device__ __forceinline__ float bfhi(unsigned w) { return __builtin_bit_cast(float, w & 0xffff0000u); }
__device__ __forceinline__ float wave_sum(float v) {
#pragma unroll
    for (int o = 1; o < 64; o <<= 1) v += __shfl_xor(v, o);
    return v;
}
__device__ __forceinline__ float siluf(float x) { return x / (1.f + __expf(-x)); }

struct Args { const float* in[N_IN]; float* out; unsigned char* ws; int ph_lo, ph_hi; };

__device__ __forceinline__ void p0_transpose_item(const float* W, int K, int N, bf16* WT, LAS float* scr, int item, int lane) {
    const int nblk = N / 32, kb = item / nblk, nb = item % nblk, k0 = 64 * kb, n0 = 32 * nb;
#pragma unroll 8
    for (int i = 0; i < 32; ++i) { const int kk = 2 * i + (lane >> 5); scr[kk * 33 + (lane & 31)] = W[(size_t)(k0 + kk) * N + n0 + (lane & 31)]; }
    LDS_WAIT(); asm volatile("" ::: "memory");
    const int c = lane & 7;
#pragma unroll
    for (int j = 0; j < 4; ++j) { const int n = (lane >> 3) + 8 * j; const LAS float* s = scr + (8 * c) * 33 + n;
        v4u o; o.x = pk2(s[0 * 33], s[1 * 33]); o.y = pk2(s[2 * 33], s[3 * 33]); o.z = pk2(s[4 * 33], s[5 * 33]); o.w = pk2(s[6 * 33], s[7 * 33]);
        *(GAS v4u*)(WT + (size_t)(n0 + n) * K + k0 + 8 * c) = o; }
    LDS_WAIT(); asm volatile("" ::: "memory");
}
__device__ __forceinline__ void phase0(const Args& a, LAS unsigned char* lds, int tid, int lane, int wave, int vcu, int G) {
    unsigned char* ws = a.ws;
    if (vcu < 96) {
        LAS float* condT = (LAS float*)lds;
        LAS float* part = (LAS float*)(lds + 65536);
        const float* c = a.in[I_C];
        for (int idx = tid; idx < 16384; idx += 512) { const int b = idx >> 10, k = idx & 1023; condT[k * 16 + b] = siluf(c[idx]); }
        __syncthreads();
        for (int it = vcu; it < 96; it += G) {
            const int l = it / 48, n0 = (it % 48) * 64;
            const float* W = a.in[I_ADAW] + (size_t)l * 1024 * 3072 + n0 + lane;
            float acc[16];
#pragma unroll
            for (int b = 0; b < 16; ++b) acc[b] = 0.f;
            const int kbeg = wave * 128;
#pragma unroll 4
            for (int k = kbeg; k < kbeg + 128; ++k) {
                const float w = W[(size_t)k * 3072];
                const LAS f32x4* cv = (const LAS f32x4*)(condT + k * 16);
                const f32x4 c0 = cv[0], c1 = cv[1], c2 = cv[2], c3 = cv[3];
                acc[0] += c0[0] * w; acc[1] += c0[1] * w; acc[2] += c0[2] * w; acc[3] += c0[3] * w;
                acc[4] += c1[0] * w; acc[5] += c1[1] * w; acc[6] += c1[2] * w; acc[7] += c1[3] * w;
                acc[8] += c2[0] * w; acc[9] += c2[1] * w; acc[10] += c2[2] * w; acc[11] += c2[3] * w;
                acc[12] += c3[0] * w; acc[13] += c3[1] * w; acc[14] += c3[2] * w; acc[15] += c3[3] * w;
            }
#pragma unroll
            for (int b = 0; b < 16; ++b) part[(wave * 16 + b) * 64 + lane] = acc[b];
            __syncthreads();
            float* mod = (float*)(ws + WS_MOD);
#pragma unroll
            for (int q = 0; q < 2; ++q) { const int b = (tid >> 6) + 8 * q; float s = 0.f;
#pragma unroll
                for (int w8 = 0; w8 < 8; ++w8) s += part[(w8 * 16 + b) * 64 + lane];
                mod[(size_t)(l * 16 + b) * 3072 + n0 + lane] = s + a.in[I_ADAB][l * 3072 + n0 + lane]; }
            __syncthreads();
        }
    }
    __syncthreads();
    LAS float* scr = (LAS float*)(lds + wave * 16384);
    const int gw = vcu * NWAVES + wave, NGW = G * NWAVES;
    constexpr int I0 = (D / 64) * (EVEN_IN / 32), I1 = (D / 64) * (D / 32), I2 = (D / 64) * (ODD_IN / 32), I3 = I1, IZ = EVEN_PAD - EVEN_IN;
    for (int it = gw; it < I0 + I1 + I2 + I3 + IZ; it += NGW) {
        int r = it;
        if (r < I0) { p0_transpose_item(a.in[I_EWIN], D, EVEN_IN, (bf16*)(ws + WS_WIN0), scr, r, lane); continue; } r -= I0;
        if (r < I1) { p0_transpose_item(a.in[I_EWOUT], D, D, (bf16*)(ws + WS_WOUT0), scr, r, lane); continue; } r -= I1;
        if (r < I2) { p0_transpose_item(a.in[I_OWIN], D, ODD_IN, (bf16*)(ws + WS_WIN1), scr, r, lane); continue; } r -= I2;
        if (r < I3) { p0_transpose_item(a.in[I_OWOUT], D, D, (bf16*)(ws + WS_WOUT1), scr, r, lane); continue; } r -= I3;
        { GAS v4u* o = (GAS v4u*)((bf16*)(ws + WS_WIN0) + (size_t)(EVEN_IN + r) * D); const v4u z = {0u, 0u, 0u, 0u}; o[lane] = z; o[lane + 64] = z; }
    }
}

__device__ __forceinline__ void phase_adaln_rows(const float* xin, const float* g, const float* modl, bf16* XN, int lane, int wave, int vcu, int G) {
    const int gw = vcu * NWAVES + wave, NGW = G * NWAVES;
    for (int r0 = gw * 16; r0 < M; r0 += NGW * 16) {
        const int b = r0 >> 11;
        f32x4 gs[4], sh[4];
#pragma unroll
        for (int j = 0; j < 4; ++j) { const int c = 4 * lane + 256 * j;
            const f32x4 gg = *(const f32x4*)(g + c), sc = *(const f32x4*)(modl + (size_t)b * 3072 + 1024 + c);
            gs[j] = gg * (sc + 1.0f); sh[j] = *(const f32x4*)(modl + (size_t)b * 3072 + c); }
        for (int r = r0; r < r0 + 16; ++r) {
            const GAS f32x4* xr = (const GAS f32x4*)(xin + (size_t)r * D) + lane;
            f32x4 v[4]; float s = 0.f;
#pragma unroll
            for (int j = 0; j < 4; ++j) { v[j] = xr[64 * j]; s += (v[j].x * v[j].x + v[j].y * v[j].y) + (v[j].z * v[j].z + v[j].w * v[j].w); }
            const float rs = 1.0f / sqrtf(wave_sum(s) * (1.f / D) + 1e-6f);
            GAS unsigned long long* o8 = (GAS unsigned long long*)(XN + (size_t)r * D) + lane;
#pragma unroll
            for (int j = 0; j < 4; ++j) { const f32x4 o = v[j] * rs * gs[j] + sh[j];
                o8[64 * j] = (unsigned long long)pk2(o.x, o.y) | ((unsigned long long)pk2(o.z, o.w) << 32); }
        }
    }
}
__device__ __forceinline__ void phase_final_rows(float* xio, const float* g, int lane, int wave, int vcu, int G) {
    const int gw = vcu * NWAVES + wave, NGW = G * NWAVES;
    f32x4 gs[4];
#pragma unroll
    for (int j = 0; j < 4; ++j) gs[j] = *(const f32x4*)(g + 4 * lane + 256 * j);
    for (int r = gw; r < M; r += NGW) {
        GAS f32x4* xr = (GAS f32x4*)(xio + (size_t)r * D) + lane;
        f32x4 v[4]; float s = 0.f;
#pragma unroll
        for (int j = 0; j < 4; ++j) { v[j] = xr[64 * j]; s += (v[j].x * v[j].x + v[j].y * v[j].y) + (v[j].z * v[j].z + v[j].w * v[j].w); }
        const float rs = 1.0f / sqrtf(wave_sum(s) * (1.f / D) + 1e-6f);
#pragma unroll
        for (int j = 0; j < 4; ++j) xr[64 * j] = v[j] * rs * gs[j];
    }
}

__device__ __forceinline__ void phase_rwkv(const Args& a, LAS unsigned char* lds, int tid, int lane, int wave, int vcu, int G) {
    const bf16* P = (const bf16*)(a.ws + WS_P); bf16* MIX = (bf16*)(a.ws + WS_MIX);
    LAS float* WUP = (LAS float*)lds;
    LAS float* AUP = WUP + 4096;
    LAS float* TW = AUP + 4096;
    LAS float* AL = TW + 2048;
    LAS float* Rr = AL + 2048;
    LAS float* KR = Rr + 2048;
    LAS float* Vv = KR + 2048;
    LAS float* Wd = Vv + 2048;
    LAS float* KK = Wd + 2048;
    LAS float* Bb = KK + 2048;
    LAS float* Yy = Bb + 2048;
    LAS float* BON = Yy + 2048;
    for (int unit = vcu; unit < BATCH * 8; unit += G) {
        const int b = unit >> 3, h = unit & 7;
        __syncthreads();
        for (int idx = tid; idx < 4096; idx += 512) { const int m = idx >> 6, j = idx & 63; WUP[idx] = a.in[I_EWUP][m * 512 + h * 64 + j]; AUP[idx] = a.in[I_EAUP][m * 512 + h * 64 + j]; }
        float S[8];
#pragma unroll
        for (int j = 0; j < 8; ++j) S[j] = 0.f;
        const int hj = h * 64 + lane;
        const float w0 = a.in[I_EW0][hj], a0 = a.in[I_EA0][hj], k_k = a.in[I_EKK][hj], k_a = a.in[I_EKA][hj], r_k = a.in[I_ERK][hj], lng = a.in[I_ELNXG][hj], lnb = a.in[I_ELNXB][hj];
        for (int ck = 0; ck < SEQ / 32; ++ck) {
            const int t0 = ck * 32;
            { const int i = tid >> 4, sub = tid & 15; const int t = t0 + i; const bf16* pc = P + (size_t)(b * SEQ + t) * EVEN_PAD; const bf16* pp = pc - EVEN_PAD; const bool hasp = t > 0;
#pragma unroll
              for (int grp = 0; grp < 5; ++grp) {
                  const int col = (grp == 0 ? C_R + h * 64 : grp == 1 ? C_K + h * 64 : grp == 2 ? C_V + h * 64 : grp == 3 ? C_WLO : C_ALO) + 4 * sub;
                  const uint2 cu = *(const uint2*)(pc + col); uint2 pu = {0u, 0u}; if (hasp) pu = *(const uint2*)(pp + col);
                  const f32x4 mu = *(const f32x4*)(a.in[I_EMU] + col);
                  float cv[4] = {bflo(cu.x), bfhi(cu.x), bflo(cu.y), bfhi(cu.y)}, pv[4] = {bflo(pu.x), bfhi(pu.x), bflo(pu.y), bfhi(pu.y)};
                  f32x4 xs;
#pragma unroll
                  for (int e = 0; e < 4; ++e) xs[e] = cv[e] + mu[e] * (pv[e] - cv[e]);
                  if (grp == 3) { xs[0] = tanhf(xs[0]); xs[1] = tanhf(xs[1]); xs[2] = tanhf(xs[2]); xs[3] = tanhf(xs[3]); }
                  LAS float* dst = (grp == 0 ? Rr : grp == 1 ? KR : grp == 2 ? Vv : grp == 3 ? TW : AL) + i * 64 + 4 * sub;
                  *(LAS f32x4*)dst = xs;
              } }
            __syncthreads();
            { float accw[4] = {0.f, 0.f, 0.f, 0.f}, acca[4] = {0.f, 0.f, 0.f, 0.f};
              for (int m4 = 0; m4 < 16; ++m4) {
                  f32x4 tw[4], al[4];
#pragma unroll
                  for (int q = 0; q < 4; ++q) { tw[q] = *(const LAS f32x4*)(TW + (wave + 8 * q) * 64 + 4 * m4); al[q] = *(const LAS f32x4*)(AL + (wave + 8 * q) * 64 + 4 * m4); }
#pragma unroll
                  for (int e = 0; e < 4; ++e) { const float wu = WUP[(4 * m4 + e) * 64 + lane], au = AUP[(4 * m4 + e) * 64 + lane];
#pragma unroll
                      for (int q = 0; q < 4; ++q) { accw[q] += tw[q][e] * wu; acca[q] += al[q][e] * au; } }
              }
#pragma unroll
              for (int q = 0; q < 4; ++q) { const int i = wave + 8 * q;
                  const float wv = w0 + accw[q];
                  const float nx = -wv; const float sp = fmaxf(nx, 0.f) + log1pf(__expf(-fabsf(nx)));
                  const float wl = -sp - 0.5f; const float decay = __expf(-__expf(wl));
                  const float av = 1.f / (1.f + __expf(-(a0 + acca[q])));
                  const float kraw = KR[i * 64 + lane]; const float kkv = kraw * k_k;
                  const float ss = wave_sum(kkv * kkv); const float kk = kkv / fmaxf(sqrtf(ss), 1e-12f);
                  const float kp = kraw * (1.f + (av - 1.f) * k_a);
                  const float bon = wave_sum(Rr[i * 64 + lane] * kp * r_k);
                  Wd[i * 64 + lane] = decay; KR[i * 64 + lane] = kp; KK[i * 64 + lane] = kk; Bb[i * 64 + lane] = kk * av; if (lane == 0) BON[i] = bon; } }
            __syncthreads();
            { const int row = wave * 8 + (lane >> 3), c8 = (lane & 7) * 8;
              for (int i = 0; i < 32; ++i) {
                  const f32x4 k0 = *(const LAS f32x4*)(KK + i * 64 + c8), k1 = *(const LAS f32x4*)(KK + i * 64 + c8 + 4);
                  const f32x4 w0v = *(const LAS f32x4*)(Wd + i * 64 + c8), w1v = *(const LAS f32x4*)(Wd + i * 64 + c8 + 4);
                  const f32x4 b0 = *(const LAS f32x4*)(Bb + i * 64 + c8), b1 = *(const LAS f32x4*)(Bb + i * 64 + c8 + 4);
                  const f32x4 p0 = *(const LAS f32x4*)(KR + i * 64 + c8), p1 = *(const LAS f32x4*)(KR + i * 64 + c8 + 4);
                  const f32x4 r0 = *(const LAS f32x4*)(Rr + i * 64 + c8), r1 = *(const LAS f32x4*)(Rr + i * 64 + c8 + 4);
                  const float vv = Vv[i * 64 + row];
                  float sa = (S[0] * k0[0] + S[1] * k0[1]) + (S[2] * k0[2] + S[3] * k0[3]) + (S[4] * k1[0] + S[5] * k1[1]) + (S[6] * k1[2] + S[7] * k1[3]);
                  sa += __shfl_xor(sa, 1); sa += __shfl_xor(sa, 2); sa += __shfl_xor(sa, 4); sa = -sa;
                  S[0] = S[0] * w0v[0] + sa * b0[0] + vv * p0[0]; S[1] = S[1] * w0v[1] + sa * b0[1] + vv * p0[1];
                  S[2] = S[2] * w0v[2] + sa * b0[2] + vv * p0[2]; S[3] = S[3] * w0v[3] + sa * b0[3] + vv * p0[3];
                  S[4] = S[4] * w1v[0] + sa * b1[0] + vv * p1[0]; S[5] = S[5] * w1v[1] + sa * b1[1] + vv * p1[1];
                  S[6] = S[6] * w1v[2] + sa * b1[2] + vv * p1[2]; S[7] = S[7] * w1v[3] + sa * b1[3] + vv * p1[3];
                  float y = (S[0] * r0[0] + S[1] * r0[1]) + (S[2] * r0[2] + S[3] * r0[3]) + (S[4] * r1[0] + S[5] * r1[1]) + (S[6] * r1[2] + S[7] * r1[3]);
                  y += __shfl_xor(y, 1); y += __shfl_xor(y, 2); y += __shfl_xor(y, 4);
                  if ((lane & 7) == 0) Yy[i * 64 + row] = y;
              } }
            __syncthreads();
#pragma unroll
            for (int q = 0; q < 4; ++q) { const int i = wave * 4 + q; const size_t rowg = (size_t)(b * SEQ + t0 + i);
                const float y = Yy[i * 64 + lane]; const float mean = wave_sum(y) * (1.f / 64.f); const float d = y - mean; const float var = wave_sum(d * d) * (1.f / 64.f);
                const float o = d * (1.0f / sqrtf(var + 64e-5f)) * lng + lnb + BON[i] * Vv[i * 64 + lane];
                const float z = bf2f(P[rowg * EVEN_PAD + C_Z0 + hj]);
                MIX[rowg * D + hj] = (bf16)f2bf(o * siluf(z)); }
            __syncthreads();
        }
    }
}

typedef unsigned u32x2 __attribute__((ext_vector_type(2)));
#define DPP_ADD(x, ctrl) x += __builtin_bit_cast(float, __builtin_amdgcn_update_dpp(0, __builtin_bit_cast(int, x), ctrl, 0xF, 0xF, true))
__device__ __forceinline__ float row_sum16(float x) { DPP_ADD(x, 0xB1); DPP_ADD(x, 0x4E); DPP_ADD(x, 0x124); DPP_ADD(x, 0x128); return x; }
__device__ __forceinline__ void split_bf(float x, unsigned& hi, unsigned& lo) { hi = f2bf(x); lo = f2bf(x - __builtin_bit_cast(float, hi << 16)); }
__device__ __forceinline__ float wave_sum_fast(float x) { x = row_sum16(x);
    const int xi = __builtin_bit_cast(int, x);
    return (__builtin_bit_cast(float, __builtin_amdgcn_readlane(xi, 0)) + __builtin_bit_cast(float, __builtin_amdgcn_readlane(xi, 16))) + (__builtin_bit_cast(float, __builtin_amdgcn_readlane(xi, 32)) + __builtin_bit_cast(float, __builtin_amdgcn_readlane(xi, 48))); }
__device__ __forceinline__ float fast_tanh(float x) { const float t = __expf(2.f * x); return 1.f - 2.f * __builtin_amdgcn_rcpf(t + 1.f); }
__device__ __forceinline__ void phase_rwkv2(const Args& a, LAS unsigned char* lds, int tid, int lane, int wave, int vcu, int G) {
    const bf16* P = (const bf16*)(a.ws + WS_P); float* YRAW = (float*)(a.ws + WS_YRAW); float* BONG = (float*)(a.ws + WS_BON);
    LAS float* Rr = (LAS float*)lds;
    LAS float* KR = Rr + 2048;
    LAS float* KK = KR + 2048;
    LAS float* Wd = KK + 2048;
    LAS float* Bb = Wd + 2048;
    LAS float* Vv = (LAS float*)(lds + 40960);
    LAS float* Yy = (LAS float*)(lds + 45056);
    LAS bf16* TWh = (LAS bf16*)(lds + 49152);
    LAS bf16* TWl = TWh + 32 * 72;
    LAS bf16* ALh = TWl + 32 * 72;
    LAS bf16* ALl = ALh + 32 * 72;
    LAS bf16* WUh = (LAS bf16*)(lds + 67584);
    LAS bf16* WUl = WUh + 64 * 72;
    LAS bf16* AUh = WUl + 64 * 72;
    LAS bf16* AUl = AUh + 64 * 72;
    for (int unit = vcu; unit < BATCH * 16; unit += G) {
        const int bh = unit >> 1, half = unit & 1, b = bh >> 3, h = bh & 7;
        __syncthreads();
        for (int idx = tid; idx < 4096; idx += 512) { const int m = idx >> 6, j = idx & 63; unsigned hi, lo;
            split_bf(a.in[I_EWUP][m * 512 + h * 64 + j], hi, lo); WUh[j * 72 + m] = (bf16)hi; WUl[j * 72 + m] = (bf16)lo;
            split_bf(a.in[I_EAUP][m * 512 + h * 64 + j], hi, lo); AUh[j * 72 + m] = (bf16)hi; AUl[j * 72 + m] = (bf16)lo; }
        float S[4] = {0.f, 0.f, 0.f, 0.f};
        const int hj = h * 64 + lane;
        const float w0 = a.in[I_EW0][hj], a0 = a.in[I_EA0][hj], k_k = a.in[I_EKK][hj], k_a = a.in[I_EKA][hj], r_k = a.in[I_ERK][hj];
        const int c4 = (lane & 15) * 4, rowl = wave * 4 + (lane >> 4);
        const int i1 = tid >> 4, sub = tid & 15;
        const int col0 = C_R + h * 64 + 4 * sub, col1 = C_K + h * 64 + 4 * sub, col2 = C_V + h * 64 + 4 * sub, col3 = C_WLO + 4 * sub, col4 = C_ALO + 4 * sub;
        const f32x4 mu0 = *(const f32x4*)(a.in[I_EMU] + col0), mu1 = *(const f32x4*)(a.in[I_EMU] + col1), mu2 = *(const f32x4*)(a.in[I_EMU] + col2), mu3 = *(const f32x4*)(a.in[I_EMU] + col3), mu4 = *(const f32x4*)(a.in[I_EMU] + col4);
        const bf16* prow = P + (size_t)(b * SEQ + i1) * EVEN_PAD;
        u32x2 c0v, c1v, c2v, c3v, c4v, p0v, p1v, p2v, p3v, p4v;
#define RW_PREFETCH(t0_) do { const bf16* pc_ = prow + (size_t)(t0_) * EVEN_PAD; \
            c0v = *(const u32x2*)(pc_ + col0); c1v = *(const u32x2*)(pc_ + col1); c2v = *(const u32x2*)(pc_ + col2); c3v = *(const u32x2*)(pc_ + col3); c4v = *(const u32x2*)(pc_ + col4); \
            if ((t0_) + i1 > 0) { const bf16* pp_ = pc_ - EVEN_PAD; p0v = *(const u32x2*)(pp_ + col0); p1v = *(const u32x2*)(pp_ + col1); p2v = *(const u32x2*)(pp_ + col2); p3v = *(const u32x2*)(pp_ + col3); p4v = *(const u32x2*)(pp_ + col4); } \
            else { p0v = (u32x2){0u, 0u}; p1v = p0v; p2v = p0v; p3v = p0v; p4v = p0v; } } while (0)
#define RW_XS(cv_, pv_, mu_) ({ f32x4 x_; const float a0_ = bflo(cv_.x), a1_ = bfhi(cv_.x), a2_ = bflo(cv_.y), a3_ = bfhi(cv_.y); \
            x_[0] = a0_ + mu_[0] * (bflo(pv_.x) - a0_); x_[1] = a1_ + mu_[1] * (bfhi(pv_.x) - a1_); x_[2] = a2_ + mu_[2] * (bflo(pv_.y) - a2_); x_[3] = a3_ + mu_[3] * (bfhi(pv_.y) - a3_); x_; })
        RW_PREFETCH(0);
        for (int ck = 0; ck < SEQ / 32; ++ck) {
            const int t0 = ck * 32;
            { *(LAS f32x4*)(Rr + i1 * 64 + 4 * sub) = RW_XS(c0v, p0v, mu0);
              *(LAS f32x4*)(KR + i1 * 64 + 4 * sub) = RW_XS(c1v, p1v, mu1);
              { const f32x4 xv = RW_XS(c2v, p2v, mu2); if ((sub >> 3) == half) *(LAS f32x4*)(Vv + i1 * 32 + 4 * (sub & 7)) = xv; }
              { f32x4 xs = RW_XS(c3v, p3v, mu3); xs[0] = fast_tanh(xs[0]); xs[1] = fast_tanh(xs[1]); xs[2] = fast_tanh(xs[2]); xs[3] = fast_tanh(xs[3]);
                unsigned h0, l0, h1, l1, h2, l2, h3, l3; split_bf(xs[0], h0, l0); split_bf(xs[1], h1, l1); split_bf(xs[2], h2, l2); split_bf(xs[3], h3, l3);
                u32x2 hv, lv; hv.x = h0 | (h1 << 16); hv.y = h2 | (h3 << 16); lv.x = l0 | (l1 << 16); lv.y = l2 | (l3 << 16);
                *(LAS u32x2*)(TWh + i1 * 72 + 4 * sub) = hv; *(LAS u32x2*)(TWl + i1 * 72 + 4 * sub) = lv; }
              { const f32x4 xs = RW_XS(c4v, p4v, mu4);
                unsigned h0, l0, h1, l1, h2, l2, h3, l3; split_bf(xs[0], h0, l0); split_bf(xs[1], h1, l1); split_bf(xs[2], h2, l2); split_bf(xs[3], h3, l3);
                u32x2 hv, lv; hv.x = h0 | (h1 << 16); hv.y = h2 | (h3 << 16); lv.x = l0 | (l1 << 16); lv.y = l2 | (l3 << 16);
                *(LAS u32x2*)(ALh + i1 * 72 + 4 * sub) = hv; *(LAS u32x2*)(ALl + i1 * 72 + 4 * sub) = lv; } }
            if (ck + 1 < SEQ / 32) RW_PREFETCH(t0 + 32);
            __syncthreads();
            { const int mi = wave >> 2, ni = wave & 3, fr = lane & 15, fq = lane >> 4;
              f32x4 accw = {0.f, 0.f, 0.f, 0.f}, acca = {0.f, 0.f, 0.f, 0.f};
#pragma unroll
              for (int ks = 0; ks < 2; ++ks) { const int ao = (16 * mi + fr) * 72 + 32 * ks + 8 * fq, bo = (16 * ni + fr) * 72 + 32 * ks + 8 * fq;
                  const bf16x8 ah = *(const LAS bf16x8*)(TWh + ao), al = *(const LAS bf16x8*)(TWl + ao), bh_ = *(const LAS bf16x8*)(WUh + bo), bl = *(const LAS bf16x8*)(WUl + bo);
                  accw = __builtin_amdgcn_mfma_f32_16x16x32_bf16(ah, bh_, accw, 0, 0, 0); accw = __builtin_amdgcn_mfma_f32_16x16x32_bf16(ah, bl, accw, 0, 0, 0); accw = __builtin_amdgcn_mfma_f32_16x16x32_bf16(al, bh_, accw, 0, 0, 0);
                  const bf16x8 ch = *(const LAS bf16x8*)(ALh + ao), cl = *(const LAS bf16x8*)(ALl + ao), dh = *(const LAS bf16x8*)(AUh + bo), dl = *(const LAS bf16x8*)(AUl + bo);
                  acca = __builtin_amdgcn_mfma_f32_16x16x32_bf16(ch, dh, acca, 0, 0, 0); acca = __builtin_amdgcn_mfma_f32_16x16x32_bf16(ch, dl, acca, 0, 0, 0); acca = __builtin_amdgcn_mfma_f32_16x16x32_bf16(cl, dh, acca, 0, 0, 0); }
#pragma unroll
              for (int rg = 0; rg < 4; ++rg) { Wd[(16 * mi + 4 * fq + rg) * 64 + 16 * ni + fr] = accw[rg]; Bb[(16 * mi + 4 * fq + rg) * 64 + 16 * ni + fr] = acca[rg]; } }
            __syncthreads();
#pragma unroll
            for (int q = 0; q < 4; ++q) { const int i = wave + 8 * q;
                const float nx = -(w0 + Wd[i * 64 + lane]); const float sp = fmaxf(nx, 0.f) + __logf(1.f + __expf(-fabsf(nx)));
                const float decay = __expf(-__expf(-sp - 0.5f));
                const float av = __builtin_amdgcn_rcpf(1.f + __expf(-(a0 + Bb[i * 64 + lane])));
                const float kraw = KR[i * 64 + lane]; const float kkv = kraw * k_k;
                const float ss = wave_sum_fast(kkv * kkv); const float kk = kkv * __builtin_amdgcn_rsqf(fmaxf(ss, 1e-24f));
                const float kp = kraw * (1.f + (av - 1.f) * k_a);
                const float bon = wave_sum_fast(Rr[i * 64 + lane] * kp * r_k);
                Wd[i * 64 + lane] = decay; KR[i * 64 + lane] = kp; KK[i * 64 + lane] = kk; Bb[i * 64 + lane] = kk * av;
                if (half == 0 && lane == 0) BONG[(size_t)(b * SEQ + t0 + i) * 8 + h] = bon; }
            __syncthreads();
            { f32x4 kk4 = *(const LAS f32x4*)(KK + c4), w4 = *(const LAS f32x4*)(Wd + c4), b4 = *(const LAS f32x4*)(Bb + c4), k4 = *(const LAS f32x4*)(KR + c4), r4 = *(const LAS f32x4*)(Rr + c4);
              float vv = Vv[rowl];
#pragma unroll 4
              for (int i = 0; i < 32; ++i) {
                const int in = (i + 1) & 31;
                const f32x4 nkk = *(const LAS f32x4*)(KK + in * 64 + c4), nw = *(const LAS f32x4*)(Wd + in * 64 + c4), nb = *(const LAS f32x4*)(Bb + in * 64 + c4), nk = *(const LAS f32x4*)(KR + in * 64 + c4), nr = *(const LAS f32x4*)(Rr + in * 64 + c4);
                const float nv = Vv[in * 32 + rowl];
                float sa = (S[0] * kk4[0] + S[1] * kk4[1]) + (S[2] * kk4[2] + S[3] * kk4[3]);
                const float p0 = S[0] * w4[0] + vv * k4[0], p1 = S[1] * w4[1] + vv * k4[1], p2 = S[2] * w4[2] + vv * k4[2], p3 = S[3] * w4[3] + vv * k4[3];
                sa = -row_sum16(sa);
                S[0] = sa * b4[0] + p0; S[1] = sa * b4[1] + p1; S[2] = sa * b4[2] + p2; S[3] = sa * b4[3] + p3;
                float y = (S[0] * r4[0] + S[1] * r4[1]) + (S[2] * r4[2] + S[3] * r4[3]);
                y = row_sum16(y);
                Yy[i * 32 + rowl] = y;
                kk4 = nkk; w4 = nw; b4 = nb; k4 = nk; r4 = nr; vv = nv;
              } }
            __syncthreads();
            for (int idx = tid; idx < 1024; idx += 512) { const int i = idx >> 5, rl = idx & 31; YRAW[(size_t)(b * SEQ + t0 + i) * 512 + h * 64 + half * 32 + rl] = Yy[idx]; }
        }
#undef RW_PREFETCH
#undef RW_XS
    }
}
__device__ __forceinline__ void phase_finish(const Args& a, int lane, int wave, int vcu, int G) {
    const bf16* P = (const bf16*)(a.ws + WS_P); bf16* MIX = (bf16*)(a.ws + WS_MIX); const float* YRAW = (const float*)(a.ws + WS_YRAW); const float* BONG = (const float*)(a.ws + WS_BON);
    const int gw = vcu * NWAVES + wave, NGW = G * NWAVES; const int c0 = 8 * lane;
    const f32x4 g0 = *(const f32x4*)(a.in[I_ELNXG] + c0), g1 = *(const f32x4*)(a.in[I_ELNXG] + c0 + 4), e0 = *(const f32x4*)(a.in[I_ELNXB] + c0), e1 = *(const f32x4*)(a.in[I_ELNXB] + c0 + 4);
    const f32x4 m0 = *(const f32x4*)(a.in[I_EMU] + C_V + c0), m1 = *(const f32x4*)(a.in[I_EMU] + C_V + c0 + 4);
    for (int row = gw; row < M; row += NGW) {
        const f32x4 y0 = *(const f32x4*)(YRAW + (size_t)row * 512 + c0), y1 = *(const f32x4*)(YRAW + (size_t)row * 512 + c0 + 4);
        float y[8] = {y0[0], y0[1], y0[2], y0[3], y1[0], y1[1], y1[2], y1[3]};
        float s = 0.f;
#pragma unroll
        for (int e = 0; e < 8; ++e) s += y[e];
        s += __shfl_xor(s, 1); s += __shfl_xor(s, 2); s += __shfl_xor(s, 4); const float mean = s * (1.f / 64.f); float q = 0.f;
#pragma unroll
        for (int e = 0; e < 8; ++e) { y[e] -= mean; q += y[e] * y[e]; }
        q += __shfl_xor(q, 1); q += __shfl_xor(q, 2); q += __shfl_xor(q, 4); const float rstd = 1.0f / sqrtf(q * (1.f / 64.f) + 64e-5f);
        const bf16* pc = P + (size_t)row * EVEN_PAD; const v4u cu = *(const v4u*)(pc + C_V + c0); v4u pu = {0u, 0u, 0u, 0u}; if ((row & (SEQ - 1)) != 0) pu = *(const v4u*)(pc - EVEN_PAD + C_V + c0);
        const v4u zu = *(const v4u*)(pc + C_Z0 + c0);
        const float cv[8] = {bflo(cu.x), bfhi(cu.x), bflo(cu.y), bfhi(cu.y), bflo(cu.z), bfhi(cu.z), bflo(cu.w), bfhi(cu.w)};
        const float pv[8] = {bflo(pu.x), bfhi(pu.x), bflo(pu.y), bfhi(pu.y), bflo(pu.z), bfhi(pu.z), bflo(pu.w), bfhi(pu.w)};
        const float zz[8] = {bflo(zu.x), bfhi(zu.x), bflo(zu.y), bfhi(zu.y), bflo(zu.z), bfhi(zu.z), bflo(zu.w), bfhi(zu.w)};
        const float mu[8] = {m0[0], m0[1], m0[2], m0[3], m1[0], m1[1], m1[2], m1[3]}, gg[8] = {g0[0], g0[1], g0[2], g0[3], g1[0], g1[1], g1[2], g1[3]}, ee[8] = {e0[0], e0[1], e0[2], e0[3], e1[0], e1[1], e1[2], e1[3]};
        const float bon = BONG[(size_t)row * 8 + (lane >> 3)];
        float o[8];
#pragma unroll
        for (int e = 0; e < 8; ++e) { const float v = cv[e] + mu[e] * (pv[e] - cv[e]); o[e] = (y[e] * rstd * gg[e] + ee[e] + bon * v) * siluf(zz[e]); }
        v4u w; w.x = pk2(o[0], o[1]); w.y = pk2(o[2], o[3]); w.z = pk2(o[4], o[5]); w.w = pk2(o[6], o[7]);
        *(v4u*)(MIX + (size_t)row * D + c0) = w;
    }
}
__device__ __forceinline__ void phase_gmlp(const Args& a, LAS unsigned char* lds, int tid, int lane, int wave, int vcu, int G) {
    const bf16* P = (const bf16*)(a.ws + WS_P); bf16* MIX = (bf16*)(a.ws + WS_MIX);
    LAS float* WS = (LAS float*)lds;
    LAS float* VLN = (LAS float*)(lds + 128 * 129 * 4);
    int gload = -1;
    for (int u = vcu; u < BATCH * 16 * 8; u += G) {
        const int b = u >> 7, ck = (u >> 3) & 15, g = u & 7;
        __syncthreads();
        if (g != gload) { for (int idx = tid; idx < 16384; idx += 512) WS[(idx >> 7) * 129 + (idx & 127)] = a.in[I_ESGW][(size_t)g * 16384 + idx]; gload = g; }
        const int i = tid >> 2, sub = tid & 3; const size_t rowg = (size_t)(b * SEQ + ck * 128 + i);
        { const v4u q0 = *(const v4u*)(P + rowg * EVEN_PAD + C_VG + g * 64 + sub * 16), q1 = *(const v4u*)(P + rowg * EVEN_PAD + C_VG + g * 64 + sub * 16 + 8);
          float v[16] = {bflo(q0.x), bfhi(q0.x), bflo(q0.y), bfhi(q0.y), bflo(q0.z), bfhi(q0.z), bflo(q0.w), bfhi(q0.w), bflo(q1.x), bfhi(q1.x), bflo(q1.y), bfhi(q1.y), bflo(q1.z), bfhi(q1.z), bflo(q1.w), bfhi(q1.w)};
          float s = 0.f;
#pragma unroll
          for (int e = 0; e < 16; ++e) s += v[e];
          s += __shfl_xor(s, 1); s += __shfl_xor(s, 2); const float mean = s * (1.f / 64.f); float q = 0.f;
#pragma unroll
          for (int e = 0; e < 16; ++e) { v[e] -= mean; q += v[e] * v[e]; }
          q += __shfl_xor(q, 1); q += __shfl_xor(q, 2); const float rstd = 1.0f / sqrtf(q * (1.f / 64.f) + 1e-5f);
#pragma unroll
          for (int e = 0; e < 16; ++e) VLN[i * 64 + sub * 16 + e] = v[e] * rstd * a.in[I_ESGLNG][g * 64 + sub * 16 + e] + a.in[I_ESGLNB][g * 64 + sub * 16 + e]; }
        __syncthreads();
        float acc[16];
#pragma unroll
        for (int e = 0; e < 16; ++e) acc[e] = 0.f;
        const int smax = wave * 16 + 16;
        for (int s = 0; s < smax; ++s) {
            const float w = (s <= i) ? WS[i * 129 + s] : 0.f;
            const f32x4 v0 = *(const LAS f32x4*)(VLN + s * 64 + sub * 16), v1 = *(const LAS f32x4*)(VLN + s * 64 + sub * 16 + 4), v2 = *(const LAS f32x4*)(VLN + s * 64 + sub * 16 + 8), v3 = *(const LAS f32x4*)(VLN + s * 64 + sub * 16 + 12);
#pragma unroll
            for (int e = 0; e < 4; ++e) { acc[e] += w * v0[e]; acc[4 + e] += w * v1[e]; acc[8 + e] += w * v2[e]; acc[12 + e] += w * v3[e]; }
        }
        const float bs = a.in[I_ESGB][g * 128 + i];
        const v4u u0 = *(const v4u*)(P + rowg * EVEN_PAD + C_U + g * 64 + sub * 16), u1 = *(const v4u*)(P + rowg * EVEN_PAD + C_U + g * 64 + sub * 16 + 8);
        const v4u z0 = *(const v4u*)(P + rowg * EVEN_PAD + C_Z0 + 512 + g * 64 + sub * 16), z1 = *(const v4u*)(P + rowg * EVEN_PAD + C_Z0 + 512 + g * 64 + sub * 16 + 8);
        const float uu[16] = {bflo(u0.x), bfhi(u0.x), bflo(u0.y), bfhi(u0.y), bflo(u0.z), bfhi(u0.z), bflo(u0.w), bfhi(u0.w), bflo(u1.x), bfhi(u1.x), bflo(u1.y), bfhi(u1.y), bflo(u1.z), bfhi(u1.z), bflo(u1.w), bfhi(u1.w)};
        const float zz[16] = {bflo(z0.x), bfhi(z0.x), bflo(z0.y), bfhi(z0.y), bflo(z0.z), bfhi(z0.z), bflo(z0.w), bfhi(z0.w), bflo(z1.x), bfhi(z1.x), bflo(z1.y), bfhi(z1.y), bflo(z1.z), bfhi(z1.z), bflo(z1.w), bfhi(z1.w)};
        float o[16];
#pragma unroll
        for (int e = 0; e < 16; ++e) o[e] = uu[e] * (acc[e] + bs) * siluf(zz[e]);
        v4u w0, w1; w0.x = pk2(o[0], o[1]); w0.y = pk2(o[2], o[3]); w0.z = pk2(o[4], o[5]); w0.w = pk2(o[6], o[7]); w1.x = pk2(o[8], o[9]); w1.y = pk2(o[10], o[11]); w1.z = pk2(o[12], o[13]); w1.w = pk2(o[14], o[15]);
        *(v4u*)(MIX + rowg * D + 512 + g * 64 + sub * 16) = w0; *(v4u*)(MIX + rowg * D + 512 + g * 64 + sub * 16 + 8) = w1;
    }
}

__device__ __forceinline__ void phase_swa(const Args& a, LAS unsigned char* lds, int tid, int lane, int wave, int vcu, int G) {
    const bf16* P = (const bf16*)(a.ws + WS_P); bf16* MIX = (bf16*)(a.ws + WS_MIX);
    LAS unsigned* KB = (LAS unsigned*)lds;
    LAS unsigned* VB = KB + 256 * 33;
    for (int u = vcu; u < BATCH * 16 * 2; u += G) {
        const int b = u >> 5, n = (u >> 1) & 15, kvh = u & 1;
        __syncthreads();
        { const int kr = tid >> 1, half = tid & 1; const int tk = n * 128 - 128 + kr;
          v4u kq[4], vq[4];
#pragma unroll
          for (int e = 0; e < 4; ++e) { kq[e] = (v4u){0u, 0u, 0u, 0u}; vq[e] = kq[e]; }
          if (tk >= 0) { const bf16* pr = P + (size_t)(b * SEQ + tk) * ODD_IN;
#pragma unroll
              for (int e = 0; e < 4; ++e) { kq[e] = *(const v4u*)(pr + C_KC + kvh * 64 + half * 32 + e * 8); vq[e] = *(const v4u*)(pr + C_VC + kvh * 64 + half * 32 + e * 8); } }
#pragma unroll
          for (int e = 0; e < 4; ++e) { LAS unsigned* kd = KB + kr * 33 + half * 16 + e * 4; kd[0] = kq[e].x; kd[1] = kq[e].y; kd[2] = kq[e].z; kd[3] = kq[e].w;
              LAS unsigned* vd = VB + kr * 33 + half * 16 + e * 4; vd[0] = vq[e].x; vd[1] = vq[e].y; vd[2] = vq[e].z; vd[3] = vq[e].w; } }
        __syncthreads();
        for (int pass = 0; pass < 2; ++pass) {
            const int gq = (tid >> 7) + 4 * pass, qi = tid & 127, h = kvh * 8 + gq; const size_t rowg = (size_t)(b * SEQ + n * 128 + qi);
            float q[64], o[64];
#pragma unroll
            for (int e = 0; e < 8; ++e) { const v4u w = *(const v4u*)(P + rowg * ODD_IN + C_Q + h * 64 + e * 8);
                q[8 * e + 0] = bflo(w.x) * 0.125f; q[8 * e + 1] = bfhi(w.x) * 0.125f; q[8 * e + 2] = bflo(w.y) * 0.125f; q[8 * e + 3] = bfhi(w.y) * 0.125f;
                q[8 * e + 4] = bflo(w.z) * 0.125f; q[8 * e + 5] = bfhi(w.z) * 0.125f; q[8 * e + 6] = bflo(w.w) * 0.125f; q[8 * e + 7] = bfhi(w.w) * 0.125f; }
#pragma unroll
            for (int e = 0; e < 64; ++e) o[e] = 0.f;
            const float slope = exp2f(-0.5f * (float)(h + 1));
            float mrun = a.in[I_OSINKS][h], lrun = 1.f;
            for (int j = 0; j < 128; ++j) {
                const int kr = qi + 1 + j; const bool valid = (n > 0) || (kr >= 128);
                const LAS unsigned* kp = KB + kr * 33;
                float s0 = 0.f, s1 = 0.f;
#pragma unroll
                for (int e = 0; e < 32; ++e) { const unsigned w = kp[e]; s0 += q[2 * e] * bflo(w); s1 += q[2 * e + 1] * bfhi(w); }
                const float s = (s0 + s1) - slope * (float)(127 - j);
                const float mn = valid ? fmaxf(mrun, s) : mrun;
                const float alpha = __expf(mrun - mn); const float p = valid ? __expf(s - mn) : 0.f;
                lrun = lrun * alpha + p; mrun = mn;
                const LAS unsigned* vp = VB + kr * 33;
#pragma unroll
                for (int e = 0; e < 32; ++e) { const unsigned w = vp[e]; o[2 * e] = o[2 * e] * alpha + p * bflo(w); o[2 * e + 1] = o[2 * e + 1] * alpha + p * bfhi(w); }
            }
            const float il = 1.f / lrun;
#pragma unroll
            for (int e = 0; e < 8; ++e) { const v4u zw = *(const v4u*)(P + rowg * ODD_IN + C_Z1 + h * 64 + e * 8);
                v4u w; w.x = pk2(o[8 * e + 0] * il * siluf(bflo(zw.x)), o[8 * e + 1] * il * siluf(bfhi(zw.x))); w.y = pk2(o[8 * e + 2] * il * siluf(bflo(zw.y)), o[8 * e + 3] * il * siluf(bfhi(zw.y)));
                w.z = pk2(o[8 * e + 4] * il * siluf(bflo(zw.z)), o[8 * e + 5] * il * siluf(bfhi(zw.z))); w.w = pk2(o[8 * e + 6] * il * siluf(bflo(zw.w)), o[8 * e + 7] * il * siluf(bfhi(zw.w)));
                *(v4u*)(MIX + rowg * D + h * 64 + e * 8) = w; }
        }
    }
}


typedef float f32x16 __attribute__((ext_vector_type(16)));
__device__ __forceinline__ int crow(int r, int hi) { return (r & 3) + 8 * (r >> 2) + 4 * hi; }
__device__ __forceinline__ unsigned cvtpk(float lo, float hi) { unsigned r; asm volatile("v_cvt_pk_bf16_f32 %0, %1, %2" : "=v"(r) : "v"(lo), "v"(hi)); return r; }
__device__ __forceinline__ void phase_swa2(const Args& a, LAS unsigned char* lds, int tid, int lane, int wave, int vcu, int G) {
    const bf16* P = (const bf16*)(a.ws + WS_P); bf16* MIX = (bf16*)(a.ws + WS_MIX);
    LAS bf16* Kl = (LAS bf16*)lds;
    LAS bf16* Vt = (LAS bf16*)(lds + 36864);
    const int l31 = lane & 31, hi = lane >> 5;
    for (int u = vcu; u < BATCH * 16 * 2; u += G) {
        const int b = u >> 5, n = (u >> 1) & 15, kvh = u & 1;
        __syncthreads();
        { const int key = tid >> 1, half = tid & 1; const int tk = n * 128 - 128 + key;
          v4u kq[4];
#pragma unroll
          for (int e = 0; e < 4; ++e) kq[e] = (v4u){0u, 0u, 0u, 0u};
          if (tk >= 0) { const bf16* pr = P + (size_t)(b * SEQ + tk) * ODD_IN + C_KC + kvh * 64 + half * 32;
#pragma unroll
              for (int e = 0; e < 4; ++e) kq[e] = *(const v4u*)(pr + e * 8); }
#pragma unroll
          for (int e = 0; e < 4; ++e) *(LAS v4u*)(Kl + key * 72 + half * 32 + e * 8) = kq[e]; }
        { const int key = tid & 255, dh = tid >> 8; const int tk = n * 128 - 128 + key;
          v4u vq[4];
#pragma unroll
          for (int e = 0; e < 4; ++e) vq[e] = (v4u){0u, 0u, 0u, 0u};
          if (tk >= 0) { const bf16* pr = P + (size_t)(b * SEQ + tk) * ODD_IN + C_VC + kvh * 64 + dh * 32;
#pragma unroll
              for (int e = 0; e < 4; ++e) vq[e] = *(const v4u*)(pr + e * 8); }
#pragma unroll
          for (int e = 0; e < 4; ++e) { LAS bf16* vd = Vt + (dh * 32 + e * 8) * 260 + key;
              vd[0 * 260] = (bf16)(vq[e].x & 0xffffu); vd[1 * 260] = (bf16)(vq[e].x >> 16); vd[2 * 260] = (bf16)(vq[e].y & 0xffffu); vd[3 * 260] = (bf16)(vq[e].y >> 16);
              vd[4 * 260] = (bf16)(vq[e].z & 0xffffu); vd[5 * 260] = (bf16)(vq[e].z >> 16); vd[6 * 260] = (bf16)(vq[e].w & 0xffffu); vd[7 * 260] = (bf16)(vq[e].w >> 16); } }
        __syncthreads();
        const int h = kvh * 8 + wave;
        const float slope = exp2f(-0.5f * (float)(h + 1)), sink = a.in[I_OSINKS][h];
#pragma unroll 1
        for (int i = 0; i < 4; ++i) {
            const size_t rowq = (size_t)(b * SEQ + n * 128 + 32 * i + l31);
            bf16x8 qf[4];
#pragma unroll
            for (int ks = 0; ks < 4; ++ks) qf[ks] = *(const bf16x8*)(P + rowq * ODD_IN + C_Q + h * 64 + 16 * ks + 8 * hi);
            f32x16 st[5];
#pragma unroll
            for (int tt = 0; tt < 5; ++tt) { f32x16 acc = {0.f, 0.f, 0.f, 0.f, 0.f, 0.f, 0.f, 0.f, 0.f, 0.f, 0.f, 0.f, 0.f, 0.f, 0.f, 0.f};
#pragma unroll
                for (int ks = 0; ks < 4; ++ks) { const bf16x8 kf = *(const LAS bf16x8*)(Kl + (32 * (i + tt) + l31) * 72 + 16 * ks + 8 * hi);
                    acc = __builtin_amdgcn_mfma_f32_32x32x16_bf16(kf, qf[ks], acc, 0, 0, 0); }
                st[tt] = acc; }
            int lbv = l31 - 4 * hi; float sbv = -slope * (float)(l31 + 128 - 4 * hi);
            asm volatile("" : "+v"(lbv), "+v"(sbv));
            float mx = sink;
#pragma unroll
            for (int tt = 0; tt < 5; ++tt) { const bool tile_ok = (n > 0) || (i + tt >= 4);
#pragma unroll
                for (int r = 0; r < 16; ++r) { const int cr = (r & 3) + 8 * (r >> 2);
                    float s = fmaf(st[tt][r], 0.125f, sbv); s = fmaf(slope, (float)(32 * tt + cr), s);
                    if (tt == 0) s = (cr > lbv) ? s : -INFINITY;
                    if (tt == 4) s = (cr <= lbv) ? s : -INFINITY;
                    s = tile_ok ? s : -INFINITY;
                    st[tt][r] = s; mx = fmaxf(mx, s); } }
            { auto rr = __builtin_amdgcn_permlane32_swap(__float_as_uint(mx), __float_as_uint(mx), false, false); mx = fmaxf(__uint_as_float(rr[0]), __uint_as_float(rr[1])); }
            float ls = 0.f;
#pragma unroll
            for (int tt = 0; tt < 5; ++tt)
#pragma unroll
                for (int r = 0; r < 16; ++r) { const float p = __expf(st[tt][r] - mx); st[tt][r] = p; ls += p; }
            { auto rr = __builtin_amdgcn_permlane32_swap(__float_as_uint(ls), __float_as_uint(ls), false, false); ls = __uint_as_float(rr[0]) + __uint_as_float(rr[1]); }
            const float inv = 1.f / (ls + __expf(sink - mx));
            f32x16 o[2];
#pragma unroll
            for (int dt = 0; dt < 2; ++dt) o[dt] = (f32x16){0.f, 0.f, 0.f, 0.f, 0.f, 0.f, 0.f, 0.f, 0.f, 0.f, 0.f, 0.f, 0.f, 0.f, 0.f, 0.f};
#pragma unroll
            for (int tt = 0; tt < 5; ++tt)
#pragma unroll
                for (int s2 = 0; s2 < 2; ++s2) {
                    v4u pw; pw.x = cvtpk(st[tt][8 * s2 + 0] * inv, st[tt][8 * s2 + 1] * inv); pw.y = cvtpk(st[tt][8 * s2 + 2] * inv, st[tt][8 * s2 + 3] * inv);
                    pw.z = cvtpk(st[tt][8 * s2 + 4] * inv, st[tt][8 * s2 + 5] * inv); pw.w = cvtpk(st[tt][8 * s2 + 6] * inv, st[tt][8 * s2 + 7] * inv);
                    const bf16x8 pa = __builtin_bit_cast(bf16x8, pw);
                    const int kb = 32 * (i + tt) + 16 * s2 + 4 * hi;
#pragma unroll
                    for (int dt = 0; dt < 2; ++dt) { const LAS bf16* vp = Vt + (dt * 32 + l31) * 260 + kb;
                        const u32x2 v0 = *(const LAS u32x2*)vp, v1 = *(const LAS u32x2*)(vp + 8);
                        v4u vw; vw.x = v0.x; vw.y = v0.y; vw.z = v1.x; vw.w = v1.y;
                        o[dt] = __builtin_amdgcn_mfma_f32_32x32x16_bf16(pa, __builtin_bit_cast(bf16x8, vw), o[dt], 0, 0, 0); } }
#pragma unroll
            for (int dt = 0; dt < 2; ++dt)
#pragma unroll
                for (int r = 0; r < 16; ++r) { const size_t row = (size_t)(b * SEQ + n * 128 + 32 * i + crow(r, hi)); const int d = h * 64 + dt * 32 + l31;
                    const float z = bf2f(P[row * ODD_IN + C_Z1 + d]);
                    MIX[row * D + d] = (bf16)f2bf(o[dt][r] * siluf(z)); if ((r & 3) == 3) asm volatile("" ::: "memory"); }
        }
    }
}
__global__ void __launch_bounds__(NWAVES * 64, 2) mk_fwd(Args args) {
    extern __shared__ __attribute__((aligned(16))) unsigned char lds_raw[];
    LAS unsigned char* lds = (LAS unsigned char*)lds_raw;
    volatile LAS unsigned* MISC = (volatile LAS unsigned*)(lds + MISC_OFF);
    const int tid = threadIdx.x, lane = tid & 63, wave = __builtin_amdgcn_readfirstlane(tid >> 6);
    const int G = gridDim.x; const int bx = blockIdx.x; const int vcu = (G % 8 == 0) ? (bx % 8) * (G / 8) + bx / 8 : bx;
    unsigned char* ws = args.ws;
    gu32* ctl = (gu32*)(ws + WS_CTL);
    for (int u = tid; u < (LDS_BYTES - LDSCTL_OFF) / 4; u += NWAVES * 64) ((LAS unsigned*)(lds + LDSCTL_OFF))[u] = 0u;
    __syncthreads();
    XcdBarrier bar = xcd_barrier_post((unsigned*)(ctl + CW_BAR), MISC + 8);
    const int lo = args.ph_lo, hi = args.ph_hi;
#define IN(k) (lo <= (k) && (k) < hi)
#define GRID_BAR() xcd_barrier(bar)
    float* mod = (float*)(ws + WS_MOD);
    bf16* XN = (bf16*)(ws + WS_XN); bf16* MIX = (bf16*)(ws + WS_MIX); bf16* P = (bf16*)(ws + WS_P);

    if (IN(0)) { phase0(args, lds, tid, lane, wave, vcu, G); GRID_BAR(); }
    if (IN(1)) { phase_adaln_rows(args.in[I_X], args.in[I_NORMG], mod, XN, lane, wave, vcu, G); GRID_BAR(); }
    if (IN(2)) {
        pg8::Gemm g{XN, (const bf16*)(ws + WS_WIN0), M, EVEN_PAD, D}; pg8::StaticOrder S; S.init(M, EVEN_PAD, G, (int)blockIdx.x);
        pg8::EpiBf16 E{P, EVEN_PAD};
        pg8::gemm_phase<pg8::EpiBf16, pg8::StaticOrder, PG8_ALIGN, PG8_SP2>(lds, g, S, E);
        GRID_BAR();
    }
    if (IN(3)) { phase_rwkv2(args, lds, tid, lane, wave, vcu, G); phase_gmlp(args, lds, tid, lane, wave, vcu, G); GRID_BAR(); phase_finish(args, lane, wave, vcu, G); GRID_BAR(); }
    if (IN(4)) {
        pg8::Gemm g{MIX, (const bf16*)(ws + WS_WOUT0), M, D, D}; pg8::StaticOrder S; S.init(M, D, G, (int)blockIdx.x);
        pg8::EpiResGate E{args.in[I_X], args.out, mod + 2048};
        pg8::gemm_phase<pg8::EpiResGate, pg8::StaticOrder, PG8_ALIGN, PG8_SP2>(lds, g, S, E);
        GRID_BAR();
    }
    if (IN(5)) { phase_adaln_rows(args.out, args.in[I_NORMG] + D, mod + 16 * 3072, XN, lane, wave, vcu, G); GRID_BAR(); }
    if (IN(6)) {
        pg8::Gemm g{XN, (const bf16*)(ws + WS_WIN1), M, ODD_IN, D}; pg8::StaticOrder S; S.init(M, ODD_IN, G, (int)blockIdx.x);
        pg8::EpiBf16 E{P, ODD_IN};
        pg8::gemm_phase<pg8::EpiBf16, pg8::StaticOrder, PG8_ALIGN, PG8_SP2>(lds, g, S, E);
        GRID_BAR();
    }
    if (IN(7)) { phase_swa2(args, lds, tid, lane, wave, vcu, G); GRID_BAR(); }
    if (IN(8)) {
        pg8::Gemm g{MIX, (const bf16*)(ws + WS_WOUT1), M, D, D}; pg8::StaticOrder S; S.init(M, D, G, (int)blockIdx.x);
        pg8::EpiResGate E{args.out, args.out, mod + 16 * 3072 + 2048};
        pg8::gemm_phase<pg8::EpiResGate, pg8::StaticOrder, PG8_ALIGN, PG8_SP2>(lds, g, S, E);
        GRID_BAR();
    }
    if (IN(9)) { phase_final_rows(args.out, args.in[I_FINALG], lane, wave, vcu, G); }
#undef IN
#undef GRID_BAR
}

extern "C" void kernel_launch(void* const* d_in, const int* in_sizes, int n_in, void* d_out, int out_size, void* d_ws, size_t ws_size, hipStream_t stream) {
    static int grid = 0;
    if (grid == 0) {
        if (n_in != N_IN || in_sizes[0] != M * D || out_size != M * D || ws_size < WS_END) { fprintf(stderr, "kernel_launch: unexpected shapes (n_in %d, in0 %d, out %d, ws %zu); nothing launched\n", n_in, n_in > 0 ? in_sizes[0] : -1, out_size, ws_size); grid = -1; return; }
        int dev = 0, cus = 0, per_cu = 0;
        if (hipGetDevice(&dev) != hipSuccess || hipDeviceGetAttribute(&cus, hipDeviceAttributeMultiprocessorCount, dev) != hipSuccess) { grid = -1; return; }
        if (hipFuncSetAttribute((const void*)mk_fwd, hipFuncAttributeMaxDynamicSharedMemorySize, LDS_BYTES) != hipSuccess) { fprintf(stderr, "kernel_launch: hipFuncSetAttribute failed\n"); grid = -1; return; }
        if (hipOccupancyMaxActiveBlocksPerMultiprocessor(&per_cu, (const void*)mk_fwd, NWAVES * 64, LDS_BYTES) != hipSuccess || per_cu < 1) fprintf(stderr, "kernel_launch: note: occupancy query reports %d\n", per_cu);
        (void)hipGetLastError();
        grid = cus;
    }
    if (grid < 0) return;
    if (hipMemsetAsync((char*)d_ws + WS_CTL, 0, CTL_ZERO_BYTES, stream) != hipSuccess) { fprintf(stderr, "kernel_launch: memset failed\n"); return; }
    Args a{};
    for (int i = 0; i < N_IN; ++i) a.in[i] = (const float*)d_in[i];
    a.out = (float*)d_out; a.ws = (unsigned char*)d_ws; a.ph_lo = 0; a.ph_hi = 10;
    hipLaunchKernelGGL(mk_fwd, dim3(grid), dim3(NWAVES * 64), LDS_BYTES, stream, a);
}
```

```cpp
#include <hip/hip_runtime.h>
#include <cstdio>
#include <cstdint>
namespace pg8 {
#define PG8_LAS __attribute__((address_space(3)))
typedef unsigned short bf16_t;
typedef short bf16x8 __attribute__((ext_vector_type(8)));
typedef float f32x4 __attribute__((ext_vector_type(4)));
typedef unsigned u32x4 __attribute__((ext_vector_type(4)));
constexpr int BM = 256, BK = 64, HALF = 128, HTB = HALF * BK * 2  , STAGE_BYTES = 8 * HTB, NXCD = 8, WGM = 8;

__host__ __device__ __forceinline__ int lds_byte(int r, int c) { const int st = (r >> 4) * 2 + (c >> 5), rr = r & 15, cc = c & 31, ob = rr * 64 + cc * 2; return st * 1024 + (ob ^ (((ob >> 9) & 1) << 5)); }
__host__ __device__ __forceinline__ void stage_rc(int b, int& R, int& C) { const int st = b / 1024, sb = b % 1024, swz = sb ^ (((sb >> 9) & 1) << 5); R = (st >> 1) * 16 + swz / 64; C = (st & 1) * 32 + (swz % 64) / 2; }
__host__ __device__ __forceinline__ int perm32(int rho) { const int n = rho >> 4, i = rho & 15; return 8 * (i >> 2) + 4 * n + (i & 3); }

struct Unit { int pm, pn; };
struct Gemm { const bf16_t* A; const bf16_t* Bt; int M, N, K; };

struct StaticOrder {
    int nM, nN, nwg, G, c;
    __host__ __device__ void init(int M, int N, int G_, int c_) { nM = M / BM; nN = N / BM; nwg = nM * nN; G = G_; c = c_; }
    __host__ __device__ bool next(int i, Unit& u) const {
        const long L = (long)i * G + c; if (L >= nwg) return false;
        int wgid = (int)L; { const int q = nwg / NXCD, r = nwg % NXCD, xcd = wgid % NXCD, off = wgid / NXCD; wgid = (xcd < r ? xcd * (q + 1) : r * (q + 1) + (xcd - r) * q) + off; }
        const int nig = WGM * nN, gid = wgid / nig, fm = gid * WGM, gsz = (nM - fm) < WGM ? (nM - fm) : WGM;
        u.pm = fm + ((wgid % nig) % gsz); u.pn = (wgid % nig) / gsz; return true;
    }
    __device__ __forceinline__ void a_ready(const Unit&) const {}
    __device__ __forceinline__ void done(const Unit&) const {}
};

__device__ __forceinline__ unsigned cvt_pk_bf16(float lo, float hi) { unsigned r; asm volatile("v_cvt_pk_bf16_f32 %0, %1, %2" : "=v"(r) : "v"(lo), "v"(hi)); return r; }
struct EpiBf16 {
    static constexpr bool PERM = true, AFTER_DRAIN = false;
    bf16_t* O; int ldc;
    __device__ __forceinline__ void operator()(const f32x4 (&acc)[2][2][4][2], const Unit& u, int wr, int wc, int fr, int fq) const {
        const int row0 = u.pm * BM + wr * 64 + fr; const int col0 = u.pn * BM + wc * 32 + 8 * fq;
#pragma unroll
        for (int ai = 0; ai < 2; ++ai)
#pragma unroll
            for (int m = 0; m < 4; ++m) { bf16_t* rowp = O + (size_t)(row0 + ai * HALF + m * 16) * ldc + col0;
#pragma unroll
                for (int bj = 0; bj < 2; ++bj) { const f32x4 v0 = acc[ai][bj][m][0], v1 = acc[ai][bj][m][1];
                    u32x4 w; w.x = cvt_pk_bf16(v0[0], v0[1]); w.y = cvt_pk_bf16(v0[2], v0[3]); w.z = cvt_pk_bf16(v1[0], v1[1]); w.w = cvt_pk_bf16(v1[2], v1[3]);
                    *(u32x4*)(rowp + bj * HALF) = w; } }
    }
};
struct EpiResGate {
    static constexpr bool PERM = false, AFTER_DRAIN = false;
    const float* base; float* out; const float* gate;
    __device__ __forceinline__ void operator()(const f32x4 (&acc)[2][2][4][2], const Unit& u, int wr, int wc, int fr, int fq) const {
        const int col0 = u.pn * BM + wc * 32 + 4 * fq; const int b = (u.pm * BM) >> 11;
        f32x4 gv[2][2];
#pragma unroll
        for (int bj = 0; bj < 2; ++bj)
#pragma unroll
            for (int n = 0; n < 2; ++n) gv[bj][n] = *(const f32x4*)(gate + (size_t)b * 3072 + col0 + bj * HALF + n * 16);
#pragma unroll
        for (int ai = 0; ai < 2; ++ai)
#pragma unroll
            for (int m = 0; m < 4; ++m) { const size_t off = (size_t)(u.pm * BM + ai * HALF + wr * 64 + m * 16 + fr) * 1024 + col0;
#pragma unroll
                for (int bj = 0; bj < 2; ++bj)
#pragma unroll
                    for (int n = 0; n < 2; ++n) { const f32x4 bs = *(const f32x4*)(base + off + bj * HALF + n * 16);
                        *(f32x4*)(out + off + bj * HALF + n * 16) = bs + gv[bj][n] * acc[ai][bj][m][n]; } }
    }
};

template <class Epi, class Sched, bool ALIGN_EPI = false, bool SP2 = false>
__device__ __forceinline__ void gemm_phase(PG8_LAS unsigned char* lds, const Gemm g, const Sched& S, const Epi& E) {
    const int tid = threadIdx.x, wid = __builtin_amdgcn_readfirstlane(tid >> 6), lane = tid & 63, wr = wid >> 2, wc = wid & 3, fr = lane & 15, fq = lane >> 4;
    const int K = g.K, nt = K / BK;
    unsigned voffA[2], voffB[2];
#pragma unroll
    for (int i = 0; i < 2; ++i) { int R, C; stage_rc(tid * 16 + i * 8192, R, C); const int Rb = Epi::PERM ? ((R & ~31) + perm32(R & 31)) : R;
        voffA[i] = (unsigned)(R * K + C) * 2u; voffB[i] = (unsigned)(Rb * K + C) * 2u; }
    const size_t kstep = (size_t)(BK * 2);
    const size_t hstep = (size_t)HALF * K * 2;
    const size_t tstep = 2 * hstep;
    const unsigned ldsw = (unsigned)wid * 1024u;
    const int aoff = lds_byte(wr * 64 + fr, fq * 8), boff = lds_byte(wc * 32 + fr, fq * 8);
#define PG8_SA(b, h) (((b) * 2 + (h)) * HTB)
#define PG8_SB(b, h) ((4 + (b) * 2 + (h)) * HTB)
#define PG8_STAGE(bufoff, gbase, voff) do { _Pragma("unroll") for (int _i = 0; _i < 2; ++_i) \
        __builtin_amdgcn_global_load_lds((const unsigned*)((const char*)(gbase) + (voff)[_i]), (PG8_LAS unsigned*)(lds + (bufoff) + ldsw + _i * 8192), 16, 0, 0); } while (0)
#define PG8_LDA(dst, b, h) do { _Pragma("unroll") for (int m = 0; m < 4; ++m) _Pragma("unroll") for (int k = 0; k < 2; ++k) dst[m][k] = *(const PG8_LAS bf16x8*)(lds + PG8_SA(b, h) + aoff + m * 2048 + k * 1024); } while (0)
#define PG8_LDB(dst, b, h) do { _Pragma("unroll") for (int n = 0; n < 2; ++n) _Pragma("unroll") for (int k = 0; k < 2; ++k) dst[n][k] = *(const PG8_LAS bf16x8*)(lds + PG8_SB(b, h) + boff + n * 2048 + k * 1024); } while (0)
#define PG8_MMA(ai, bj, At, Bt) do { __builtin_amdgcn_s_setprio(1); _Pragma("unroll") for (int m = 0; m < 4; ++m) _Pragma("unroll") for (int n = 0; n < 2; ++n) _Pragma("unroll") for (int k = 0; k < 2; ++k) \
        acc[ai][bj][m][n] = __builtin_amdgcn_mfma_f32_16x16x32_bf16(Bt[n][k], At[m][k], acc[ai][bj][m][n], 0, 0, 0); __builtin_amdgcn_s_setprio(0); } while (0)
#define PG8_WAIT_V(n) asm volatile("s_waitcnt vmcnt(" #n ")" ::: "memory")
#define PG8_WAIT_L(n) asm volatile("s_waitcnt lgkmcnt(" #n ")" ::: "memory")
#define PG8_BAR __builtin_amdgcn_s_barrier()
#define PG8_SCHED __builtin_amdgcn_sched_barrier(0)
    Unit cur, nxt; int ui = 0;
    if (!S.next(0, cur)) return;
    f32x4 acc[2][2][4][2];
#pragma unroll
    for (int a = 0; a < 2; ++a)
#pragma unroll
        for (int b = 0; b < 2; ++b)
#pragma unroll
            for (int m = 0; m < 4; ++m)
#pragma unroll
                for (int n = 0; n < 2; ++n) acc[a][b][m][n] = (f32x4){0.f, 0.f, 0.f, 0.f};
    bf16x8 At[4][2], B0[2][2], B1[2][2];
    const char* cA = (const char*)g.A + (size_t)cur.pm * tstep; const char* cB = (const char*)g.Bt + (size_t)cur.pn * tstep;
    S.a_ready(cur);
    if constexpr (SP2) {
        PG8_STAGE(PG8_SB(0, 0), cB, voffB); PG8_STAGE(PG8_SB(0, 1), cB + hstep, voffB); PG8_STAGE(PG8_SA(0, 0), cA, voffA); PG8_STAGE(PG8_SA(0, 1), cA + hstep, voffA);
        if (wr == 1) PG8_BAR;
        PG8_WAIT_V(2); PG8_BAR;
        PG8_STAGE(PG8_SB(1, 0), cB + kstep, voffB); PG8_STAGE(PG8_SA(1, 0), cA + kstep, voffA); PG8_STAGE(PG8_SB(1, 1), cB + hstep + kstep, voffB);
        PG8_WAIT_V(6); PG8_BAR;
    } else {
        PG8_STAGE(PG8_SB(0, 0), cB, voffB); PG8_STAGE(PG8_SA(0, 0), cA, voffA); PG8_STAGE(PG8_SB(0, 1), cB + hstep, voffB); PG8_STAGE(PG8_SA(0, 1), cA + hstep, voffA);
        if (wr == 1) PG8_BAR;
        PG8_WAIT_V(4); PG8_BAR;
        PG8_STAGE(PG8_SB(1, 0), cB + kstep, voffB); PG8_STAGE(PG8_SA(1, 0), cA + kstep, voffA); PG8_STAGE(PG8_SB(1, 1), cB + hstep + kstep, voffB);
        PG8_WAIT_V(6); PG8_BAR;
    }
    for (;;) {
        const bool has_next = S.next(ui + 1, nxt);
        const char* nA = has_next ? (const char*)g.A + (size_t)nxt.pm * tstep : cA; const char* nB = has_next ? (const char*)g.Bt + (size_t)nxt.pn * tstep : cB;
        for (int t = 0; t < nt; t += 2) {
            const bool last = (t == nt - 2);
            const char* a1 = cA + (size_t)(t + 1) * kstep;
            const char* a2 = last ? nA : cA + (size_t)(t + 2) * kstep; const char* b2 = last ? nB : cB + (size_t)(t + 2) * kstep;
            const char* a3 = a2 + kstep; const char* b3 = b2 + kstep;
            if (last && has_next) S.a_ready(nxt);
            if constexpr (SP2) {
            PG8_LDB(B0, 0, 0); PG8_LDB(B1, 0, 1); PG8_SCHED; PG8_LDA(At, 0, 0); PG8_STAGE(PG8_SA(1, 1), a1 + hstep, voffA);
            PG8_WAIT_V(8); PG8_WAIT_L(0); PG8_BAR; PG8_MMA(0, 0, At, B0); PG8_MMA(0, 1, At, B1); PG8_BAR; PG8_SCHED;
            PG8_LDA(At, 0, 1); PG8_STAGE(PG8_SB(0, 0), b2, voffB); PG8_STAGE(PG8_SB(0, 1), b2 + hstep, voffB); PG8_STAGE(PG8_SA(0, 0), a2, voffA);
            PG8_WAIT_V(8); PG8_WAIT_L(0); PG8_BAR; PG8_MMA(1, 0, At, B0); PG8_MMA(1, 1, At, B1); PG8_BAR; PG8_SCHED;
            PG8_LDB(B0, 1, 0); PG8_LDB(B1, 1, 1); PG8_SCHED; PG8_LDA(At, 1, 0); PG8_STAGE(PG8_SA(0, 1), a2 + hstep, voffA);
            PG8_WAIT_V(8); PG8_WAIT_L(0); PG8_BAR; PG8_MMA(0, 0, At, B0); PG8_MMA(0, 1, At, B1); PG8_BAR; PG8_SCHED;
            PG8_LDA(At, 1, 1); PG8_STAGE(PG8_SB(1, 0), b3, voffB); PG8_STAGE(PG8_SB(1, 1), b3 + hstep, voffB); PG8_STAGE(PG8_SA(1, 0), a3, voffA);
            PG8_WAIT_V(8); PG8_WAIT_L(0); PG8_BAR; PG8_MMA(1, 0, At, B0); PG8_MMA(1, 1, At, B1); PG8_BAR; PG8_SCHED;
            } else {
            PG8_LDB(B0, 0, 0); PG8_SCHED; PG8_LDA(At, 0, 0); PG8_STAGE(PG8_SA(1, 1), a1 + hstep, voffA);
            PG8_WAIT_L(8); PG8_BAR; PG8_WAIT_L(0); PG8_MMA(0, 0, At, B0); PG8_BAR; PG8_SCHED;
            PG8_LDB(B1, 0, 1); PG8_STAGE(PG8_SB(0, 0), b2, voffB);
            PG8_BAR; PG8_WAIT_L(0); PG8_MMA(0, 1, At, B1); PG8_BAR;
            PG8_LDA(At, 0, 1); PG8_STAGE(PG8_SA(0, 0), a2, voffA);
            PG8_BAR; PG8_WAIT_L(0); PG8_MMA(1, 0, At, B0); PG8_BAR; PG8_SCHED;
            PG8_STAGE(PG8_SB(0, 1), b2 + hstep, voffB);
            PG8_WAIT_V(6); PG8_BAR; PG8_MMA(1, 1, At, B1); PG8_BAR;
            PG8_LDB(B0, 1, 0); PG8_SCHED; PG8_LDA(At, 1, 0); PG8_STAGE(PG8_SA(0, 1), a2 + hstep, voffA);
            PG8_WAIT_L(8); PG8_BAR; PG8_WAIT_L(0); PG8_MMA(0, 0, At, B0); PG8_BAR; PG8_SCHED;
            PG8_LDB(B1, 1, 1); PG8_STAGE(PG8_SB(1, 0), b3, voffB);
            PG8_BAR; PG8_WAIT_L(0); PG8_MMA(0, 1, At, B1); PG8_BAR;
            PG8_LDA(At, 1, 1); PG8_STAGE(PG8_SA(1, 0), a3, voffA);
            PG8_BAR; PG8_WAIT_L(0); PG8_MMA(1, 0, At, B0); PG8_BAR; PG8_SCHED;
            PG8_STAGE(PG8_SB(1, 1), b3 + hstep, voffB);
            PG8_WAIT_V(6); PG8_BAR; PG8_MMA(1, 1, At, B1); PG8_BAR;
            }
        }
        if constexpr (ALIGN_EPI) { if (wr == 0) PG8_BAR; }
        if constexpr (!Epi::AFTER_DRAIN) { E(acc, cur, wr, wc, fr, fq); S.done(cur); }
        if (!has_next) break;
#pragma unroll
        for (int a = 0; a < 2; ++a)
#pragma unroll
            for (int b = 0; b < 2; ++b)
#pragma unroll
                for (int m = 0; m < 4; ++m)
#pragma unroll
                    for (int n = 0; n < 2; ++n) acc[a][b][m][n] = (f32x4){0.f, 0.f, 0.f, 0.f};
        cur = nxt; cA = nA; cB = nB; ++ui;
        if constexpr (ALIGN_EPI) { if (wr == 1) PG8_BAR; }
    }
    PG8_WAIT_V(0);
    if constexpr (!ALIGN_EPI) { if (wr == 0) PG8_BAR; }
    PG8_BAR;
    if constexpr (Epi::AFTER_DRAIN) { E.fused(acc, cur, wr, wc, fr, fq, lds, wid, lane); S.done(cur); }
#undef PG8_SA
#undef PG8_SB
#undef PG8_STAGE
#undef PG8_LDA
#undef PG8_LDB
#undef PG8_MMA
#undef PG8_WAIT_V
#undef PG8_WAIT_L
#undef PG8_BAR
#undef PG8_SCHED
}
}

#ifndef PG8_SP2
#define PG8_SP2 true
#endif
#ifndef PG8_ALIGN
#define PG8_ALIGN true
#endif
#define GAS __attribute__((address_space(1)))
#define LAS __attribute__((address_space(3)))
typedef unsigned short bf16;
typedef unsigned v4u __attribute__((ext_vector_type(4)));
typedef float f32x4 __attribute__((ext_vector_type(4)));
typedef short bf16x8 __attribute__((ext_vector_type(8)));
typedef GAS unsigned gu32;
typedef GAS unsigned long long gu64;
#define RLX_AGENT __ATOMIC_RELAXED, __HIP_MEMORY_SCOPE_AGENT
#define LDS_WAIT() asm volatile("s_waitcnt lgkmcnt(0)" ::: "memory")
#define VM_WAIT() asm volatile("s_waitcnt vmcnt(0)" ::: "memory")
__device__ __forceinline__ unsigned long long rt() { return __builtin_amdgcn_s_memrealtime(); }
__device__ __forceinline__ unsigned f2bf(float f) { unsigned u = __builtin_bit_cast(unsigned, f); return (u + 0x7fffu + ((u >> 16) & 1u)) >> 16; }
__device__ __forceinline__ unsigned pk2(float lo, float hi) { return f2bf(lo) | (f2bf(hi) << 16); }

#define XB_TMO      128
#define XB_XCNT(j)  (256  + 64 * (j))
#define XB_XSUB(j)  (1280 + 64 * (j))
#define XB_XGEN(j)  (2304 + 64 * (j))
#define XB_TOP      3328
#define XB_TOPGEN   3392
#define XCD_BAR_WORDS 3456
#define XB_SPIN_CAP (1u << 22)

__device__ __forceinline__ unsigned xb_ld(unsigned* p)              { return __hip_atomic_load(p, __ATOMIC_RELAXED, __HIP_MEMORY_SCOPE_AGENT); }
__device__ __forceinline__ unsigned xb_add(unsigned* p, unsigned v) { return __hip_atomic_fetch_add(p, v, __ATOMIC_RELAXED, __HIP_MEMORY_SCOPE_AGENT); }
__device__ __forceinline__ unsigned xb_xcc_id() { return (unsigned)__builtin_amdgcn_s_getreg((3 << 11) | 20) & 0xFu; }
#define XB_SPIN(cond, bar) do { unsigned _sp = 0; while (cond) { __builtin_amdgcn_s_sleep(1); \
    if ((++_sp & 255u) == 0u) { if (xb_ld(&(bar)[XB_TMO])) break; if (_sp > XB_SPIN_CAP) { atomicAdd(&(bar)[XB_TMO], 1u); break; } } } } while (0)

struct XcdBarrier {
    unsigned* bar; unsigned x;
    volatile LAS unsigned* st;
};

__device__ __forceinline__ XcdBarrier xcd_barrier_post(unsigned* bar, volatile LAS unsigned* st) {
    XcdBarrier b; b.bar = bar; b.x = xb_xcc_id(); b.st = st;
    if (threadIdx.x == 0) (void)xb_add(&bar[XB_XCNT(b.x)], 1u);
    return b;
}
__device__ __forceinline__ void xcd_barrier_complete(unsigned* bar, unsigned x, unsigned& nloc, unsigned& nx) {
    const unsigned G = gridDim.x * gridDim.y * gridDim.z;
    unsigned sum, cnt, mine, sp = 0u;
    for (;;) {
        sum = 0u; cnt = 0u; mine = 0u;
#pragma unroll
        for (unsigned j = 0; j < 16; ++j) { const unsigned c = xb_ld(&bar[XB_XCNT(j)]); sum += c; cnt += (c > 0u) ? 1u : 0u; mine = (j == x) ? c : mine; }
        if (sum == G) break;
        __builtin_amdgcn_s_sleep(1);
        if ((++sp & 255u) == 0u) { if (xb_ld(&bar[XB_TMO])) break; if (sp > XB_SPIN_CAP) { atomicAdd(&bar[XB_TMO], 1u); break; } }
    }
    nloc = mine > 0u ? mine : 1u; nx = cnt > 0u ? cnt : 1u;
}

__device__ __forceinline__ void xcd_barrier(const XcdBarrier& b) {
    asm volatile("s_waitcnt vmcnt(0)" ::: "memory");
    __syncthreads();
    if (threadIdx.x == 0) {
        unsigned* bar = b.bar;
        __builtin_amdgcn_s_waitcnt(0);
        unsigned nloc = b.st[0], nx = b.st[1];
        if (nloc == 0u) { xcd_barrier_complete(bar, b.x, nloc, nx); b.st[0] = nloc; b.st[1] = nx; }
        const unsigned old = xb_add(&bar[XB_XSUB(b.x)], 1u);
        const unsigned gen = old / nloc;
        if (old + 1u == (gen + 1u) * nloc) {
            __builtin_amdgcn_fence(__ATOMIC_RELEASE, "agent");
            asm volatile("s_waitcnt vmcnt(0)" ::: "memory");
            const unsigned og = xb_add(&bar[XB_TOP], 1u);
            const unsigned tg = og / nx;
            if (og + 1u == (tg + 1u) * nx) xb_add(&bar[XB_TOPGEN], 1u);
            else XB_SPIN(xb_ld(&bar[XB_TOPGEN]) == tg, bar);
            __builtin_amdgcn_fence(__ATOMIC_ACQUIRE, "agent");
            xb_add(&bar[XB_XGEN(b.x)], 1u);
            asm volatile("s_waitcnt vmcnt(0)" ::: "memory");
        } else {
            XB_SPIN(xb_ld(&bar[XB_XGEN(b.x)]) == gen, bar);
            __builtin_amdgcn_fence(__ATOMIC_ACQUIRE, "agent");
            asm volatile("s_waitcnt vmcnt(0)" ::: "memory");
        }
    }
    __syncthreads();
}


constexpr int NWAVES = 8;
constexpr int BATCH = 16, SEQ = 2048, D = 1024, M = BATCH * SEQ;
constexpr int EVEN_IN = 3712, EVEN_PAD = 3840, ODD_IN = 2304;
constexpr int C_R = 0, C_K = 512, C_V = 1024, C_WLO = 1536, C_ALO = 1600, C_U = 1664, C_VG = 2176, C_Z0 = 2688;
constexpr int C_Q = 0, C_KC = 1024, C_VC = 1152, C_Z1 = 1280;
enum { I_X = 0, I_C, I_ADAW, I_ADAB, I_NORMG, I_EWIN, I_EMU, I_EW0, I_EWUP, I_EA0, I_EAUP, I_EKK, I_EKA, I_ERK, I_ELNXG, I_ELNXB, I_ESGLNG, I_ESGLNB, I_ESGW, I_ESGB, I_EWOUT, I_OWIN, I_OSINKS, I_OWOUT, I_FINALG, N_IN };

constexpr size_t MiB = 1u << 20;
constexpr size_t WS_CTL = 0, CTL_ZERO_BYTES = 64 * 1024;
constexpr size_t WS_MOD = 1 * MiB;
constexpr size_t WS_WIN0 = 2 * MiB, WS_WOUT0 = 10 * MiB, WS_WIN1 = 12 * MiB, WS_WOUT1 = 17 * MiB;
constexpr size_t WS_XN = 32 * MiB, WS_MIX = 96 * MiB, WS_P = 160 * MiB, WS_YRAW = 400 * MiB, WS_BON = 464 * MiB, WS_END = 466 * MiB;
constexpr int CW_BAR = 4096;

constexpr int RING_BYTES = 131072, LDSCTL_OFF = RING_BYTES, MISC_OFF = LDSCTL_OFF + 320, LDS_BYTES = 147456;

__device__ __forceinline__ float bf2f(unsigned short h) { return __builtin_bit_cast(float, (unsigned)h << 16); }
__device__ __forceinline__ float bflo(unsigned w) { return __builtin_bit_cast(float, w << 16); }
__device__ __forceinline__ float bfhi(unsigned w) { return __builtin_bit_cast(float, w & 0xffff0000u); }
__device__ __forceinline__ float wave_sum(float v) {
#pragma unroll
    for (int o = 1; o < 64; o <<= 1) v += __shfl_xor(v, o);
    return v;
}
__device__ __forceinline__ float siluf(float x) { return x / (1.f + __expf(-x)); }

struct Args { const float* in[N_IN]; float* out; unsigned char* ws; int ph_lo, ph_hi; };

__device__ __forceinline__ void p0_transpose_item(const float* W, int K, int N, bf16* WT, LAS float* scr, int item, int lane) {
    const int nblk = N / 32, kb = item / nblk, nb = item % nblk, k0 = 64 * kb, n0 = 32 * nb;
#pragma unroll 8
    for (int i = 0; i < 32; ++i) { const int kk = 2 * i + (lane >> 5); scr[kk * 33 + (lane & 31)] = W[(size_t)(k0 + kk) * N + n0 + (lane & 31)]; }
    LDS_WAIT(); asm volatile("" ::: "memory");
    const int c = lane & 7;
#pragma unroll
    for (int j = 0; j < 4; ++j) { const int n = (lane >> 3) + 8 * j; const LAS float* s = scr + (8 * c) * 33 + n;
        v4u o; o.x = pk2(s[0 * 33], s[1 * 33]); o.y = pk2(s[2 * 33], s[3 * 33]); o.z = pk2(s[4 * 33], s[5 * 33]); o.w = pk2(s[6 * 33], s[7 * 33]);
        *(GAS v4u*)(WT + (size_t)(n0 + n) * K + k0 + 8 * c) = o; }
    LDS_WAIT(); asm volatile("" ::: "memory");
}
__device__ __forceinline__ void phase0(const Args& a, LAS unsigned char* lds, int tid, int lane, int wave, int vcu, int G) {
    unsigned char* ws = a.ws;
    if (vcu < 96) {
        LAS float* condT = (LAS float*)lds;
        LAS float* part = (LAS float*)(lds + 65536);
        const float* c = a.in[I_C];
        for (int idx = tid; idx < 16384; idx += 512) { const int b = idx >> 10, k = idx & 1023; condT[k * 16 + b] = siluf(c[idx]); }
        __syncthreads();
        for (int it = vcu; it < 96; it += G) {
            const int l = it / 48, n0 = (it % 48) * 64;
            const float* W = a.in[I_ADAW] + (size_t)l * 1024 * 3072 + n0 + lane;
            float acc[16];
#pragma unroll
            for (int b = 0; b < 16; ++b) acc[b] = 0.f;
            const int kbeg = wave * 128;
#pragma unroll 4
            for (int k = kbeg; k < kbeg + 128; ++k) {
                const float w = W[(size_t)k * 3072];
                const LAS f32x4* cv = (const LAS f32x4*)(condT + k * 16);
                const f32x4 c0 = cv[0], c1 = cv[1], c2 = cv[2], c3 = cv[3];
                acc[0] += c0[0] * w; acc[1] += c0[1] * w; acc[2] += c0[2] * w; acc[3] += c0[3] * w;
                acc[4] += c1[0] * w; acc[5] += c1[1] * w; acc[6] += c1[2] * w; acc[7] += c1[3] * w;
                acc[8] += c2[0] * w; acc[9] += c2[1] * w; acc[10] += c2[2] * w; acc[11] += c2[3] * w;
                acc[12] += c3[0] * w; acc[13] += c3[1] * w; acc[14] += c3[2] * w; acc[15] += c3[3] * w;
            }
#pragma unroll
            for (int b = 0; b < 16; ++b) part[(wave * 16 + b) * 64 + lane] = acc[b];
            __syncthreads();
            float* mod = (float*)(ws + WS_MOD);
#pragma unroll
            for (int q = 0; q < 2; ++q) { const int b = (tid >> 6) + 8 * q; float s = 0.f;
#pragma unroll
                for (int w8 = 0; w8 < 8; ++w8) s += part[(w8 * 16 + b) * 64 + lane];
                mod[(size_t)(l * 16 + b) * 3072 + n0 + lane] = s + a.in[I_ADAB][l * 3072 + n0 + lane]; }
            __syncthreads();
        }
    }
    __syncthreads();
    LAS float* scr = (LAS float*)(lds + wave * 16384);
    const int gw = vcu * NWAVES + wave, NGW = G * NWAVES;
    constexpr int I0 = (D / 64) * (EVEN_IN / 32), I1 = (D / 64) * (D / 32), I2 = (D / 64) * (ODD_IN / 32), I3 = I1, IZ = EVEN_PAD - EVEN_IN;
    for (int it = gw; it < I0 + I1 + I2 + I3 + IZ; it += NGW) {
        int r = it;
        if (r < I0) { p0_transpose_item(a.in[I_EWIN], D, EVEN_IN, (bf16*)(ws + WS_WIN0), scr, r, lane); continue; } r -= I0;
        if (r < I1) { p0_transpose_item(a.in[I_EWOUT], D, D, (bf16*)(ws + WS_WOUT0), scr, r, lane); continue; } r -= I1;
        if (r < I2) { p0_transpose_item(a.in[I_OWIN], D, ODD_IN, (bf16*)(ws + WS_WIN1), scr, r, lane); continue; } r -= I2;
        if (r < I3) { p0_transpose_item(a.in[I_OWOUT], D, D, (bf16*)(ws + WS_WOUT1), scr, r, lane); continue; } r -= I3;
        { GAS v4u* o = (GAS v4u*)((bf16*)(ws + WS_WIN0) + (size_t)(EVEN_IN + r) * D); const v4u z = {0u, 0u, 0u, 0u}; o[lane] = z; o[lane + 64] = z; }
    }
}

__device__ __forceinline__ void phase_adaln_rows(const float* xin, const float* g, const float* modl, bf16* XN, int lane, int wave, int vcu, int G) {
    const int gw = vcu * NWAVES + wave, NGW = G * NWAVES;
    for (int r0 = gw * 16; r0 < M; r0 += NGW * 16) {
        const int b = r0 >> 11;
        f32x4 gs[4], sh[4];
#pragma unroll
        for (int j = 0; j < 4; ++j) { const int c = 4 * lane + 256 * j;
            const f32x4 gg = *(const f32x4*)(g + c), sc = *(const f32x4*)(modl + (size_t)b * 3072 + 1024 + c);
            gs[j] = gg * (sc + 1.0f); sh[j] = *(const f32x4*)(modl + (size_t)b * 3072 + c); }
        for (int r = r0; r < r0 + 16; ++r) {
            const GAS f32x4* xr = (const GAS f32x4*)(xin + (size_t)r * D) + lane;
            f32x4 v[4]; float s = 0.f;
#pragma unroll
            for (int j = 0; j < 4; ++j) { v[j] = xr[64 * j]; s += (v[j].x * v[j].x + v[j].y * v[j].y) + (v[j].z * v[j].z + v[j].w * v[j].w); }
            const float rs = 1.0f / sqrtf(wave_sum(s) * (1.f / D) + 1e-6f);
            GAS unsigned long long* o8 = (GAS unsigned long long*)(XN + (size_t)r * D) + lane;
#pragma unroll
            for (int j = 0; j < 4; ++j) { const f32x4 o = v[j] * rs * gs[j] + sh[j];
                o8[64 * j] = (unsigned long long)pk2(o.x, o.y) | ((unsigned long long)pk2(o.z, o.w) << 32); }
        }
    }
}
__device__ __forceinline__ void phase_final_rows(float* xio, const float* g, int lane, int wave, int vcu, int G) {
    const int gw = vcu * NWAVES + wave, NGW = G * NWAVES;
    f32x4 gs[4];
#pragma unroll
    for (int j = 0; j < 4; ++j) gs[j] = *(const f32x4*)(g + 4 * lane + 256 * j);
    for (int r = gw; r < M; r += NGW) {
        GAS f32x4* xr = (GAS f32x4*)(xio + (size_t)r * D) + lane;
        f32x4 v[4]; float s = 0.f;
#pragma unroll
        for (int j = 0; j < 4; ++j) { v[j] = xr[64 * j]; s += (v[j].x * v[j].x + v[j].y * v[j].y) + (v[j].z * v[j].z + v[j].w * v[j].w); }
        const float rs = 1.0f / sqrtf(wave_sum(s) * (1.f / D) + 1e-6f);
#pragma unroll
        for (int j = 0; j < 4; ++j) xr[64 * j] = v[j] * rs * gs[j];
    }
}

__device__ __forceinline__ void phase_rwkv(const Args& a, LAS unsigned char* lds, int tid, int lane, int wave, int vcu, int G) {
    const bf16* P = (const bf16*)(a.ws + WS_P); bf16* MIX = (bf16*)(a.ws + WS_MIX);
    LAS float* WUP = (LAS float*)lds;
    LAS float* AUP = WUP + 4096;
    LAS float* TW = AUP + 4096;
    LAS float* AL = TW + 2048;
    LAS float* Rr = AL + 2048;
    LAS float* KR = Rr + 2048;
    LAS float* Vv = KR + 2048;
    LAS float* Wd = Vv + 2048;
    LAS float* KK = Wd + 2048;
    LAS float* Bb = KK + 2048;
    LAS float* Yy = Bb + 2048;
    LAS float* BON = Yy + 2048;
    for (int unit = vcu; unit < BATCH * 8; unit += G) {
        const int b = unit >> 3, h = unit & 7;
        __syncthreads();
        for (int idx = tid; idx < 4096; idx += 512) { const int m = idx >> 6, j = idx & 63; WUP[idx] = a.in[I_EWUP][m * 512 + h * 64 + j]; AUP[idx] = a.in[I_EAUP][m * 512 + h * 64 + j]; }
        float S[8];
#pragma unroll
        for (int j = 0; j < 8; ++j) S[j] = 0.f;
        const int hj = h * 64 + lane;
        const float w0 = a.in[I_EW0][hj], a0 = a.in[I_EA0][hj], k_k = a.in[I_EKK][hj], k_a = a.in[I_EKA][hj], r_k = a.in[I_ERK][hj], lng = a.in[I_ELNXG][hj], lnb = a.in[I_ELNXB][hj];
        for (int ck = 0; ck < SEQ / 32; ++ck) {
            const int t0 = ck * 32;
            { const int i = tid >> 4, sub = tid & 15; const int t = t0 + i; const bf16* pc = P + (size_t)(b * SEQ + t) * EVEN_PAD; const bf16* pp = pc - EVEN_PAD; const bool hasp = t > 0;
#pragma unroll
              for (int grp = 0; grp < 5; ++grp) {
                  const int col = (grp == 0 ? C_R + h * 64 : grp == 1 ? C_K + h * 64 : grp == 2 ? C_V + h * 64 : grp == 3 ? C_WLO : C_ALO) + 4 * sub;
                  const uint2 cu = *(const uint2*)(pc + col); uint2 pu = {0u, 0u}; if (hasp) pu = *(const uint2*)(pp + col);
                  const f32x4 mu = *(const f32x4*)(a.in[I_EMU] + col);
                  float cv[4] = {bflo(cu.x), bfhi(cu.x), bflo(cu.y), bfhi(cu.y)}, pv[4] = {bflo(pu.x), bfhi(pu.x), bflo(pu.y), bfhi(pu.y)};
                  f32x4 xs;
#pragma unroll
                  for (int e = 0; e < 4; ++e) xs[e] = cv[e] + mu[e] * (pv[e] - cv[e]);
                  if (grp == 3) { xs[0] = tanhf(xs[0]); xs[1] = tanhf(xs[1]); xs[2] = tanhf(xs[2]); xs[3] = tanhf(xs[3]); }
                  LAS float* dst = (grp == 0 ? Rr : grp == 1 ? KR : grp == 2 ? Vv : grp == 3 ? TW : AL) + i * 64 + 4 * sub;
                  *(LAS f32x4*)dst = xs;
              } }
            __syncthreads();
            { float accw[4] = {0.f, 0.f, 0.f, 0.f}, acca[4] = {0.f, 0.f, 0.f, 0.f};
              for (int m4 = 0; m4 < 16; ++m4) {
                  f32x4 tw[4], al[4];
#pragma unroll
                  for (int q = 0; q < 4; ++q) { tw[q] = *(const LAS f32x4*)(TW + (wave + 8 * q) * 64 + 4 * m4); al[q] = *(const LAS f32x4*)(AL + (wave + 8 * q) * 64 + 4 * m4); }
#pragma unroll
                  for (int e = 0; e < 4; ++e) { const float wu = WUP[(4 * m4 + e) * 64 + lane], au = AUP[(4 * m4 + e) * 64 + lane];
#pragma unroll
                      for (int q = 0; q < 4; ++q) { accw[q] += tw[q][e] * wu; acca[q] += al[q][e] * au; } }
              }
#pragma unroll
              for (int q = 0; q < 4; ++q) { const int i = wave + 8 * q;
                  const float wv = w0 + accw[q];
                  const float nx = -wv; const float sp = fmaxf(nx, 0.f) + log1pf(__expf(-fabsf(nx)));
                  const float wl = -sp - 0.5f; const float decay = __expf(-__expf(wl));
                  const float av = 1.f / (1.f + __expf(-(a0 + acca[q])));
                  const float kraw = KR[i * 64 + lane]; const float kkv = kraw * k_k;
                  const float ss = wave_sum(kkv * kkv); const float kk = kkv / fmaxf(sqrtf(ss), 1e-12f);
                  const float kp = kraw * (1.f + (av - 1.f) * k_a);
                  const float bon = wave_sum(Rr[i * 64 + lane] * kp * r_k);
                  Wd[i * 64 + lane] = decay; KR[i * 64 + lane] = kp; KK[i * 64 + lane] = kk; Bb[i * 64 + lane] = kk * av; if (lane == 0) BON[i] = bon; } }
            __syncthreads();
            { const int row = wave * 8 + (lane >> 3), c8 = (lane & 7) * 8;
              for (int i = 0; i < 32; ++i) {
                  const f32x4 k0 = *(const LAS f32x4*)(KK + i * 64 + c8), k1 = *(const LAS f32x4*)(KK + i * 64 + c8 + 4);
                  const f32x4 w0v = *(const LAS f32x4*)(Wd + i * 64 + c8), w1v = *(const LAS f32x4*)(Wd + i * 64 + c8 + 4);
                  const f32x4 b0 = *(const LAS f32x4*)(Bb + i * 64 + c8), b1 = *(const LAS f32x4*)(Bb + i * 64 + c8 + 4);
                  const f32x4 p0 = *(const LAS f32x4*)(KR + i * 64 + c8), p1 = *(const LAS f32x4*)(KR + i * 64 + c8 + 4);
                  const f32x4 r0 = *(const LAS f32x4*)(Rr + i * 64 + c8), r1 = *(const LAS f32x4*)(Rr + i * 64 + c8 + 4);
                  const float vv = Vv[i * 64 + row];
                  float sa = (S[0] * k0[0] + S[1] * k0[1]) + (S[2] * k0[2] + S[3] * k0[3]) + (S[4] * k1[0] + S[5] * k1[1]) + (S[6] * k1[2] + S[7] * k1[3]);
                  sa += __shfl_xor(sa, 1); sa += __shfl_xor(sa, 2); sa += __shfl_xor(sa, 4); sa = -sa;
                  S[0] = S[0] * w0v[0] + sa * b0[0] + vv * p0[0]; S[1] = S[1] * w0v[1] + sa * b0[1] + vv * p0[1];
                  S[2] = S[2] * w0v[2] + sa * b0[2] + vv * p0[2]; S[3] = S[3] * w0v[3] + sa * b0[3] + vv * p0[3];
                  S[4] = S[4] * w1v[0] + sa * b1[0] + vv * p1[0]; S[5] = S[5] * w1v[1] + sa * b1[1] + vv * p1[1];
                  S[6] = S[6] * w1v[2] + sa * b1[2] + vv * p1[2]; S[7] = S[7] * w1v[3] + sa * b1[3] + vv * p1[3];
                  float y = (S[0] * r0[0] + S[1] * r0[1]) + (S[2] * r0[2] + S[3] * r0[3]) + (S[4] * r1[0] + S[5] * r1[1]) + (S[6] * r1[2] + S[7] * r1[3]);
                  y += __shfl_xor(y, 1); y += __shfl_xor(y, 2); y += __shfl_xor(y, 4);
                  if ((lane & 7) == 0) Yy[i * 64 + row] = y;
              } }
            __syncthreads();
#pragma unroll
            for (int q = 0; q < 4; ++q) { const int i = wave * 4 + q; const size_t rowg = (size_t)(b * SEQ + t0 + i);
                const float y = Yy[i * 64 + lane]; const float mean = wave_sum(y) * (1.f / 64.f); const float d = y - mean; const float var = wave_sum(d * d) * (1.f / 64.f);
                const float o = d * (1.0f / sqrtf(var + 64e-5f)) * lng + lnb + BON[i] * Vv[i * 64 + lane];
                const float z = bf2f(P[rowg * EVEN_PAD + C_Z0 + hj]);
                MIX[rowg * D + hj] = (bf16)f2bf(o * siluf(z)); }
            __syncthreads();
        }
    }
}

typedef unsigned u32x2 __attribute__((ext_vector_type(2)));
#define DPP_ADD(x, ctrl) x += __builtin_bit_cast(float, __builtin_amdgcn_update_dpp(0, __builtin_bit_cast(int, x), ctrl, 0xF, 0xF, true))
__device__ __forceinline__ float row_sum16(float x) { DPP_ADD(x, 0xB1); DPP_ADD(x, 0x4E); DPP_ADD(x, 0x124); DPP_ADD(x, 0x128); return x; }
__device__ __forceinline__ void split_bf(float x, unsigned& hi, unsigned& lo) { hi = f2bf(x); lo = f2bf(x - __builtin_bit_cast(float, hi << 16)); }
__device__ __forceinline__ float wave_sum_fast(float x) { x = row_sum16(x);
    const int xi = __builtin_bit_cast(int, x);
    return (__builtin_bit_cast(float, __builtin_amdgcn_readlane(xi, 0)) + __builtin_bit_cast(float, __builtin_amdgcn_readlane(xi, 16))) + (__builtin_bit_cast(float, __builtin_amdgcn_readlane(xi, 32)) + __builtin_bit_cast(float, __builtin_amdgcn_readlane(xi, 48))); }
__device__ __forceinline__ float fast_tanh(float x) { const float t = __expf(2.f * x); return 1.f - 2.f * __builtin_amdgcn_rcpf(t + 1.f); }
__device__ __forceinline__ void phase_rwkv2(const Args& a, LAS unsigned char* lds, int tid, int lane, int wave, int vcu, int G) {
    const bf16* P = (const bf16*)(a.ws + WS_P); float* YRAW = (float*)(a.ws + WS_YRAW); float* BONG = (float*)(a.ws + WS_BON);
    LAS float* Rr = (LAS float*)lds;
    LAS float* KR = Rr + 2048;
    LAS float* KK = KR + 2048;
    LAS float* Wd = KK + 2048;
    LAS float* Bb = Wd + 2048;
    LAS float* Vv = (LAS float*)(lds + 40960);
    LAS float* Yy = (LAS float*)(lds + 45056);
    LAS bf16* TWh = (LAS bf16*)(lds + 49152);
    LAS bf16* TWl = TWh + 32 * 72;
    LAS bf16* ALh = TWl + 32 * 72;
    LAS bf16* ALl = ALh + 32 * 72;
    LAS bf16* WUh = (LAS bf16*)(lds + 67584);
    LAS bf16* WUl = WUh + 64 * 72;
    LAS bf16* AUh = WUl + 64 * 72;
    LAS bf16* AUl = AUh + 64 * 72;
    for (int unit = vcu; unit < BATCH * 16; unit += G) {
        const int bh = unit >> 1, half = unit & 1, b = bh >> 3, h = bh & 7;
        __syncthreads();
        for (int idx = tid; idx < 4096; idx += 512) { const int m = idx >> 6, j = idx & 63; unsigned hi, lo;
            split_bf(a.in[I_EWUP][m * 512 + h * 64 + j], hi, lo); WUh[j * 72 + m] = (bf16)hi; WUl[j * 72 + m] = (bf16)lo;
            split_bf(a.in[I_EAUP][m * 512 + h * 64 + j], hi, lo); AUh[j * 72 + m] = (bf16)hi; AUl[j * 72 + m] = (bf16)lo; }
        float S[4] = {0.f, 0.f, 0.f, 0.f};
        const int hj = h * 64 + lane;
        const float w0 = a.in[I_EW0][hj], a0 = a.in[I_EA0][hj], k_k = a.in[I_EKK][hj], k_a = a.in[I_EKA][hj], r_k = a.in[I_ERK][hj];
        const int c4 = (lane & 15) * 4, rowl = wave * 4 + (lane >> 4);
        const int i1 = tid >> 4, sub = tid & 15;
        const int col0 = C_R + h * 64 + 4 * sub, col1 = C_K + h * 64 + 4 * sub, col2 = C_V + h * 64 + 4 * sub, col3 = C_WLO + 4 * sub, col4 = C_ALO + 4 * sub;
        const f32x4 mu0 = *(const f32x4*)(a.in[I_EMU] + col0), mu1 = *(const f32x4*)(a.in[I_EMU] + col1), mu2 = *(const f32x4*)(a.in[I_EMU] + col2), mu3 = *(const f32x4*)(a.in[I_EMU] + col3), mu4 = *(const f32x4*)(a.in[I_EMU] + col4);
        const bf16* prow = P + (size_t)(b * SEQ + i1) * EVEN_PAD;
        u32x2 c0v, c1v, c2v, c3v, c4v, p0v, p1v, p2v, p3v, p4v;
#define RW_PREFETCH(t0_) do { const bf16* pc_ = prow + (size_t)(t0_) * EVEN_PAD; \
            c0v = *(const u32x2*)(pc_ + col0); c1v = *(const u32x2*)(pc_ + col1); c2v = *(const u32x2*)(pc_ + col2); c3v = *(const u32x2*)(pc_ + col3); c4v = *(const u32x2*)(pc_ + col4); \
            if ((t0_) + i1 > 0) { const bf16* pp_ = pc_ - EVEN_PAD; p0v = *(const u32x2*)(pp_ + col0); p1v = *(const u32x2*)(pp_ + col1); p2v = *(const u32x2*)(pp_ + col2); p3v = *(const u32x2*)(pp_ + col3); p4v = *(const u32x2*)(pp_ + col4); } \
            else { p0v = (u32x2){0u, 0u}; p1v = p0v; p2v = p0v; p3v = p0v; p4v = p0v; } } while (0)
#define RW_XS(cv_, pv_, mu_) ({ f32x4 x_; const float a0_ = bflo(cv_.x), a1_ = bfhi(cv_.x), a2_ = bflo(cv_.y), a3_ = bfhi(cv_.y); \
            x_[0] = a0_ + mu_[0] * (bflo(pv_.x) - a0_); x_[1] = a1_ + mu_[1] * (bfhi(pv_.x) - a1_); x_[2] = a2_ + mu_[2] * (bflo(pv_.y) - a2_); x_[3] = a3_ + mu_[3] * (bfhi(pv_.y) - a3_); x_; })
        RW_PREFETCH(0);
        for (int ck = 0; ck < SEQ / 32; ++ck) {
            const int t0 = ck * 32;
            { *(LAS f32x4*)(Rr + i1 * 64 + 4 * sub) = RW_XS(c0v, p0v, mu0);
              *(LAS f32x4*)(KR + i1 * 64 + 4 * sub) = RW_XS(c1v, p1v, mu1);
              { const f32x4 xv = RW_XS(c2v, p2v, mu2); if ((sub >> 3) == half) *(LAS f32x4*)(Vv + i1 * 32 + 4 * (sub & 7)) = xv; }
              { f32x4 xs = RW_XS(c3v, p3v, mu3); xs[0] = fast_tanh(xs[0]); xs[1] = fast_tanh(xs[1]); xs[2] = fast_tanh(xs[2]); xs[3] = fast_tanh(xs[3]);
                unsigned h0, l0, h1, l1, h2, l2, h3, l3; split_bf(xs[0], h0, l0); split_bf(xs[1], h1, l1); split_bf(xs[2], h2, l2); split_bf(xs[3], h3, l3);
                u32x2 hv, lv; hv.x = h0 | (h1 << 16); hv.y = h2 | (h3 << 16); lv.x = l0 | (l1 << 16); lv.y = l2 | (l3 << 16);
                *(LAS u32x2*)(TWh + i1 * 72 + 4 * sub) = hv; *(LAS u32x2*)(TWl + i1 * 72 + 4 * sub) = lv; }
              { const f32x4 xs = RW_XS(c4v, p4v, mu4);
                unsigned h0, l0, h1, l1, h2, l2, h3, l3; split_bf(xs[0], h0, l0); split_bf(xs[1], h1, l1); split_bf(xs[2], h2, l2); split_bf(xs[3], h3, l3);
                u32x2 hv, lv; hv.x = h0 | (h1 << 16); hv.y = h2 | (h3 << 16); lv.x = l0 | (l1 << 16); lv.y = l2 | (l3 << 16);
                *(LAS u32x2*)(ALh + i1 * 72 + 4 * sub) = hv; *(LAS u32x2*)(ALl + i1 * 72 + 4 * sub) = lv; } }
            if (ck + 1 < SEQ / 32) RW_PREFETCH(t0 + 32);
            __syncthreads();
            { const int mi = wave >> 2, ni = wave & 3, fr = lane & 15, fq = lane >> 4;
              f32x4 accw = {0.f, 0.f, 0.f, 0.f}, acca = {0.f, 0.f, 0.f, 0.f};
#pragma unroll
              for (int ks = 0; ks < 2; ++ks) { const int ao = (16 * mi + fr) * 72 + 32 * ks + 8 * fq, bo = (16 * ni + fr) * 72 + 32 * ks + 8 * fq;
                  const bf16x8 ah = *(const LAS bf16x8*)(TWh + ao), al = *(const LAS bf16x8*)(TWl + ao), bh_ = *(const LAS bf16x8*)(WUh + bo), bl = *(const LAS bf16x8*)(WUl + bo);
                  accw = __builtin_amdgcn_mfma_f32_16x16x32_bf16(ah, bh_, accw, 0, 0, 0); accw = __builtin_amdgcn_mfma_f32_16x16x32_bf16(ah, bl, accw, 0, 0, 0); accw = __builtin_amdgcn_mfma_f32_16x16x32_bf16(al, bh_, accw, 0, 0, 0);
                  const bf16x8 ch = *(const LAS bf16x8*)(ALh + ao), cl = *(const LAS bf16x8*)(ALl + ao), dh = *(const LAS bf16x8*)(AUh + bo), dl = *(const LAS bf16x8*)(AUl + bo);
                  acca = __builtin_amdgcn_mfma_f32_16x16x32_bf16(ch, dh, acca, 0, 0, 0); acca = __builtin_amdgcn_mfma_f32_16x16x32_bf16(ch, dl, acca, 0, 0, 0); acca = __builtin_amdgcn_mfma_f32_16x16x32_bf16(cl, dh, acca, 0, 0, 0); }
#pragma unroll
              for (int rg = 0; rg < 4; ++rg) { Wd[(16 * mi + 4 * fq + rg) * 64 + 16 * ni + fr] = accw[rg]; Bb[(16 * mi + 4 * fq + rg) * 64 + 16 * ni + fr] = acca[rg]; } }
            __syncthreads();
#pragma unroll
            for (int q = 0; q < 4; ++q) { const int i = wave + 8 * q;
                const float nx = -(w0 + Wd[i * 64 + lane]); const float sp = fmaxf(nx, 0.f) + __logf(1.f + __expf(-fabsf(nx)));
                const float decay = __expf(-__expf(-sp - 0.5f));
                const float av = __builtin_amdgcn_rcpf(1.f + __expf(-(a0 + Bb[i * 64 + lane])));
                const float kraw = KR[i * 64 + lane]; const float kkv = kraw * k_k;
                const float ss = wave_sum_fast(kkv * kkv); const float kk = kkv * __builtin_amdgcn_rsqf(fmaxf(ss, 1e-24f));
                const float kp = kraw * (1.f + (av - 1.f) * k_a);
                const float bon = wave_sum_fast(Rr[i * 64 + lane] * kp * r_k);
                Wd[i * 64 + lane] = decay; KR[i * 64 + lane] = kp; KK[i * 64 + lane] = kk; Bb[i * 64 + lane] = kk * av;
                if (half == 0 && lane == 0) BONG[(size_t)(b * SEQ + t0 + i) * 8 + h] = bon; }
            __syncthreads();
            { f32x4 kk4 = *(const LAS f32x4*)(KK + c4), w4 = *(const LAS f32x4*)(Wd + c4), b4 = *(const LAS f32x4*)(Bb + c4), k4 = *(const LAS f32x4*)(KR + c4), r4 = *(const LAS f32x4*)(Rr + c4);
              float vv = Vv[rowl];
#pragma unroll 4
              for (int i = 0; i < 32; ++i) {
                const int in = (i + 1) & 31;
                const f32x4 nkk = *(const LAS f32x4*)(KK + in * 64 + c4), nw = *(const LAS f32x4*)(Wd + in * 64 + c4), nb = *(const LAS f32x4*)(Bb + in * 64 + c4), nk = *(const LAS f32x4*)(KR + in * 64 + c4), nr = *(const LAS f32x4*)(Rr + in * 64 + c4);
                const float nv = Vv[in * 32 + rowl];
                float sa = (S[0] * kk4[0] + S[1] * kk4[1]) + (S[2] * kk4[2] + S[3] * kk4[3]);
                const float p0 = S[0] * w4[0] + vv * k4[0], p1 = S[1] * w4[1] + vv * k4[1], p2 = S[2] * w4[2] + vv * k4[2], p3 = S[3] * w4[3] + vv * k4[3];
                sa = -row_sum16(sa);
                S[0] = sa * b4[0] + p0; S[1] = sa * b4[1] + p1; S[2] = sa * b4[2] + p2; S[3] = sa * b4[3] + p3;
                float y = (S[0] * r4[0] + S[1] * r4[1]) + (S[2] * r4[2] + S[3] * r4[3]);
                y = row_sum16(y);
                Yy[i * 32 + rowl] = y;
                kk4 = nkk; w4 = nw; b4 = nb; k4 = nk; r4 = nr; vv = nv;
              } }
            __syncthreads();
            for (int idx = tid; idx < 1024; idx += 512) { const int i = idx >> 5, rl = idx & 31; YRAW[(size_t)(b * SEQ + t0 + i) * 512 + h * 64 + half * 32 + rl] = Yy[idx]; }
        }
#undef RW_PREFETCH
#undef RW_XS
    }
}
__device__ __forceinline__ void phase_finish(const Args& a, int lane, int wave, int vcu, int G) {
    const bf16* P = (const bf16*)(a.ws + WS_P); bf16* MIX = (bf16*)(a.ws + WS_MIX); const float* YRAW = (const float*)(a.ws + WS_YRAW); const float* BONG = (const float*)(a.ws + WS_BON);
    const int gw = vcu * NWAVES + wave, NGW = G * NWAVES; const int c0 = 8 * lane;
    const f32x4 g0 = *(const f32x4*)(a.in[I_ELNXG] + c0), g1 = *(const f32x4*)(a.in[I_ELNXG] + c0 + 4), e0 = *(const f32x4*)(a.in[I_ELNXB] + c0), e1 = *(const f32x4*)(a.in[I_ELNXB] + c0 + 4);
    const f32x4 m0 = *(const f32x4*)(a.in[I_EMU] + C_V + c0), m1 = *(const f32x4*)(a.in[I_EMU] + C_V + c0 + 4);
    for (int row = gw; row < M; row += NGW) {
        const f32x4 y0 = *(const f32x4*)(YRAW + (size_t)row * 512 + c0), y1 = *(const f32x4*)(YRAW + (size_t)row * 512 + c0 + 4);
        float y[8] = {y0[0], y0[1], y0[2], y0[3], y1[0], y1[1], y1[2], y1[3]};
        float s = 0.f;
#pragma unroll
        for (int e = 0; e < 8; ++e) s += y[e];
        s += __shfl_xor(s, 1); s += __shfl_xor(s, 2); s += __shfl_xor(s, 4); const float mean = s * (1.f / 64.f); float q = 0.f;
#pragma unroll
        for (int e = 0; e < 8; ++e) { y[e] -= mean; q += y[e] * y[e]; }
        q += __shfl_xor(q, 1); q += __shfl_xor(q, 2); q += __shfl_xor(q, 4); const float rstd = 1.0f / sqrtf(q * (1.f / 64.f) + 64e-5f);
        const bf16* pc = P + (size_t)row * EVEN_PAD; const v4u cu = *(const v4u*)(pc + C_V + c0); v4u pu = {0u, 0u, 0u, 0u}; if ((row & (SEQ - 1)) != 0) pu = *(const v4u*)(pc - EVEN_PAD + C_V + c0);
        const v4u zu = *(const v4u*)(pc + C_Z0 + c0);
        const float cv[8] = {bflo(cu.x), bfhi(cu.x), bflo(cu.y), bfhi(cu.y), bflo(cu.z), bfhi(cu.z), bflo(cu.w), bfhi(cu.w)};
        const float pv[8] = {bflo(pu.x), bfhi(pu.x), bflo(pu.y), bfhi(pu.y), bflo(pu.z), bfhi(pu.z), bflo(pu.w), bfhi(pu.w)};
        const float zz[8] = {bflo(zu.x), bfhi(zu.x), bflo(zu.y), bfhi(zu.y), bflo(zu.z), bfhi(zu.z), bflo(zu.w), bfhi(zu.w)};
        const float mu[8] = {m0[0], m0[1], m0[2], m0[3], m1[0], m1[1], m1[2], m1[3]}, gg[8] = {g0[0], g0[1], g0[2], g0[3], g1[0], g1[1], g1[2], g1[3]}, ee[8] = {e0[0], e0[1], e0[2], e0[3], e1[0], e1[1], e1[2], e1[3]};
        const float bon = BONG[(size_t)row * 8 + (lane >> 3)];
        float o[8];
#pragma unroll
        for (int e = 0; e < 8; ++e) { const float v = cv[e] + mu[e] * (pv[e] - cv[e]); o[e] = (y[e] * rstd * gg[e] + ee[e] + bon * v) * siluf(zz[e]); }
        v4u w; w.x = pk2(o[0], o[1]); w.y = pk2(o[2], o[3]); w.z = pk2(o[4], o[5]); w.w = pk2(o[6], o[7]);
        *(v4u*)(MIX + (size_t)row * D + c0) = w;
    }
}
__device__ __forceinline__ void phase_gmlp(const Args& a, LAS unsigned char* lds, int tid, int lane, int wave, int vcu, int G) {
    const bf16* P = (const bf16*)(a.ws + WS_P); bf16* MIX = (bf16*)(a.ws + WS_MIX);
    LAS float* WS = (LAS float*)lds;
    LAS float* VLN = (LAS float*)(lds + 128 * 129 * 4);
    int gload = -1;
    for (int u = vcu; u < BATCH * 16 * 8; u += G) {
        const int b = u >> 7, ck = (u >> 3) & 15, g = u & 7;
        __syncthreads();
        if (g != gload) { for (int idx = tid; idx < 16384; idx += 512) WS[(idx >> 7) * 129 + (idx & 127)] = a.in[I_ESGW][(size_t)g * 16384 + idx]; gload = g; }
        const int i = tid >> 2, sub = tid & 3; const size_t rowg = (size_t)(b * SEQ + ck * 128 + i);
        { const v4u q0 = *(const v4u*)(P + rowg * EVEN_PAD + C_VG + g * 64 + sub * 16), q1 = *(const v4u*)(P + rowg * EVEN_PAD + C_VG + g * 64 + sub * 16 + 8);
          float v[16] = {bflo(q0.x), bfhi(q0.x), bflo(q0.y), bfhi(q0.y), bflo(q0.z), bfhi(q0.z), bflo(q0.w), bfhi(q0.w), bflo(q1.x), bfhi(q1.x), bflo(q1.y), bfhi(q1.y), bflo(q1.z), bfhi(q1.z), bflo(q1.w), bfhi(q1.w)};
          float s = 0.f;
#pragma unroll
          for (int e = 0; e < 16; ++e) s += v[e];
          s += __shfl_xor(s, 1); s += __shfl_xor(s, 2); const float mean = s * (1.f / 64.f); float q = 0.f;
#pragma unroll
          for (int e = 0; e < 16; ++e) { v[e] -= mean; q += v[e] * v[e]; }
          q += __shfl_xor(q, 1); q += __shfl_xor(q, 2); const float rstd = 1.0f / sqrtf(q * (1.f / 64.f) + 1e-5f);
#pragma unroll
          for (int e = 0; e < 16; ++e) VLN[i * 64 + sub * 16 + e] = v[e] * rstd * a.in[I_ESGLNG][g * 64 + sub * 16 + e] + a.in[I_ESGLNB][g * 64 + sub * 16 + e]; }
        __syncthreads();
        float acc[16];
#pragma unroll
        for (int e = 0; e < 16; ++e) acc[e] = 0.f;
        const int smax = wave * 16 + 16;
        for (int s = 0; s < smax; ++s) {
            const float w = (s <= i) ? WS[i * 129 + s] : 0.f;
            const f32x4 v0 = *(const LAS f32x4*)(VLN + s * 64 + sub * 16), v1 = *(const LAS f32x4*)(VLN + s * 64 + sub * 16 + 4), v2 = *(const LAS f32x4*)(VLN + s * 64 + sub * 16 + 8), v3 = *(const LAS f32x4*)(VLN + s * 64 + sub * 16 + 12);
#pragma unroll
            for (int e = 0; e < 4; ++e) { acc[e] += w * v0[e]; acc[4 + e] += w * v1[e]; acc[8 + e] += w * v2[e]; acc[12 + e] += w * v3[e]; }
        }
        const float bs = a.in[I_ESGB][g * 128 + i];
        const v4u u0 = *(const v4u*)(P + rowg * EVEN_PAD + C_U + g * 64 + sub * 16), u1 = *(const v4u*)(P + rowg * EVEN_PAD + C_U + g * 64 + sub * 16 + 8);
        const v4u z0 = *(const v4u*)(P + rowg * EVEN_PAD + C_Z0 + 512 + g * 64 + sub * 16), z1 = *(const v4u*)(P + rowg * EVEN_PAD + C_Z0 + 512 + g * 64 + sub * 16 + 8);
        const float uu[16] = {bflo(u0.x), bfhi(u0.x), bflo(u0.y), bfhi(u0.y), bflo(u0.z), bfhi(u0.z), bflo(u0.w), bfhi(u0.w), bflo(u1.x), bfhi(u1.x), bflo(u1.y), bfhi(u1.y), bflo(u1.z), bfhi(u1.z), bflo(u1.w), bfhi(u1.w)};
        const float zz[16] = {bflo(z0.x), bfhi(z0.x), bflo(z0.y), bfhi(z0.y), bflo(z0.z), bfhi(z0.z), bflo(z0.w), bfhi(z0.w), bflo(z1.x), bfhi(z1.x), bflo(z1.y), bfhi(z1.y), bflo(z1.z), bfhi(z1.z), bflo(z1.w), bfhi(z1.w)};
        float o[16];
#pragma unroll
        for (int e = 0; e < 16; ++e) o[e] = uu[e] * (acc[e] + bs) * siluf(zz[e]);
        v4u w0, w1; w0.x = pk2(o[0], o[1]); w0.y = pk2(o[2], o[3]); w0.z = pk2(o[4], o[5]); w0.w = pk2(o[6], o[7]); w1.x = pk2(o[8], o[9]); w1.y = pk2(o[10], o[11]); w1.z = pk2(o[12], o[13]); w1.w = pk2(o[14], o[15]);
        *(v4u*)(MIX + rowg * D + 512 + g * 64 + sub * 16) = w0; *(v4u*)(MIX + rowg * D + 512 + g * 64 + sub * 16 + 8) = w1;
    }
}

__device__ __forceinline__ void phase_swa(const Args& a, LAS unsigned char* lds, int tid, int lane, int wave, int vcu, int G) {
    const bf16* P = (const bf16*)(a.ws + WS_P); bf16* MIX = (bf16*)(a.ws + WS_MIX);
    LAS unsigned* KB = (LAS unsigned*)lds;
    LAS unsigned* VB = KB + 256 * 33;
    for (int u = vcu; u < BATCH * 16 * 2; u += G) {
        const int b = u >> 5, n = (u >> 1) & 15, kvh = u & 1;
        __syncthreads();
        { const int kr = tid >> 1, half = tid & 1; const int tk = n * 128 - 128 + kr;
          v4u kq[4], vq[4];
#pragma unroll
          for (int e = 0; e < 4; ++e) { kq[e] = (v4u){0u, 0u, 0u, 0u}; vq[e] = kq[e]; }
          if (tk >= 0) { const bf16* pr = P + (size_t)(b * SEQ + tk) * ODD_IN;
#pragma unroll
              for (int e = 0; e < 4; ++e) { kq[e] = *(const v4u*)(pr + C_KC + kvh * 64 + half * 32 + e * 8); vq[e] = *(const v4u*)(pr + C_VC + kvh * 64 + half * 32 + e * 8); } }
#pragma unroll
          for (int e = 0; e < 4; ++e) { LAS unsigned* kd = KB + kr * 33 + half * 16 + e * 4; kd[0] = kq[e].x; kd[1] = kq[e].y; kd[2] = kq[e].z; kd[3] = kq[e].w;
              LAS unsigned* vd = VB + kr * 33 + half * 16 + e * 4; vd[0] = vq[e].x; vd[1] = vq[e].y; vd[2] = vq[e].z; vd[3] = vq[e].w; } }
        __syncthreads();
        for (int pass = 0; pass < 2; ++pass) {
            const int gq = (tid >> 7) + 4 * pass, qi = tid & 127, h = kvh * 8 + gq; const size_t rowg = (size_t)(b * SEQ + n * 128 + qi);
            float q[64], o[64];
#pragma unroll
            for (int e = 0; e < 8; ++e) { const v4u w = *(const v4u*)(P + rowg * ODD_IN + C_Q + h * 64 + e * 8);
                q[8 * e + 0] = bflo(w.x) * 0.125f; q[8 * e + 1] = bfhi(w.x) * 0.125f; q[8 * e + 2] = bflo(w.y) * 0.125f; q[8 * e + 3] = bfhi(w.y) * 0.125f;
                q[8 * e + 4] = bflo(w.z) * 0.125f; q[8 * e + 5] = bfhi(w.z) * 0.125f; q[8 * e + 6] = bflo(w.w) * 0.125f; q[8 * e + 7] = bfhi(w.w) * 0.125f; }
#pragma unroll
            for (int e = 0; e < 64; ++e) o[e] = 0.f;
            const float slope = exp2f(-0.5f * (float)(h + 1));
            float mrun = a.in[I_OSINKS][h], lrun = 1.f;
            for (int j = 0; j < 128; ++j) {
                const int kr = qi + 1 + j; const bool valid = (n > 0) || (kr >= 128);
                const LAS unsigned* kp = KB + kr * 33;
                float s0 = 0.f, s1 = 0.f;
#pragma unroll
                for (int e = 0; e < 32; ++e) { const unsigned w = kp[e]; s0 += q[2 * e] * bflo(w); s1 += q[2 * e + 1] * bfhi(w); }
                const float s = (s0 + s1) - slope * (float)(127 - j);
                const float mn = valid ? fmaxf(mrun, s) : mrun;
                const float alpha = __expf(mrun - mn); const float p = valid ? __expf(s - mn) : 0.f;
                lrun = lrun * alpha + p; mrun = mn;
                const LAS unsigned* vp = VB + kr * 33;
#pragma unroll
                for (int e = 0; e < 32; ++e) { const unsigned w = vp[e]; o[2 * e] = o[2 * e] * alpha + p * bflo(w); o[2 * e + 1] = o[2 * e + 1] * alpha + p * bfhi(w); }
            }
            const float il = 1.f / lrun;
#pragma unroll
            for (int e = 0; e < 8; ++e) { const v4u zw = *(const v4u*)(P + rowg * ODD_IN + C_Z1 + h * 64 + e * 8);
                v4u w; w.x = pk2(o[8 * e + 0] * il * siluf(bflo(zw.x)), o[8 * e + 1] * il * siluf(bfhi(zw.x))); w.y = pk2(o[8 * e + 2] * il * siluf(bflo(zw.y)), o[8 * e + 3] * il * siluf(bfhi(zw.y)));
                w.z = pk2(o[8 * e + 4] * il * siluf(bflo(zw.z)), o[8 * e + 5] * il * siluf(bfhi(zw.z))); w.w = pk2(o[8 * e + 6] * il * siluf(bflo(zw.w)), o[8 * e + 7] * il * siluf(bfhi(zw.w)));
                *(v4u*)(MIX + rowg * D + h * 64 + e * 8) = w; }
        }
    }
}


typedef float f32x16 __attribute__((ext_vector_type(16)));
__device__ __forceinline__ int crow(int r, int hi) { return (r & 3) + 8 * (r >> 2) + 4 * hi; }
__device__ __forceinline__ unsigned cvtpk(float lo, float hi) { unsigned r; asm volatile("v_cvt_pk_bf16_f32 %0, %1, %2" : "=v"(r) : "v"(lo), "v"(hi)); return r; }
__device__ __forceinline__ void phase_swa2(const Args& a, LAS unsigned char* lds, int tid, int lane, int wave, int vcu, int G) {
    const bf16* P = (const bf16*)(a.ws + WS_P); bf16* MIX = (bf16*)(a.ws + WS_MIX);
    LAS bf16* Kl = (LAS bf16*)lds;
    LAS bf16* Vt = (LAS bf16*)(lds + 36864);
    const int l31 = lane & 31, hi = lane >> 5;
    for (int u = vcu; u < BATCH * 16 * 2; u += G) {
        const int b = u >> 5, n = (u >> 1) & 15, kvh = u & 1;
        __syncthreads();
        { const int key = tid >> 1, half = tid & 1; const int tk = n * 128 - 128 + key;
          v4u kq[4];
#pragma unroll
          for (int e = 0; e < 4; ++e) kq[e] = (v4u){0u, 0u, 0u, 0u};
          if (tk >= 0) { const bf16* pr = P + (size_t)(b * SEQ + tk) * ODD_IN + C_KC + kvh * 64 + half * 32;
#pragma unroll
              for (int e = 0; e < 4; ++e) kq[e] = *(const v4u*)(pr + e * 8); }
#pragma unroll
          for (int e = 0; e < 4; ++e) *(LAS v4u*)(Kl + key * 72 + half * 32 + e * 8) = kq[e]; }
        { const int key = tid & 255, dh = tid >> 8; const int tk = n * 128 - 128 + key;
          v4u vq[4];
#pragma unroll
          for (int e = 0; e < 4; ++e) vq[e] = (v4u){0u, 0u, 0u, 0u};
          if (tk >= 0) { const bf16* pr = P + (size_t)(b * SEQ + tk) * ODD_IN + C_VC + kvh * 64 + dh * 32;
#pragma unroll
              for (int e = 0; e < 4; ++e) vq[e] = *(const v4u*)(pr + e * 8); }
#pragma unroll
          for (int e = 0; e < 4; ++e) { LAS bf16* vd = Vt + (dh * 32 + e * 8) * 260 + key;
              vd[0 * 260] = (bf16)(vq[e].x & 0xffffu); vd[1 * 260] = (bf16)(vq[e].x >> 16); vd[2 * 260] = (bf16)(vq[e].y & 0xffffu); vd[3 * 260] = (bf16)(vq[e].y >> 16);
              vd[4 * 260] = (bf16)(vq[e].z & 0xffffu); vd[5 * 260] = (bf16)(vq[e].z >> 16); vd[6 * 260] = (bf16)(vq[e].w & 0xffffu); vd[7 * 260] = (bf16)(vq[e].w >> 16); } }
        __syncthreads();
        const int h = kvh * 8 + wave;
        const float slope = exp2f(-0.5f * (float)(h + 1)), sink = a.in[I_OSINKS][h];
#pragma unroll 1
        for (int i = 0; i < 4; ++i) {
            const size_t rowq = (size_t)(b * SEQ + n * 128 + 32 * i + l31);
            bf16x8 qf[4];
#pragma unroll
            for (int ks = 0; ks < 4; ++ks) qf[ks] = *(const bf16x8*)(P + rowq * ODD_IN + C_Q + h * 64 + 16 * ks + 8 * hi);
            f32x16 st[5];
#pragma unroll
            for (int tt = 0; tt < 5; ++tt) { f32x16 acc = {0.f, 0.f, 0.f, 0.f, 0.f, 0.f, 0.f, 0.f, 0.f, 0.f, 0.f, 0.f, 0.f, 0.f, 0.f, 0.f};
#pragma unroll
                for (int ks = 0; ks < 4; ++ks) { const bf16x8 kf = *(const LAS bf16x8*)(Kl + (32 * (i + tt) + l31) * 72 + 16 * ks + 8 * hi);
                    acc = __builtin_amdgcn_mfma_f32_32x32x16_bf16(kf, qf[ks], acc, 0, 0, 0); }
                st[tt] = acc; }
            int lbv = l31 - 4 * hi; float sbv = -slope * (float)(l31 + 128 - 4 * hi);
            asm volatile("" : "+v"(lbv), "+v"(sbv));
            float mx = sink;
#pragma unroll
            for (int tt = 0; tt < 5; ++tt) { const bool tile_ok = (n > 0) || (i + tt >= 4);
#pragma unroll
                for (int r = 0; r < 16; ++r) { const int cr = (r & 3) + 8 * (r >> 2);
                    float s = fmaf(st[tt][r], 0.125f, sbv); s = fmaf(slope, (float)(32 * tt + cr), s);
                    if (tt == 0) s = (cr > lbv) ? s : -INFINITY;
                    if (tt == 4) s = (cr <= lbv) ? s : -INFINITY;
                    s = tile_ok ? s : -INFINITY;
                    st[tt][r] = s; mx = fmaxf(mx, s); } }
            { auto rr = __builtin_amdgcn_permlane32_swap(__float_as_uint(mx), __float_as_uint(mx), false, false); mx = fmaxf(__uint_as_float(rr[0]), __uint_as_float(rr[1])); }
            float ls = 0.f;
#pragma unroll
            for (int tt = 0; tt < 5; ++tt)
#pragma unroll
                for (int r = 0; r < 16; ++r) { const float p = __expf(st[tt][r] - mx); st[tt][r] = p; ls += p; }
            { auto rr = __builtin_amdgcn_permlane32_swap(__float_as_uint(ls), __float_as_uint(ls), false, false); ls = __uint_as_float(rr[0]) + __uint_as_float(rr[1]); }
            const float inv = 1.f / (ls + __expf(sink - mx));
            f32x16 o[2];
#pragma unroll
            for (int dt = 0; dt < 2; ++dt) o[dt] = (f32x16){0.f, 0.f, 0.f, 0.f, 0.f, 0.f, 0.f, 0.f, 0.f, 0.f, 0.f, 0.f, 0.f, 0.f, 0.f, 0.f};
#pragma unroll
            for (int tt = 0; tt < 5; ++tt)
#pragma unroll
                for (int s2 = 0; s2 < 2; ++s2) {
                    v4u pw; pw.x = cvtpk(st[tt][8 * s2 + 0] * inv, st[tt][8 * s2 + 1] * inv); pw.y = cvtpk(st[tt][8 * s2 + 2] * inv, st[tt][8 * s2 + 3] * inv);
                    pw.z = cvtpk(st[tt][8 * s2 + 4] * inv, st[tt][8 * s2 + 5] * inv); pw.w = cvtpk(st[tt][8 * s2 + 6] * inv, st[tt][8 * s2 + 7] * inv);
                    const bf16x8 pa = __builtin_bit_cast(bf16x8, pw);
                    const int kb = 32 * (i + tt) + 16 * s2 + 4 * hi;
#pragma unroll
                    for (int dt = 0; dt < 2; ++dt) { const LAS bf16* vp = Vt + (dt * 32 + l31) * 260 + kb;
                        const u32x2 v0 = *(const LAS u32x2*)vp, v1 = *(const LAS u32x2*)(vp + 8);
                        v4u vw; vw.x = v0.x; vw.y = v0.y; vw.z = v1.x; vw.w = v1.y;
                        o[dt] = __builtin_amdgcn_mfma_f32_32x32x16_bf16(pa, __builtin_bit_cast(bf16x8, vw), o[dt], 0, 0, 0); } }
#pragma unroll
            for (int dt = 0; dt < 2; ++dt)
#pragma unroll
                for (int r = 0; r < 16; ++r) { const size_t row = (size_t)(b * SEQ + n * 128 + 32 * i + crow(r, hi)); const int d = h * 64 + dt * 32 + l31;
                    const float z = bf2f(P[row * ODD_IN + C_Z1 + d]);
                    MIX[row * D + d] = (bf16)f2bf(o[dt][r] * siluf(z)); if ((r & 3) == 3) asm volatile("" ::: "memory"); }
        }
    }
}

__device__ __forceinline__ void phase_gmlp2(const Args& a, LAS unsigned char* lds, int tid, int lane, int wave, int vcu, int G) {
    const bf16* P = (const bf16*)(a.ws + WS_P); bf16* MIX = (bf16*)(a.ws + WS_MIX);
    LAS bf16* Wl = (LAS bf16*)lds;
    LAS bf16* Vn = (LAS bf16*)(lds + 34816);
    const int l31 = lane & 31, hi = lane >> 5;
    int gload = -1;
    for (int u = vcu; u < BATCH * 16 * 8; u += G) {
        const int b = u >> 7, ck = (u >> 3) & 15, g = u & 7;
        __syncthreads();
        if (g != gload) { for (int idx = tid; idx < 16384; idx += 512) { const int t = idx >> 7, s = idx & 127; const float w = a.in[I_ESGW][(size_t)g * 16384 + idx]; Wl[t * 136 + s] = (bf16)f2bf(s <= t ? w : 0.f); } gload = g; }
        { const int i = tid >> 2, sub = tid & 3; const size_t rowg = (size_t)(b * SEQ + ck * 128 + i);
          const v4u q0 = *(const v4u*)(P + rowg * EVEN_PAD + C_VG + g * 64 + sub * 16), q1 = *(const v4u*)(P + rowg * EVEN_PAD + C_VG + g * 64 + sub * 16 + 8);
          float v[16] = {bflo(q0.x), bfhi(q0.x), bflo(q0.y), bfhi(q0.y), bflo(q0.z), bfhi(q0.z), bflo(q0.w), bfhi(q0.w), bflo(q1.x), bfhi(q1.x), bflo(q1.y), bfhi(q1.y), bflo(q1.z), bfhi(q1.z), bflo(q1.w), bfhi(q1.w)};
          float s = 0.f;
#pragma unroll
          for (int e = 0; e < 16; ++e) s += v[e];
          s += __shfl_xor(s, 1); s += __shfl_xor(s, 2); const float mean = s * (1.f / 64.f); float q = 0.f;
#pragma unroll
          for (int e = 0; e < 16; ++e) { v[e] -= mean; q += v[e] * v[e]; }
          q += __shfl_xor(q, 1); q += __shfl_xor(q, 2); const float rstd = 1.0f / sqrtf(q * (1.f / 64.f) + 1e-5f);
#pragma unroll
          for (int e = 0; e < 16; ++e) Vn[(sub * 16 + e) * 136 + i] = (bf16)f2bf(v[e] * rstd * a.in[I_ESGLNG][g * 64 + sub * 16 + e] + a.in[I_ESGLNB][g * 64 + sub * 16 + e]); }
        __syncthreads();
        const int ti = wave >> 1, dt = wave & 1;
        f32x16 acc = {0.f, 0.f, 0.f, 0.f, 0.f, 0.f, 0.f, 0.f, 0.f, 0.f, 0.f, 0.f, 0.f, 0.f, 0.f, 0.f};
        const LAS bf16* ap = Wl + (32 * ti + l31) * 136 + 8 * hi; const LAS bf16* bp = Vn + (32 * dt + l31) * 136 + 8 * hi;
        for (int ks = 0; ks < 2 * ti + 2; ++ks) acc = __builtin_amdgcn_mfma_f32_32x32x16_bf16(*(const LAS bf16x8*)(ap + 16 * ks), *(const LAS bf16x8*)(bp + 16 * ks), acc, 0, 0, 0);
#pragma unroll
        for (int r = 0; r < 16; ++r) { const int t = 32 * ti + crow(r, hi); const size_t rowg = (size_t)(b * SEQ + ck * 128 + t); const int d = g * 64 + 32 * dt + l31;
            const float mixed = acc[r] + a.in[I_ESGB][g * 128 + t];
            const float uu = bf2f(P[rowg * EVEN_PAD + C_U + d]), zz = bf2f(P[rowg * EVEN_PAD + C_Z0 + 512 + d]);
            MIX[rowg * D + 512 + d] = (bf16)f2bf(uu * mixed * siluf(zz)); if ((r & 3) == 3) asm volatile("" ::: "memory"); }
    }
}
__global__ void __launch_bounds__(NWAVES * 64, 2) mk_fwd(Args args) {
    extern __shared__ __attribute__((aligned(16))) unsigned char lds_raw[];
    LAS unsigned char* lds = (LAS unsigned char*)lds_raw;
    volatile LAS unsigned* MISC = (volatile LAS unsigned*)(lds + MISC_OFF);
    const int tid = threadIdx.x, lane = tid & 63, wave = __builtin_amdgcn_readfirstlane(tid >> 6);
    const int G = gridDim.x; const int bx = blockIdx.x; const int vcu = (G % 8 == 0) ? (bx % 8) * (G / 8) + bx / 8 : bx;
    unsigned char* ws = args.ws;
    gu32* ctl = (gu32*)(ws + WS_CTL);
    for (int u = tid; u < (LDS_BYTES - LDSCTL_OFF) / 4; u += NWAVES * 64) ((LAS unsigned*)(lds + LDSCTL_OFF))[u] = 0u;
    __syncthreads();
    XcdBarrier bar = xcd_barrier_post((unsigned*)(ctl + CW_BAR), MISC + 8);
    const int lo = args.ph_lo, hi = args.ph_hi;
#define IN(k) (lo <= (k) && (k) < hi)
#define GRID_BAR() xcd_barrier(bar)
    float* mod = (float*)(ws + WS_MOD);
    bf16* XN = (bf16*)(ws + WS_XN); bf16* MIX = (bf16*)(ws + WS_MIX); bf16* P = (bf16*)(ws + WS_P);

    if (IN(0)) { phase0(args, lds, tid, lane, wave, vcu, G); GRID_BAR(); }
    if (IN(1)) { phase_adaln_rows(args.in[I_X], args.in[I_NORMG], mod, XN, lane, wave, vcu, G); GRID_BAR(); }
    if (IN(2)) {
        pg8::Gemm g{XN, (const bf16*)(ws + WS_WIN0), M, EVEN_PAD, D}; pg8::StaticOrder S; S.init(M, EVEN_PAD, G, (int)blockIdx.x);
        pg8::EpiBf16 E{P, EVEN_PAD};
        pg8::gemm_phase<pg8::EpiBf16, pg8::StaticOrder, PG8_ALIGN, PG8_SP2>(lds, g, S, E);
        GRID_BAR();
    }
    if (IN(3)) { phase_rwkv2(args, lds, tid, lane, wave, vcu, G); phase_gmlp2(args, lds, tid, lane, wave, vcu, G); GRID_BAR(); phase_finish(args, lane, wave, vcu, G); GRID_BAR(); }
    if (IN(4)) {
        pg8::Gemm g{MIX, (const bf16*)(ws + WS_WOUT0), M, D, D}; pg8::StaticOrder S; S.init(M, D, G, (int)blockIdx.x);
        pg8::EpiResGate E{args.in[I_X], args.out, mod + 2048};
        pg8::gemm_phase<pg8::EpiResGate, pg8::StaticOrder, PG8_ALIGN, PG8_SP2>(lds, g, S, E);
        GRID_BAR();
    }
    if (IN(5)) { phase_adaln_rows(args.out, args.in[I_NORMG] + D, mod + 16 * 3072, XN, lane, wave, vcu, G); GRID_BAR(); }
    if (IN(6)) {
        pg8::Gemm g{XN, (const bf16*)(ws + WS_WIN1), M, ODD_IN, D}; pg8::StaticOrder S; S.init(M, ODD_IN, G, (int)blockIdx.x);
        pg8::EpiBf16 E{P, ODD_IN};
        pg8::gemm_phase<pg8::EpiBf16, pg8::StaticOrder, PG8_ALIGN, PG8_SP2>(lds, g, S, E);
        GRID_BAR();
    }
    if (IN(7)) { phase_swa2(args, lds, tid, lane, wave, vcu, G); GRID_BAR(); }
    if (IN(8)) {
        pg8::Gemm g{MIX, (const bf16*)(ws + WS_WOUT1), M, D, D}; pg8::StaticOrder S; S.init(M, D, G, (int)blockIdx.x);
        pg8::EpiResGate E{args.out, args.out, mod + 16 * 3072 + 2048};
        pg8::gemm_phase<pg8::EpiResGate, pg8::StaticOrder, PG8_ALIGN, PG8_SP2>(lds, g, S, E);
        GRID_BAR();
    }
    if (IN(9)) { phase_final_rows(args.out, args.in[I_FINALG], lane, wave, vcu, G); }
#undef IN
#undef GRID_BAR
}

extern "C" void kernel_launch(void* const* d_in, const int* in_sizes, int n_in, void* d_out, int out_size, void* d_ws, size_t ws_size, hipStream_t stream) {
    static int grid = 0;
    if (grid == 0) {
        if (n_in != N_IN || in_sizes[0] != M * D || out_size != M * D || ws_size < WS_END) { fprintf(stderr, "kernel_launch: unexpected shapes (n_in %d, in0 %d, out %d, ws %zu); nothing launched\n", n_in, n_in > 0 ? in_sizes[0] : -1, out_size, ws_size); grid = -1; return; }
        int dev = 0, cus = 0, per_cu = 0;
        if (hipGetDevice(&dev) != hipSuccess || hipDeviceGetAttribute(&cus, hipDeviceAttributeMultiprocessorCount, dev) != hipSuccess) { grid = -1; return; }
        if (hipFuncSetAttribute((const void*)mk_fwd, hipFuncAttributeMaxDynamicSharedMemorySize, LDS_BYTES) != hipSuccess) { fprintf(stderr, "kernel_launch: hipFuncSetAttribute failed\n"); grid = -1; return; }
        if (hipOccupancyMaxActiveBlocksPerMultiprocessor(&per_cu, (const void*)mk_fwd, NWAVES * 64, LDS_BYTES) != hipSuccess || per_cu < 1) fprintf(stderr, "kernel_launch: note: occupancy query reports %d\n", per_cu);
        (void)hipGetLastError();
        grid = cus;
    }
    if (grid < 0) return;
    if (hipMemsetAsync((char*)d_ws + WS_CTL, 0, CTL_ZERO_BYTES, stream) != hipSuccess) { fprintf(stderr, "kernel_launch: memset failed\n"); return; }
    Args a{};
    for (int i = 0; i < N_IN; ++i) a.in[i] = (const float*)d_in[i];
    a.out = (float*)d_out; a.ws = (unsigned char*)d_ws; a.ph_lo = 0; a.ph_hi = 10;
    hipLaunchKernelGGL(mk_fwd, dim3(grid), dim3(NWAVES * 64), LDS_BYTES, stream, a);
}
```

```cpp
#include <hip/hip_runtime.h>
#include <cstdio>
#include <cstdint>
namespace pg8 {
#define PG8_LAS __attribute__((address_space(3)))
typedef unsigned short bf16_t;
typedef short bf16x8 __attribute__((ext_vector_type(8)));
typedef float f32x4 __attribute__((ext_vector_type(4)));
typedef unsigned u32x4 __attribute__((ext_vector_type(4)));
constexpr int BM = 256, BK = 64, HALF = 128, HTB = HALF * BK * 2  , STAGE_BYTES = 8 * HTB, NXCD = 8, WGM = 8;

__host__ __device__ __forceinline__ int lds_byte(int r, int c) { const int st = (r >> 4) * 2 + (c >> 5), rr = r & 15, cc = c & 31, ob = rr * 64 + cc * 2; return st * 1024 + (ob ^ (((ob >> 9) & 1) << 5)); }
__host__ __device__ __forceinline__ void stage_rc(int b, int& R, int& C) { const int st = b / 1024, sb = b % 1024, swz = sb ^ (((sb >> 9) & 1) << 5); R = (st >> 1) * 16 + swz / 64; C = (st & 1) * 32 + (swz % 64) / 2; }
__host__ __device__ __forceinline__ int perm32(int rho) { const int n = rho >> 4, i = rho & 15; return 8 * (i >> 2) + 4 * n + (i & 3); }

struct Unit { int pm, pn; };
struct Gemm { const bf16_t* A; const bf16_t* Bt; int M, N, K; };

struct StaticOrder {
    int nM, nN, nwg, G, c;
    __host__ __device__ void init(int M, int N, int G_, int c_) { nM = M / BM; nN = N / BM; nwg = nM * nN; G = G_; c = c_; }
    __host__ __device__ bool next(int i, Unit& u) const {
        const long L = (long)i * G + c; if (L >= nwg) return false;
        int wgid = (int)L; { const int q = nwg / NXCD, r = nwg % NXCD, xcd = wgid % NXCD, off = wgid / NXCD; wgid = (xcd < r ? xcd * (q + 1) : r * (q + 1) + (xcd - r) * q) + off; }
        const int nig = WGM * nN, gid = wgid / nig, fm = gid * WGM, gsz = (nM - fm) < WGM ? (nM - fm) : WGM;
        u.pm = fm + ((wgid % nig) % gsz); u.pn = (wgid % nig) / gsz; return true;
    }
    __device__ __forceinline__ void a_ready(const Unit&) const {}
    __device__ __forceinline__ void done(const Unit&) const {}
};

__device__ __forceinline__ unsigned cvt_pk_bf16(float lo, float hi) { unsigned r; asm volatile("v_cvt_pk_bf16_f32 %0, %1, %2" : "=v"(r) : "v"(lo), "v"(hi)); return r; }
struct EpiBf16 {
    static constexpr bool PERM = true, AFTER_DRAIN = false;
    bf16_t* O; int ldc;
    __device__ __forceinline__ void operator()(const f32x4 (&acc)[2][2][4][2], const Unit& u, int wr, int wc, int fr, int fq) const {
        const int row0 = u.pm * BM + wr * 64 + fr; const int col0 = u.pn * BM + wc * 32 + 8 * fq;
#pragma unroll
        for (int ai = 0; ai < 2; ++ai)
#pragma unroll
            for (int m = 0; m < 4; ++m) { bf16_t* rowp = O + (size_t)(row0 + ai * HALF + m * 16) * ldc + col0;
#pragma unroll
                for (int bj = 0; bj < 2; ++bj) { const f32x4 v0 = acc[ai][bj][m][0], v1 = acc[ai][bj][m][1];
                    u32x4 w; w.x = cvt_pk_bf16(v0[0], v0[1]); w.y = cvt_pk_bf16(v0[2], v0[3]); w.z = cvt_pk_bf16(v1[0], v1[1]); w.w = cvt_pk_bf16(v1[2], v1[3]);
                    *(u32x4*)(rowp + bj * HALF) = w; } }
    }
};
struct EpiResGate {
    static constexpr bool PERM = false, AFTER_DRAIN = false;
    const float* base; float* out; const float* gate;
    __device__ __forceinline__ void operator()(const f32x4 (&acc)[2][2][4][2], const Unit& u, int wr, int wc, int fr, int fq) const {
        const int col0 = u.pn * BM + wc * 32 + 4 * fq; const int b = (u.pm * BM) >> 11;
        f32x4 gv[2][2];
#pragma unroll
        for (int bj = 0; bj < 2; ++bj)
#pragma unroll
            for (int n = 0; n < 2; ++n) gv[bj][n] = *(const f32x4*)(gate + (size_t)b * 3072 + col0 + bj * HALF + n * 16);
#pragma unroll
        for (int ai = 0; ai < 2; ++ai)
#pragma unroll
            for (int m = 0; m < 4; ++m) { const size_t off = (size_t)(u.pm * BM + ai * HALF + wr * 64 + m * 16 + fr) * 1024 + col0;
#pragma unroll
                for (int bj = 0; bj < 2; ++bj)
#pragma unroll
                    for (int n = 0; n < 2; ++n) { const f32x4 bs = *(const f32x4*)(base + off + bj * HALF + n * 16);
                        *(f32x4*)(out + off + bj * HALF + n * 16) = bs + gv[bj][n] * acc[ai][bj][m][n]; } }
    }
};

template <class Epi, class Sched, bool ALIGN_EPI = false, bool SP2 = false>
__device__ __forceinline__ void gemm_phase(PG8_LAS unsigned char* lds, const Gemm g, const Sched& S, const Epi& E) {
    const int tid = threadIdx.x, wid = __builtin_amdgcn_readfirstlane(tid >> 6), lane = tid & 63, wr = wid >> 2, wc = wid & 3, fr = lane & 15, fq = lane >> 4;
    const int K = g.K, nt = K / BK;
    unsigned voffA[2], voffB[2];
#pragma unroll
    for (int i = 0; i < 2; ++i) { int R, C; stage_rc(tid * 16 + i * 8192, R, C); const int Rb = Epi::PERM ? ((R & ~31) + perm32(R & 31)) : R;
        voffA[i] = (unsigned)(R * K + C) * 2u; voffB[i] = (unsigned)(Rb * K + C) * 2u; }
    const size_t kstep = (size_t)(BK * 2);
    const size_t hstep = (size_t)HALF * K * 2;
    const size_t tstep = 2 * hstep;
    const unsigned ldsw = (unsigned)wid * 1024u;
    const int aoff = lds_byte(wr * 64 + fr, fq * 8), boff = lds_byte(wc * 32 + fr, fq * 8);
#define PG8_SA(b, h) (((b) * 2 + (h)) * HTB)
#define PG8_SB(b, h) ((4 + (b) * 2 + (h)) * HTB)
#define PG8_STAGE(bufoff, gbase, voff) do { _Pragma("unroll") for (int _i = 0; _i < 2; ++_i) \
        __builtin_amdgcn_global_load_lds((const unsigned*)((const char*)(gbase) + (voff)[_i]), (PG8_LAS unsigned*)(lds + (bufoff) + ldsw + _i * 8192), 16, 0, 0); } while (0)
#define PG8_LDA(dst, b, h) do { _Pragma("unroll") for (int m = 0; m < 4; ++m) _Pragma("unroll") for (int k = 0; k < 2; ++k) dst[m][k] = *(const PG8_LAS bf16x8*)(lds + PG8_SA(b, h) + aoff + m * 2048 + k * 1024); } while (0)
#define PG8_LDB(dst, b, h) do { _Pragma("unroll") for (int n = 0; n < 2; ++n) _Pragma("unroll") for (int k = 0; k < 2; ++k) dst[n][k] = *(const PG8_LAS bf16x8*)(lds + PG8_SB(b, h) + boff + n * 2048 + k * 1024); } while (0)
#define PG8_MMA(ai, bj, At, Bt) do { __builtin_amdgcn_s_setprio(1); _Pragma("unroll") for (int m = 0; m < 4; ++m) _Pragma("unroll") for (int n = 0; n < 2; ++n) _Pragma("unroll") for (int k = 0; k < 2; ++k) \
        acc[ai][bj][m][n] = __builtin_amdgcn_mfma_f32_16x16x32_bf16(Bt[n][k], At[m][k], acc[ai][bj][m][n], 0, 0, 0); __builtin_amdgcn_s_setprio(0); } while (0)
#define PG8_WAIT_V(n) asm volatile("s_waitcnt vmcnt(" #n ")" ::: "memory")
#define PG8_WAIT_L(n) asm volatile("s_waitcnt lgkmcnt(" #n ")" ::: "memory")
#define PG8_BAR __builtin_amdgcn_s_barrier()
#define PG8_SCHED __builtin_amdgcn_sched_barrier(0)
    Unit cur, nxt; int ui = 0;
    if (!S.next(0, cur)) return;
    f32x4 acc[2][2][4][2];
#pragma unroll
    for (int a = 0; a < 2; ++a)
#pragma unroll
        for (int b = 0; b < 2; ++b)
#pragma unroll
            for (int m = 0; m < 4; ++m)
#pragma unroll
                for (int n = 0; n < 2; ++n) acc[a][b][m][n] = (f32x4){0.f, 0.f, 0.f, 0.f};
    bf16x8 At[4][2], B0[2][2], B1[2][2];
    const char* cA = (const char*)g.A + (size_t)cur.pm * tstep; const char* cB = (const char*)g.Bt + (size_t)cur.pn * tstep;
    S.a_ready(cur);
    if constexpr (SP2) {
        PG8_STAGE(PG8_SB(0, 0), cB, voffB); PG8_STAGE(PG8_SB(0, 1), cB + hstep, voffB); PG8_STAGE(PG8_SA(0, 0), cA, voffA); PG8_STAGE(PG8_SA(0, 1), cA + hstep, voffA);
        if (wr == 1) PG8_BAR;
        PG8_WAIT_V(2); PG8_BAR;
        PG8_STAGE(PG8_SB(1, 0), cB + kstep, voffB); PG8_STAGE(PG8_SA(1, 0), cA + kstep, voffA); PG8_STAGE(PG8_SB(1, 1), cB + hstep + kstep, voffB);
        PG8_WAIT_V(6); PG8_BAR;
    } else {
        PG8_STAGE(PG8_SB(0, 0), cB, voffB); PG8_STAGE(PG8_SA(0, 0), cA, voffA); PG8_STAGE(PG8_SB(0, 1), cB + hstep, voffB); PG8_STAGE(PG8_SA(0, 1), cA + hstep, voffA);
        if (wr == 1) PG8_BAR;
        PG8_WAIT_V(4); PG8_BAR;
        PG8_STAGE(PG8_SB(1, 0), cB + kstep, voffB); PG8_STAGE(PG8_SA(1, 0), cA + kstep, voffA); PG8_STAGE(PG8_SB(1, 1), cB + hstep + kstep, voffB);
        PG8_WAIT_V(6); PG8_BAR;
    }
    for (;;) {
        const bool has_next = S.next(ui + 1, nxt);
        const char* nA = has_next ? (const char*)g.A + (size_t)nxt.pm * tstep : cA; const char* nB = has_next ? (const char*)g.Bt + (size_t)nxt.pn * tstep : cB;
        for (int t = 0; t < nt; t += 2) {
            const bool last = (t == nt - 2);
            const char* a1 = cA + (size_t)(t + 1) * kstep;
            const char* a2 = last ? nA : cA + (size_t)(t + 2) * kstep; const char* b2 = last ? nB : cB + (size_t)(t + 2) * kstep;
            const char* a3 = a2 + kstep; const char* b3 = b2 + kstep;
            if (last && has_next) S.a_ready(nxt);
            if constexpr (SP2) {
            PG8_LDB(B0, 0, 0); PG8_LDB(B1, 0, 1); PG8_SCHED; PG8_LDA(At, 0, 0); PG8_STAGE(PG8_SA(1, 1), a1 + hstep, voffA);
            PG8_WAIT_V(8); PG8_WAIT_L(0); PG8_BAR; PG8_MMA(0, 0, At, B0); PG8_MMA(0, 1, At, B1); PG8_BAR; PG8_SCHED;
            PG8_LDA(At, 0, 1); PG8_STAGE(PG8_SB(0, 0), b2, voffB); PG8_STAGE(PG8_SB(0, 1), b2 + hstep, voffB); PG8_STAGE(PG8_SA(0, 0), a2, voffA);
            PG8_WAIT_V(8); PG8_WAIT_L(0); PG8_BAR; PG8_MMA(1, 0, At, B0); PG8_MMA(1, 1, At, B1); PG8_BAR; PG8_SCHED;
            PG8_LDB(B0, 1, 0); PG8_LDB(B1, 1, 1); PG8_SCHED; PG8_LDA(At, 1, 0); PG8_STAGE(PG8_SA(0, 1), a2 + hstep, voffA);
            PG8_WAIT_V(8); PG8_WAIT_L(0); PG8_BAR; PG8_MMA(0, 0, At, B0); PG8_MMA(0, 1, At, B1); PG8_BAR; PG8_SCHED;
            PG8_LDA(At, 1, 1); PG8_STAGE(PG8_SB(1, 0), b3, voffB); PG8_STAGE(PG8_SB(1, 1), b3 + hstep, voffB); PG8_STAGE(PG8_SA(1, 0), a3, voffA);
            PG8_WAIT_V(8); PG8_WAIT_L(0); PG8_BAR; PG8_MMA(1, 0, At, B0); PG8_MMA(1, 1, At, B1); PG8_BAR; PG8_SCHED;
            } else {
            PG8_LDB(B0, 0, 0); PG8_SCHED; PG8_LDA(At, 0, 0); PG8_STAGE(PG8_SA(1, 1), a1 + hstep, voffA);
            PG8_WAIT_L(8); PG8_BAR; PG8_WAIT_L(0); PG8_MMA(0, 0, At, B0); PG8_BAR; PG8_SCHED;
            PG8_LDB(B1, 0, 1); PG8_STAGE(PG8_SB(0, 0), b2, voffB);
            PG8_BAR; PG8_WAIT_L(0); PG8_MMA(0, 1, At, B1); PG8_BAR;
            PG8_LDA(At, 0, 1); PG8_STAGE(PG8_SA(0, 0), a2, voffA);
            PG8_BAR; PG8_WAIT_L(0); PG8_MMA(1, 0, At, B0); PG8_BAR; PG8_SCHED;
            PG8_STAGE(PG8_SB(0, 1), b2 + hstep, voffB);
            PG8_WAIT_V(6); PG8_BAR; PG8_MMA(1, 1, At, B1); PG8_BAR;
            PG8_LDB(B0, 1, 0); PG8_SCHED; PG8_LDA(At, 1, 0); PG8_STAGE(PG8_SA(0, 1), a2 + hstep, voffA);
            PG8_WAIT_L(8); PG8_BAR; PG8_WAIT_L(0); PG8_MMA(0, 0, At, B0); PG8_BAR; PG8_SCHED;
            PG8_LDB(B1, 1, 1); PG8_STAGE(PG8_SB(1, 0), b3, voffB);
            PG8_BAR; PG8_WAIT_L(0); PG8_MMA(0, 1, At, B1); PG8_BAR;
            PG8_LDA(At, 1, 1); PG8_STAGE(PG8_SA(1, 0), a3, voffA);
            PG8_BAR; PG8_WAIT_L(0); PG8_MMA(1, 0, At, B0); PG8_BAR; PG8_SCHED;
            PG8_STAGE(PG8_SB(1, 1), b3 + hstep, voffB);
            PG8_WAIT_V(6); PG8_BAR; PG8_MMA(1, 1, At, B1); PG8_BAR;
            }
        }
        if constexpr (ALIGN_EPI) { if (wr == 0) PG8_BAR; }
        if constexpr (!Epi::AFTER_DRAIN) { E(acc, cur, wr, wc, fr, fq); S.done(cur); }
        if (!has_next) break;
#pragma unroll
        for (int a = 0; a < 2; ++a)
#pragma unroll
            for (int b = 0; b < 2; ++b)
#pragma unroll
                for (int m = 0; m < 4; ++m)
#pragma unroll
                    for (int n = 0; n < 2; ++n) acc[a][b][m][n] = (f32x4){0.f, 0.f, 0.f, 0.f};
        cur = nxt; cA = nA; cB = nB; ++ui;
        if constexpr (ALIGN_EPI) { if (wr == 1) PG8_BAR; }
    }
    PG8_WAIT_V(0);
    if constexpr (!ALIGN_EPI) { if (wr == 0) PG8_BAR; }
    PG8_BAR;
    if constexpr (Epi::AFTER_DRAIN) { E.fused(acc, cur, wr, wc, fr, fq, lds, wid, lane); S.done(cur); }
#undef PG8_SA
#undef PG8_SB
#undef PG8_STAGE
#undef PG8_LDA
#undef PG8_LDB
#undef PG8_MMA
#undef PG8_WAIT_V
#undef PG8_WAIT_L
#undef PG8_BAR
#undef PG8_SCHED
}
}

#ifndef PG8_SP2
#define PG8_SP2 true
#endif
#ifndef PG8_ALIGN
#define PG8_ALIGN true
#endif
#define GAS __attribute__((address_space(1)))
#define LAS __attribute__((address_space(3)))
typedef unsigned short bf16;
typedef unsigned v4u __attribute__((ext_vector_type(4)));
typedef float f32x4 __attribute__((ext_vector_type(4)));
typedef short bf16x8 __attribute__((ext_vector_type(8)));
typedef GAS unsigned gu32;
typedef GAS unsigned long long gu64;
#define RLX_AGENT __ATOMIC_RELAXED, __HIP_MEMORY_SCOPE_AGENT
#define LDS_WAIT() asm volatile("s_waitcnt lgkmcnt(0)" ::: "memory")
#define VM_WAIT() asm volatile("s_waitcnt vmcnt(0)" ::: "memory")
__device__ __forceinline__ unsigned long long rt() { return __builtin_amdgcn_s_memrealtime(); }
__device__ __forceinline__ unsigned f2bf(float f) { unsigned u = __builtin_bit_cast(unsigned, f); return (u + 0x7fffu + ((u >> 16) & 1u)) >> 16; }
__device__ __forceinline__ unsigned pk2(float lo, float hi) { return f2bf(lo) | (f2bf(hi) << 16); }

#define XB_TMO      128
#define XB_XCNT(j)  (256  + 64 * (j))
#define XB_XSUB(j)  (1280 + 64 * (j))
#define XB_XGEN(j)  (2304 + 64 * (j))
#define XB_TOP      3328
#define XB_TOPGEN   3392
#define XCD_BAR_WORDS 3456
#define XB_SPIN_CAP (1u << 22)

__device__ __forceinline__ unsigned xb_ld(unsigned* p)              { return __hip_atomic_load(p, __ATOMIC_RELAXED, __HIP_MEMORY_SCOPE_AGENT); }
__device__ __forceinline__ unsigned xb_add(unsigned* p, unsigned v) { return __hip_atomic_fetch_add(p, v, __ATOMIC_RELAXED, __HIP_MEMORY_SCOPE_AGENT); }
__device__ __forceinline__ unsigned xb_xcc_id() { return (unsigned)__builtin_amdgcn_s_getreg((3 << 11) | 20) & 0xFu; }
#define XB_SPIN(cond, bar) do { unsigned _sp = 0; while (cond) { __builtin_amdgcn_s_sleep(1); \
    if ((++_sp & 255u) == 0u) { if (xb_ld(&(bar)[XB_TMO])) break; if (_sp > XB_SPIN_CAP) { atomicAdd(&(bar)[XB_TMO], 1u); break; } } } } while (0)

struct XcdBarrier {
    unsigned* bar; unsigned x;
    volatile LAS unsigned* st;
};

__device__ __forceinline__ XcdBarrier xcd_barrier_post(unsigned* bar, volatile LAS unsigned* st) {
    XcdBarrier b; b.bar = bar; b.x = xb_xcc_id(); b.st = st;
    if (threadIdx.x == 0) (void)xb_add(&bar[XB_XCNT(b.x)], 1u);
    return b;
}
__device__ __forceinline__ void xcd_barrier_complete(unsigned* bar, unsigned x, unsigned& nloc, unsigned& nx) {
    const unsigned G = gridDim.x * gridDim.y * gridDim.z;
    unsigned sum, cnt, mine, sp = 0u;
    for (;;) {
        sum = 0u; cnt = 0u; mine = 0u;
#pragma unroll
        for (unsigned j = 0; j < 16; ++j) { const unsigned c = xb_ld(&bar[XB_XCNT(j)]); sum += c; cnt += (c > 0u) ? 1u : 0u; mine = (j == x) ? c : mine; }
        if (sum == G) break;
        __builtin_amdgcn_s_sleep(1);
        if ((++sp & 255u) == 0u) { if (xb_ld(&bar[XB_TMO])) break; if (sp > XB_SPIN_CAP) { atomicAdd(&bar[XB_TMO], 1u); break; } }
    }
    nloc = mine > 0u ? mine : 1u; nx = cnt > 0u ? cnt : 1u;
}

__device__ __forceinline__ void xcd_barrier(const XcdBarrier& b) {
    asm volatile("s_waitcnt vmcnt(0)" ::: "memory");
    __syncthreads();
    if (threadIdx.x == 0) {
        unsigned* bar = b.bar;
        __builtin_amdgcn_s_waitcnt(0);
        unsigned nloc = b.st[0], nx = b.st[1];
        if (nloc == 0u) { xcd_barrier_complete(bar, b.x, nloc, nx); b.st[0] = nloc; b.st[1] = nx; }
        const unsigned old = xb_add(&bar[XB_XSUB(b.x)], 1u);
        const unsigned gen = old / nloc;
        if (old + 1u == (gen + 1u) * nloc) {
            __builtin_amdgcn_fence(__ATOMIC_RELEASE, "agent");
            asm volatile("s_waitcnt vmcnt(0)" ::: "memory");
            const unsigned og = xb_add(&bar[XB_TOP], 1u);
            const unsigned tg = og / nx;
            if (og + 1u == (tg + 1u) * nx) xb_add(&bar[XB_TOPGEN], 1u);
            else XB_SPIN(xb_ld(&bar[XB_TOPGEN]) == tg, bar);
            __builtin_amdgcn_fence(__ATOMIC_ACQUIRE, "agent");
            xb_add(&bar[XB_XGEN(b.x)], 1u);
            asm volatile("s_waitcnt vmcnt(0)" ::: "memory");
        } else {
            XB_SPIN(xb_ld(&bar[XB_XGEN(b.x)]) == gen, bar);
            __builtin_amdgcn_fence(__ATOMIC_ACQUIRE, "agent");
            asm volatile("s_waitcnt vmcnt(0)" ::: "memory");
        }
    }
    __syncthreads();
}


constexpr int NWAVES = 8;
constexpr int BATCH = 16, SEQ = 2048, D = 1024, M = BATCH * SEQ;
constexpr int EVEN_IN = 3712, EVEN_PAD = 3840, ODD_IN = 2304;
constexpr int C_R = 0, C_K = 512, C_V = 1024, C_WLO = 1536, C_ALO = 1600, C_U = 1664, C_VG = 2176, C_Z0 = 2688;
constexpr int C_Q = 0, C_KC = 1024, C_VC = 1152, C_Z1 = 1280;
enum { I_X = 0, I_C, I_ADAW, I_ADAB, I_NORMG, I_EWIN, I_EMU, I_EW0, I_EWUP, I_EA0, I_EAUP, I_EKK, I_EKA, I_ERK, I_ELNXG, I_ELNXB, I_ESGLNG, I_ESGLNB, I_ESGW, I_ESGB, I_EWOUT, I_OWIN, I_OSINKS, I_OWOUT, I_FINALG, N_IN };

constexpr size_t MiB = 1u << 20;
constexpr size_t WS_CTL = 0, CTL_ZERO_BYTES = 64 * 1024;
constexpr size_t WS_MOD = 1 * MiB;
constexpr size_t WS_WIN0 = 2 * MiB, WS_WOUT0 = 10 * MiB, WS_WIN1 = 12 * MiB, WS_WOUT1 = 17 * MiB;
constexpr size_t WS_XN = 32 * MiB, WS_MIX = 96 * MiB, WS_P = 160 * MiB, WS_YRAW = 400 * MiB, WS_BON = 464 * MiB, WS_END = 466 * MiB;
constexpr size_t WS_WUT = 20 * MiB, WS_AUT = 21 * MiB;
constexpr int CW_BAR = 4096;

constexpr int RING_BYTES = 131072, LDS_BYTES = 147456, LDSCTL_OFF = LDS_BYTES - 512, MISC_OFF = LDSCTL_OFF;

__device__ __forceinline__ float bf2f(unsigned short h) { return __builtin_bit_cast(float, (unsigned)h << 16); }
__device__ __forceinline__ float bflo(unsigned w) { return __builtin_bit_cast(float, w << 16); }
__device__ __forceinline__ float bfhi(unsigned w) { return __builtin_bit_cast(float, w & 0xffff0000u); }
__device__ __forceinline__ float wave_sum(float v) {
#pragma unroll
    for (int o = 1; o < 64; o <<= 1) v += __shfl_xor(v, o);
    return v;
}
__device__ __forceinline__ float siluf(float x) { return x / (1.f + __expf(-x)); }

struct Args { const float* in[N_IN]; float* out; unsigned char* ws; int ph_lo, ph_hi; };

__device__ __forceinline__ void p0_transpose_item(const float* W, int K, int N, bf16* WT, LAS float* scr, int item, int lane) {
    const int nblk = N / 32, kb = item / nblk, nb = item % nblk, k0 = 64 * kb, n0 = 32 * nb;
#pragma unroll 8
    for (int i = 0; i < 32; ++i) { const int kk = 2 * i + (lane >> 5); scr[kk * 33 + (lane & 31)] = W[(size_t)(k0 + kk) * N + n0 + (lane & 31)]; }
    LDS_WAIT(); asm volatile("" ::: "memory");
    const int c = lane & 7;
#pragma unroll
    for (int j = 0; j < 4; ++j) { const int n = (lane >> 3) + 8 * j; const LAS float* s = scr + (8 * c) * 33 + n;
        v4u o; o.x = pk2(s[0 * 33], s[1 * 33]); o.y = pk2(s[2 * 33], s[3 * 33]); o.z = pk2(s[4 * 33], s[5 * 33]); o.w = pk2(s[6 * 33], s[7 * 33]);
        *(GAS v4u*)(WT + (size_t)(n0 + n) * K + k0 + 8 * c) = o; }
    LDS_WAIT(); asm volatile("" ::: "memory");
}
__device__ __forceinline__ void phase0(const Args& a, LAS unsigned char* lds, int tid, int lane, int wave, int vcu, int G) {
    unsigned char* ws = a.ws;
    if (vcu < 96) {
        LAS float* condT = (LAS float*)lds;
        LAS float* part = (LAS float*)(lds + 65536);
        const float* c = a.in[I_C];
        for (int idx = tid; idx < 16384; idx += 512) { const int b = idx >> 10, k = idx & 1023; condT[k * 16 + b] = siluf(c[idx]); }
        __syncthreads();
        for (int it = vcu; it < 96; it += G) {
            const int l = it / 48, n0 = (it % 48) * 64;
            const float* W = a.in[I_ADAW] + (size_t)l * 1024 * 3072 + n0 + lane;
            float acc[16];
#pragma unroll
            for (int b = 0; b < 16; ++b) acc[b] = 0.f;
            const int kbeg = wave * 128;
#pragma unroll 4
            for (int k = kbeg; k < kbeg + 128; ++k) {
                const float w = W[(size_t)k * 3072];
                const LAS f32x4* cv = (const LAS f32x4*)(condT + k * 16);
                const f32x4 c0 = cv[0], c1 = cv[1], c2 = cv[2], c3 = cv[3];
                acc[0] += c0[0] * w; acc[1] += c0[1] * w; acc[2] += c0[2] * w; acc[3] += c0[3] * w;
                acc[4] += c1[0] * w; acc[5] += c1[1] * w; acc[6] += c1[2] * w; acc[7] += c1[3] * w;
                acc[8] += c2[0] * w; acc[9] += c2[1] * w; acc[10] += c2[2] * w; acc[11] += c2[3] * w;
                acc[12] += c3[0] * w; acc[13] += c3[1] * w; acc[14] += c3[2] * w; acc[15] += c3[3] * w;
            }
#pragma unroll
            for (int b = 0; b < 16; ++b) part[(wave * 16 + b) * 64 + lane] = acc[b];
            __syncthreads();
            float* mod = (float*)(ws + WS_MOD);
#pragma unroll
            for (int q = 0; q < 2; ++q) { const int b = (tid >> 6) + 8 * q; float s = 0.f;
#pragma unroll
                for (int w8 = 0; w8 < 8; ++w8) s += part[(w8 * 16 + b) * 64 + lane];
                mod[(size_t)(l * 16 + b) * 3072 + n0 + lane] = s + a.in[I_ADAB][l * 3072 + n0 + lane]; }
            __syncthreads();
        }
    }
    __syncthreads();
    LAS float* scr = (LAS float*)(lds + wave * 16384);
    const int gw = vcu * NWAVES + wave, NGW = G * NWAVES;
    constexpr int I0 = (D / 64) * (EVEN_IN / 32), I1 = (D / 64) * (D / 32), I2 = (D / 64) * (ODD_IN / 32), I3 = I1, IZ = EVEN_PAD - EVEN_IN;
    for (int it = gw; it < I0 + I1 + I2 + I3 + IZ; it += NGW) {
        int r = it;
        if (r < I0) { p0_transpose_item(a.in[I_EWIN], D, EVEN_IN, (bf16*)(ws + WS_WIN0), scr, r, lane); continue; } r -= I0;
        if (r < I1) { p0_transpose_item(a.in[I_EWOUT], D, D, (bf16*)(ws + WS_WOUT0), scr, r, lane); continue; } r -= I1;
        if (r < I2) { p0_transpose_item(a.in[I_OWIN], D, ODD_IN, (bf16*)(ws + WS_WIN1), scr, r, lane); continue; } r -= I2;
        if (r < I3) { p0_transpose_item(a.in[I_OWOUT], D, D, (bf16*)(ws + WS_WOUT1), scr, r, lane); continue; } r -= I3;
        { GAS v4u* o = (GAS v4u*)((bf16*)(ws + WS_WIN0) + (size_t)(EVEN_IN + r) * D); const v4u z = {0u, 0u, 0u, 0u}; o[lane] = z; o[lane + 64] = z; }
    }
    for (int idx = (vcu * NWAVES + wave) * 64 + lane; idx < 512 * 64; idx += G * NWAVES * 64) { const int n = idx >> 6, m = idx & 63;
        ((bf16*)(ws + WS_WUT))[idx] = (bf16)f2bf(a.in[I_EWUP][m * 512 + n]); ((bf16*)(ws + WS_AUT))[idx] = (bf16)f2bf(a.in[I_EAUP][m * 512 + n]); }
}

__device__ __forceinline__ void phase_adaln_rows(const float* xin, const float* g, const float* modl, bf16* XN, int lane, int wave, int vcu, int G) {
    const int gw = vcu * NWAVES + wave, NGW = G * NWAVES;
    for (int r0 = gw * 16; r0 < M; r0 += NGW * 16) {
        const int b = r0 >> 11;
        f32x4 gs[4], sh[4];
#pragma unroll
        for (int j = 0; j < 4; ++j) { const int c = 4 * lane + 256 * j;
            const f32x4 gg = *(const f32x4*)(g + c), sc = *(const f32x4*)(modl + (size_t)b * 3072 + 1024 + c);
            gs[j] = gg * (sc + 1.0f); sh[j] = *(const f32x4*)(modl + (size_t)b * 3072 + c); }
        for (int r = r0; r < r0 + 16; ++r) {
            const GAS f32x4* xr = (const GAS f32x4*)(xin + (size_t)r * D) + lane;
            f32x4 v[4]; float s = 0.f;
#pragma unroll
            for (int j = 0; j < 4; ++j) { v[j] = xr[64 * j]; s += (v[j].x * v[j].x + v[j].y * v[j].y) + (v[j].z * v[j].z + v[j].w * v[j].w); }
            const float rs = 1.0f / sqrtf(wave_sum(s) * (1.f / D) + 1e-6f);
            GAS unsigned long long* o8 = (GAS unsigned long long*)(XN + (size_t)r * D) + lane;
#pragma unroll
            for (int j = 0; j < 4; ++j) { const f32x4 o = v[j] * rs * gs[j] + sh[j];
                o8[64 * j] = (unsigned long long)pk2(o.x, o.y) | ((unsigned long long)pk2(o.z, o.w) << 32); }
        }
    }
}
__device__ __forceinline__ void phase_final_rows(float* xio, const float* g, int lane, int wave, int vcu, int G) {
    const int gw = vcu * NWAVES + wave, NGW = G * NWAVES;
    f32x4 gs[4];
#pragma unroll
    for (int j = 0; j < 4; ++j) gs[j] = *(const f32x4*)(g + 4 * lane + 256 * j);
    for (int r = gw; r < M; r += NGW) {
        GAS f32x4* xr = (GAS f32x4*)(xio + (size_t)r * D) + lane;
        f32x4 v[4]; float s = 0.f;
#pragma unroll
        for (int j = 0; j < 4; ++j) { v[j] = xr[64 * j]; s += (v[j].x * v[j].x + v[j].y * v[j].y) + (v[j].z * v[j].z + v[j].w * v[j].w); }
        const float rs = 1.0f / sqrtf(wave_sum(s) * (1.f / D) + 1e-6f);
#pragma unroll
        for (int j = 0; j < 4; ++j) xr[64 * j] = v[j] * rs * gs[j];
    }
}

__device__ __forceinline__ void phase_rwkv(const Args& a, LAS unsigned char* lds, int tid, int lane, int wave, int vcu, int G) {
    const bf16* P = (const bf16*)(a.ws + WS_P); bf16* MIX = (bf16*)(a.ws + WS_MIX);
    LAS float* WUP = (LAS float*)lds;
    LAS float* AUP = WUP + 4096;
    LAS float* TW = AUP + 4096;
    LAS float* AL = TW + 2048;
    LAS float* Rr = AL + 2048;
    LAS float* KR = Rr + 2048;
    LAS float* Vv = KR + 2048;
    LAS float* Wd = Vv + 2048;
    LAS float* KK = Wd + 2048;
    LAS float* Bb = KK + 2048;
    LAS float* Yy = Bb + 2048;
    LAS float* BON = Yy + 2048;
    for (int unit = vcu; unit < BATCH * 8; unit += G) {
        const int b = unit >> 3, h = unit & 7;
        __syncthreads();
        for (int idx = tid; idx < 4096; idx += 512) { const int m = idx >> 6, j = idx & 63; WUP[idx] = a.in[I_EWUP][m * 512 + h * 64 + j]; AUP[idx] = a.in[I_EAUP][m * 512 + h * 64 + j]; }
        float S[8];
#pragma unroll
        for (int j = 0; j < 8; ++j) S[j] = 0.f;
        const int hj = h * 64 + lane;
        const float w0 = a.in[I_EW0][hj], a0 = a.in[I_EA0][hj], k_k = a.in[I_EKK][hj], k_a = a.in[I_EKA][hj], r_k = a.in[I_ERK][hj], lng = a.in[I_ELNXG][hj], lnb = a.in[I_ELNXB][hj];
        for (int ck = 0; ck < SEQ / 32; ++ck) {
            const int t0 = ck * 32;
            { const int i = tid >> 4, sub = tid & 15; const int t = t0 + i; const bf16* pc = P + (size_t)(b * SEQ + t) * EVEN_PAD; const bf16* pp = pc - EVEN_PAD; const bool hasp = t > 0;
#pragma unroll
              for (int grp = 0; grp < 5; ++grp) {
                  const int col = (grp == 0 ? C_R + h * 64 : grp == 1 ? C_K + h * 64 : grp == 2 ? C_V + h * 64 : grp == 3 ? C_WLO : C_ALO) + 4 * sub;
                  const uint2 cu = *(const uint2*)(pc + col); uint2 pu = {0u, 0u}; if (hasp) pu = *(const uint2*)(pp + col);
                  const f32x4 mu = *(const f32x4*)(a.in[I_EMU] + col);
                  float cv[4] = {bflo(cu.x), bfhi(cu.x), bflo(cu.y), bfhi(cu.y)}, pv[4] = {bflo(pu.x), bfhi(pu.x), bflo(pu.y), bfhi(pu.y)};
                  f32x4 xs;
#pragma unroll
                  for (int e = 0; e < 4; ++e) xs[e] = cv[e] + mu[e] * (pv[e] - cv[e]);
                  if (grp == 3) { xs[0] = tanhf(xs[0]); xs[1] = tanhf(xs[1]); xs[2] = tanhf(xs[2]); xs[3] = tanhf(xs[3]); }
                  LAS float* dst = (grp == 0 ? Rr : grp == 1 ? KR : grp == 2 ? Vv : grp == 3 ? TW : AL) + i * 64 + 4 * sub;
                  *(LAS f32x4*)dst = xs;
              } }
            __syncthreads();
            { float accw[4] = {0.f, 0.f, 0.f, 0.f}, acca[4] = {0.f, 0.f, 0.f, 0.f};
              for (int m4 = 0; m4 < 16; ++m4) {
                  f32x4 tw[4], al[4];
#pragma unroll
                  for (int q = 0; q < 4; ++q) { tw[q] = *(const LAS f32x4*)(TW + (wave + 8 * q) * 64 + 4 * m4); al[q] = *(const LAS f32x4*)(AL + (wave + 8 * q) * 64 + 4 * m4); }
#pragma unroll
                  for (int e = 0; e < 4; ++e) { const float wu = WUP[(4 * m4 + e) * 64 + lane], au = AUP[(4 * m4 + e) * 64 + lane];
#pragma unroll
                      for (int q = 0; q < 4; ++q) { accw[q] += tw[q][e] * wu; acca[q] += al[q][e] * au; } }
              }
#pragma unroll
              for (int q = 0; q < 4; ++q) { const int i = wave + 8 * q;
                  const float wv = w0 + accw[q];
                  const float nx = -wv; const float sp = fmaxf(nx, 0.f) + log1pf(__expf(-fabsf(nx)));
                  const float wl = -sp - 0.5f; const float decay = __expf(-__expf(wl));
                  const float av = 1.f / (1.f + __expf(-(a0 + acca[q])));
                  const float kraw = KR[i * 64 + lane]; const float kkv = kraw * k_k;
                  const float ss = wave_sum(kkv * kkv); const float kk = kkv / fmaxf(sqrtf(ss), 1e-12f);
                  const float kp = kraw * (1.f + (av - 1.f) * k_a);
                  const float bon = wave_sum(Rr[i * 64 + lane] * kp * r_k);
                  Wd[i * 64 + lane] = decay; KR[i * 64 + lane] = kp; KK[i * 64 + lane] = kk; Bb[i * 64 + lane] = kk * av; if (lane == 0) BON[i] = bon; } }
            __syncthreads();
            { const int row = wave * 8 + (lane >> 3), c8 = (lane & 7) * 8;
              for (int i = 0; i < 32; ++i) {
                  const f32x4 k0 = *(const LAS f32x4*)(KK + i * 64 + c8), k1 = *(const LAS f32x4*)(KK + i * 64 + c8 + 4);
                  const f32x4 w0v = *(const LAS f32x4*)(Wd + i * 64 + c8), w1v = *(const LAS f32x4*)(Wd + i * 64 + c8 + 4);
                  const f32x4 b0 = *(const LAS f32x4*)(Bb + i * 64 + c8), b1 = *(const LAS f32x4*)(Bb + i * 64 + c8 + 4);
                  const f32x4 p0 = *(const LAS f32x4*)(KR + i * 64 + c8), p1 = *(const LAS f32x4*)(KR + i * 64 + c8 + 4);
                  const f32x4 r0 = *(const LAS f32x4*)(Rr + i * 64 + c8), r1 = *(const LAS f32x4*)(Rr + i * 64 + c8 + 4);
                  const float vv = Vv[i * 64 + row];
                  float sa = (S[0] * k0[0] + S[1] * k0[1]) + (S[2] * k0[2] + S[3] * k0[3]) + (S[4] * k1[0] + S[5] * k1[1]) + (S[6] * k1[2] + S[7] * k1[3]);
                  sa += __shfl_xor(sa, 1); sa += __shfl_xor(sa, 2); sa += __shfl_xor(sa, 4); sa = -sa;
                  S[0] = S[0] * w0v[0] + sa * b0[0] + vv * p0[0]; S[1] = S[1] * w0v[1] + sa * b0[1] + vv * p0[1];
                  S[2] = S[2] * w0v[2] + sa * b0[2] + vv * p0[2]; S[3] = S[3] * w0v[3] + sa * b0[3] + vv * p0[3];
                  S[4] = S[4] * w1v[0] + sa * b1[0] + vv * p1[0]; S[5] = S[5] * w1v[1] + sa * b1[1] + vv * p1[1];
                  S[6] = S[6] * w1v[2] + sa * b1[2] + vv * p1[2]; S[7] = S[7] * w1v[3] + sa * b1[3] + vv * p1[3];
                  float y = (S[0] * r0[0] + S[1] * r0[1]) + (S[2] * r0[2] + S[3] * r0[3]) + (S[4] * r1[0] + S[5] * r1[1]) + (S[6] * r1[2] + S[7] * r1[3]);
                  y += __shfl_xor(y, 1); y += __shfl_xor(y, 2); y += __shfl_xor(y, 4);
                  if ((lane & 7) == 0) Yy[i * 64 + row] = y;
              } }
            __syncthreads();
#pragma unroll
            for (int q = 0; q < 4; ++q) { const int i = wave * 4 + q; const size_t rowg = (size_t)(b * SEQ + t0 + i);
                const float y = Yy[i * 64 + lane]; const float mean = wave_sum(y) * (1.f / 64.f); const float d = y - mean; const float var = wave_sum(d * d) * (1.f / 64.f);
                const float o = d * (1.0f / sqrtf(var + 64e-5f)) * lng + lnb + BON[i] * Vv[i * 64 + lane];
                const float z = bf2f(P[rowg * EVEN_PAD + C_Z0 + hj]);
                MIX[rowg * D + hj] = (bf16)f2bf(o * siluf(z)); }
            __syncthreads();
        }
    }
}

typedef unsigned u32x2 __attribute__((ext_vector_type(2)));
#define DPP_ADD(x, ctrl) x += __builtin_bit_cast(float, __builtin_amdgcn_update_dpp(0, __builtin_bit_cast(int, x), ctrl, 0xF, 0xF, true))
__device__ __forceinline__ float row_sum16(float x) { DPP_ADD(x, 0xB1); DPP_ADD(x, 0x4E); DPP_ADD(x, 0x124); DPP_ADD(x, 0x128); return x; }
__device__ __forceinline__ void split_bf(float x, unsigned& hi, unsigned& lo) { hi = f2bf(x); lo = f2bf(x - __builtin_bit_cast(float, hi << 16)); }
__device__ __forceinline__ float wave_sum_fast(float x) { x = row_sum16(x);
    const int xi = __builtin_bit_cast(int, x);
    return (__builtin_bit_cast(float, __builtin_amdgcn_readlane(xi, 0)) + __builtin_bit_cast(float, __builtin_amdgcn_readlane(xi, 16))) + (__builtin_bit_cast(float, __builtin_amdgcn_readlane(xi, 32)) + __builtin_bit_cast(float, __builtin_amdgcn_readlane(xi, 48))); }
__device__ __forceinline__ float fast_tanh(float x) { const float t = __expf(2.f * x); return 1.f - 2.f * __builtin_amdgcn_rcpf(t + 1.f); }
__device__ __forceinline__ void phase_rwkv2(const Args& a, LAS unsigned char* lds, int tid, int lane, int wave, int vcu, int G) {
    const bf16* P = (const bf16*)(a.ws + WS_P); float* YRAW = (float*)(a.ws + WS_YRAW); float* BONG = (float*)(a.ws + WS_BON);
    LAS float* Rr = (LAS float*)lds;
    LAS float* KR = Rr + 2048;
    LAS float* KK = KR + 2048;
    LAS float* Wd = KK + 2048;
    LAS float* Bb = Wd + 2048;
    LAS float* Vv = (LAS float*)(lds + 40960);
    LAS float* Yy = (LAS float*)(lds + 45056);
    LAS bf16* TWh = (LAS bf16*)(lds + 49152);
    LAS bf16* TWl = TWh + 32 * 72;
    LAS bf16* ALh = TWl + 32 * 72;
    LAS bf16* ALl = ALh + 32 * 72;
    LAS bf16* WUh = (LAS bf16*)(lds + 67584);
    LAS bf16* WUl = WUh + 64 * 72;
    LAS bf16* AUh = WUl + 64 * 72;
    LAS bf16* AUl = AUh + 64 * 72;
    for (int unit = vcu; unit < BATCH * 16; unit += G) {
        const int bh = unit >> 1, half = unit & 1, b = bh >> 3, h = bh & 7;
        __syncthreads();
        for (int idx = tid; idx < 4096; idx += 512) { const int m = idx >> 6, j = idx & 63; unsigned hi, lo;
            split_bf(a.in[I_EWUP][m * 512 + h * 64 + j], hi, lo); WUh[j * 72 + m] = (bf16)hi; WUl[j * 72 + m] = (bf16)lo;
            split_bf(a.in[I_EAUP][m * 512 + h * 64 + j], hi, lo); AUh[j * 72 + m] = (bf16)hi; AUl[j * 72 + m] = (bf16)lo; }
        float S[4] = {0.f, 0.f, 0.f, 0.f};
        const int hj = h * 64 + lane;
        const float w0 = a.in[I_EW0][hj], a0 = a.in[I_EA0][hj], k_k = a.in[I_EKK][hj], k_a = a.in[I_EKA][hj], r_k = a.in[I_ERK][hj];
        const int c4 = (lane & 15) * 4, rowl = wave * 4 + (lane >> 4);
        const int i1 = tid >> 4, sub = tid & 15;
        const int col0 = C_R + h * 64 + 4 * sub, col1 = C_K + h * 64 + 4 * sub, col2 = C_V + h * 64 + 4 * sub, col3 = C_WLO + 4 * sub, col4 = C_ALO + 4 * sub;
        const f32x4 mu0 = *(const f32x4*)(a.in[I_EMU] + col0), mu1 = *(const f32x4*)(a.in[I_EMU] + col1), mu2 = *(const f32x4*)(a.in[I_EMU] + col2), mu3 = *(const f32x4*)(a.in[I_EMU] + col3), mu4 = *(const f32x4*)(a.in[I_EMU] + col4);
        const bf16* prow = P + (size_t)(b * SEQ + i1) * EVEN_PAD;
        u32x2 c0v, c1v, c2v, c3v, c4v, p0v, p1v, p2v, p3v, p4v;
#define RW_PREFETCH(t0_) do { const bf16* pc_ = prow + (size_t)(t0_) * EVEN_PAD; \
            c0v = *(const u32x2*)(pc_ + col0); c1v = *(const u32x2*)(pc_ + col1); c2v = *(const u32x2*)(pc_ + col2); c3v = *(const u32x2*)(pc_ + col3); c4v = *(const u32x2*)(pc_ + col4); \
            if ((t0_) + i1 > 0) { const bf16* pp_ = pc_ - EVEN_PAD; p0v = *(const u32x2*)(pp_ + col0); p1v = *(const u32x2*)(pp_ + col1); p2v = *(const u32x2*)(pp_ + col2); p3v = *(const u32x2*)(pp_ + col3); p4v = *(const u32x2*)(pp_ + col4); } \
            else { p0v = (u32x2){0u, 0u}; p1v = p0v; p2v = p0v; p3v = p0v; p4v = p0v; } } while (0)
#define RW_XS(cv_, pv_, mu_) ({ f32x4 x_; const float a0_ = bflo(cv_.x), a1_ = bfhi(cv_.x), a2_ = bflo(cv_.y), a3_ = bfhi(cv_.y); \
            x_[0] = a0_ + mu_[0] * (bflo(pv_.x) - a0_); x_[1] = a1_ + mu_[1] * (bfhi(pv_.x) - a1_); x_[2] = a2_ + mu_[2] * (bflo(pv_.y) - a2_); x_[3] = a3_ + mu_[3] * (bfhi(pv_.y) - a3_); x_; })
        RW_PREFETCH(0);
        for (int ck = 0; ck < SEQ / 32; ++ck) {
            const int t0 = ck * 32;
            { *(LAS f32x4*)(Rr + i1 * 64 + 4 * sub) = RW_XS(c0v, p0v, mu0);
              *(LAS f32x4*)(KR + i1 * 64 + 4 * sub) = RW_XS(c1v, p1v, mu1);
              { const f32x4 xv = RW_XS(c2v, p2v, mu2); if ((sub >> 3) == half) *(LAS f32x4*)(Vv + i1 * 32 + 4 * (sub & 7)) = xv; }
              { f32x4 xs = RW_XS(c3v, p3v, mu3); xs[0] = fast_tanh(xs[0]); xs[1] = fast_tanh(xs[1]); xs[2] = fast_tanh(xs[2]); xs[3] = fast_tanh(xs[3]);
                unsigned h0, l0, h1, l1, h2, l2, h3, l3; split_bf(xs[0], h0, l0); split_bf(xs[1], h1, l1); split_bf(xs[2], h2, l2); split_bf(xs[3], h3, l3);
                u32x2 hv, lv; hv.x = h0 | (h1 << 16); hv.y = h2 | (h3 << 16); lv.x = l0 | (l1 << 16); lv.y = l2 | (l3 << 16);
                *(LAS u32x2*)(TWh + i1 * 72 + 4 * sub) = hv; *(LAS u32x2*)(TWl + i1 * 72 + 4 * sub) = lv; }
              { const f32x4 xs = RW_XS(c4v, p4v, mu4);
                unsigned h0, l0, h1, l1, h2, l2, h3, l3; split_bf(xs[0], h0, l0); split_bf(xs[1], h1, l1); split_bf(xs[2], h2, l2); split_bf(xs[3], h3, l3);
                u32x2 hv, lv; hv.x = h0 | (h1 << 16); hv.y = h2 | (h3 << 16); lv.x = l0 | (l1 << 16); lv.y = l2 | (l3 << 16);
                *(LAS u32x2*)(ALh + i1 * 72 + 4 * sub) = hv; *(LAS u32x2*)(ALl + i1 * 72 + 4 * sub) = lv; } }
            if (ck + 1 < SEQ / 32) RW_PREFETCH(t0 + 32);
            __syncthreads();
            { const int mi = wave >> 2, ni = wave & 3, fr = lane & 15, fq = lane >> 4;
              f32x4 accw = {0.f, 0.f, 0.f, 0.f}, acca = {0.f, 0.f, 0.f, 0.f};
#pragma unroll
              for (int ks = 0; ks < 2; ++ks) { const int ao = (16 * mi + fr) * 72 + 32 * ks + 8 * fq, bo = (16 * ni + fr) * 72 + 32 * ks + 8 * fq;
                  const bf16x8 ah = *(const LAS bf16x8*)(TWh + ao), al = *(const LAS bf16x8*)(TWl + ao), bh_ = *(const LAS bf16x8*)(WUh + bo), bl = *(const LAS bf16x8*)(WUl + bo);
                  accw = __builtin_amdgcn_mfma_f32_16x16x32_bf16(ah, bh_, accw, 0, 0, 0); accw = __builtin_amdgcn_mfma_f32_16x16x32_bf16(ah, bl, accw, 0, 0, 0); accw = __builtin_amdgcn_mfma_f32_16x16x32_bf16(al, bh_, accw, 0, 0, 0);
                  const bf16x8 ch = *(const LAS bf16x8*)(ALh + ao), cl = *(const LAS bf16x8*)(ALl + ao), dh = *(const LAS bf16x8*)(AUh + bo), dl = *(const LAS bf16x8*)(AUl + bo);
                  acca = __builtin_amdgcn_mfma_f32_16x16x32_bf16(ch, dh, acca, 0, 0, 0); acca = __builtin_amdgcn_mfma_f32_16x16x32_bf16(ch, dl, acca, 0, 0, 0); acca = __builtin_amdgcn_mfma_f32_16x16x32_bf16(cl, dh, acca, 0, 0, 0); }
#pragma unroll
              for (int rg = 0; rg < 4; ++rg) { Wd[(16 * mi + 4 * fq + rg) * 64 + 16 * ni + fr] = accw[rg]; Bb[(16 * mi + 4 * fq + rg) * 64 + 16 * ni + fr] = acca[rg]; } }
            __syncthreads();
#pragma unroll
            for (int q = 0; q < 4; ++q) { const int i = wave + 8 * q;
                const float nx = -(w0 + Wd[i * 64 + lane]); const float sp = fmaxf(nx, 0.f) + __logf(1.f + __expf(-fabsf(nx)));
                const float decay = __expf(-__expf(-sp - 0.5f));
                const float av = __builtin_amdgcn_rcpf(1.f + __expf(-(a0 + Bb[i * 64 + lane])));
                const float kraw = KR[i * 64 + lane]; const float kkv = kraw * k_k;
                const float ss = wave_sum_fast(kkv * kkv); const float kk = kkv * __builtin_amdgcn_rsqf(fmaxf(ss, 1e-24f));
                const float kp = kraw * (1.f + (av - 1.f) * k_a);
                const float bon = wave_sum_fast(Rr[i * 64 + lane] * kp * r_k);
                Wd[i * 64 + lane] = decay; KR[i * 64 + lane] = kp; KK[i * 64 + lane] = kk; Bb[i * 64 + lane] = kk * av;
                if (half == 0 && lane == 0) BONG[(size_t)(b * SEQ + t0 + i) * 8 + h] = bon; }
            __syncthreads();
            { f32x4 kk4 = *(const LAS f32x4*)(KK + c4), w4 = *(const LAS f32x4*)(Wd + c4), b4 = *(const LAS f32x4*)(Bb + c4), k4 = *(const LAS f32x4*)(KR + c4), r4 = *(const LAS f32x4*)(Rr + c4);
              float vv = Vv[rowl];
#pragma unroll 4
              for (int i = 0; i < 32; ++i) {
                const int in = (i + 1) & 31;
                const f32x4 nkk = *(const LAS f32x4*)(KK + in * 64 + c4), nw = *(const LAS f32x4*)(Wd + in * 64 + c4), nb = *(const LAS f32x4*)(Bb + in * 64 + c4), nk = *(const LAS f32x4*)(KR + in * 64 + c4), nr = *(const LAS f32x4*)(Rr + in * 64 + c4);
                const float nv = Vv[in * 32 + rowl];
                float sa = (S[0] * kk4[0] + S[1] * kk4[1]) + (S[2] * kk4[2] + S[3] * kk4[3]);
                const float p0 = S[0] * w4[0] + vv * k4[0], p1 = S[1] * w4[1] + vv * k4[1], p2 = S[2] * w4[2] + vv * k4[2], p3 = S[3] * w4[3] + vv * k4[3];
                sa = -row_sum16(sa);
                S[0] = sa * b4[0] + p0; S[1] = sa * b4[1] + p1; S[2] = sa * b4[2] + p2; S[3] = sa * b4[3] + p3;
                float y = (S[0] * r4[0] + S[1] * r4[1]) + (S[2] * r4[2] + S[3] * r4[3]);
                y = row_sum16(y);
                Yy[i * 32 + rowl] = y;
                kk4 = nkk; w4 = nw; b4 = nb; k4 = nk; r4 = nr; vv = nv;
              } }
            __syncthreads();
            for (int idx = tid; idx < 1024; idx += 512) { const int i = idx >> 5, rl = idx & 31; YRAW[(size_t)(b * SEQ + t0 + i) * 512 + h * 64 + half * 32 + rl] = Yy[idx]; }
        }
#undef RW_PREFETCH
#undef RW_XS
    }
}
__device__ __forceinline__ void phase_finish(const Args& a, int lane, int wave, int vcu, int G) {
    const bf16* P = (const bf16*)(a.ws + WS_P); bf16* MIX = (bf16*)(a.ws + WS_MIX); const float* YRAW = (const float*)(a.ws + WS_YRAW); const float* BONG = (const float*)(a.ws + WS_BON);
    const int gw = vcu * NWAVES + wave, NGW = G * NWAVES; const int c0 = 8 * lane;
    const f32x4 g0 = *(const f32x4*)(a.in[I_ELNXG] + c0), g1 = *(const f32x4*)(a.in[I_ELNXG] + c0 + 4), e0 = *(const f32x4*)(a.in[I_ELNXB] + c0), e1 = *(const f32x4*)(a.in[I_ELNXB] + c0 + 4);
    const f32x4 m0 = *(const f32x4*)(a.in[I_EMU] + C_V + c0), m1 = *(const f32x4*)(a.in[I_EMU] + C_V + c0 + 4);
    for (int row = gw; row < M; row += NGW) {
        const f32x4 y0 = *(const f32x4*)(YRAW + (size_t)row * 512 + c0), y1 = *(const f32x4*)(YRAW + (size_t)row * 512 + c0 + 4);
        float y[8] = {y0[0], y0[1], y0[2], y0[3], y1[0], y1[1], y1[2], y1[3]};
        float s = 0.f;
#pragma unroll
        for (int e = 0; e < 8; ++e) s += y[e];
        s += __shfl_xor(s, 1); s += __shfl_xor(s, 2); s += __shfl_xor(s, 4); const float mean = s * (1.f / 64.f); float q = 0.f;
#pragma unroll
        for (int e = 0; e < 8; ++e) { y[e] -= mean; q += y[e] * y[e]; }
        q += __shfl_xor(q, 1); q += __shfl_xor(q, 2); q += __shfl_xor(q, 4); const float rstd = 1.0f / sqrtf(q * (1.f / 64.f) + 64e-5f);
        const bf16* pc = P + (size_t)row * EVEN_PAD; const v4u cu = *(const v4u*)(pc + C_V + c0); v4u pu = {0u, 0u, 0u, 0u}; if ((row & (SEQ - 1)) != 0) pu = *(const v4u*)(pc - EVEN_PAD + C_V + c0);
        const v4u zu = *(const v4u*)(pc + C_Z0 + c0);
        const float cv[8] = {bflo(cu.x), bfhi(cu.x), bflo(cu.y), bfhi(cu.y), bflo(cu.z), bfhi(cu.z), bflo(cu.w), bfhi(cu.w)};
        const float pv[8] = {bflo(pu.x), bfhi(pu.x), bflo(pu.y), bfhi(pu.y), bflo(pu.z), bfhi(pu.z), bflo(pu.w), bfhi(pu.w)};
        const float zz[8] = {bflo(zu.x), bfhi(zu.x), bflo(zu.y), bfhi(zu.y), bflo(zu.z), bfhi(zu.z), bflo(zu.w), bfhi(zu.w)};
        const float mu[8] = {m0[0], m0[1], m0[2], m0[3], m1[0], m1[1], m1[2], m1[3]}, gg[8] = {g0[0], g0[1], g0[2], g0[3], g1[0], g1[1], g1[2], g1[3]}, ee[8] = {e0[0], e0[1], e0[2], e0[3], e1[0], e1[1], e1[2], e1[3]};
        const float bon = BONG[(size_t)row * 8 + (lane >> 3)];
        float o[8];
#pragma unroll
        for (int e = 0; e < 8; ++e) { const float v = cv[e] + mu[e] * (pv[e] - cv[e]); o[e] = (y[e] * rstd * gg[e] + ee[e] + bon * v) * siluf(zz[e]); }
        v4u w; w.x = pk2(o[0], o[1]); w.y = pk2(o[2], o[3]); w.z = pk2(o[4], o[5]); w.w = pk2(o[6], o[7]);
        *(v4u*)(MIX + (size_t)row * D + c0) = w;
    }
}
__device__ __forceinline__ void phase_gmlp(const Args& a, LAS unsigned char* lds, int tid, int lane, int wave, int vcu, int G) {
    const bf16* P = (const bf16*)(a.ws + WS_P); bf16* MIX = (bf16*)(a.ws + WS_MIX);
    LAS float* WS = (LAS float*)lds;
    LAS float* VLN = (LAS float*)(lds + 128 * 129 * 4);
    int gload = -1;
    for (int u = vcu; u < BATCH * 16 * 8; u += G) {
        const int b = u >> 7, ck = (u >> 3) & 15, g = u & 7;
        __syncthreads();
        if (g != gload) { for (int idx = tid; idx < 16384; idx += 512) WS[(idx >> 7) * 129 + (idx & 127)] = a.in[I_ESGW][(size_t)g * 16384 + idx]; gload = g; }
        const int i = tid >> 2, sub = tid & 3; const size_t rowg = (size_t)(b * SEQ + ck * 128 + i);
        { const v4u q0 = *(const v4u*)(P + rowg * EVEN_PAD + C_VG + g * 64 + sub * 16), q1 = *(const v4u*)(P + rowg * EVEN_PAD + C_VG + g * 64 + sub * 16 + 8);
          float v[16] = {bflo(q0.x), bfhi(q0.x), bflo(q0.y), bfhi(q0.y), bflo(q0.z), bfhi(q0.z), bflo(q0.w), bfhi(q0.w), bflo(q1.x), bfhi(q1.x), bflo(q1.y), bfhi(q1.y), bflo(q1.z), bfhi(q1.z), bflo(q1.w), bfhi(q1.w)};
          float s = 0.f;
#pragma unroll
          for (int e = 0; e < 16; ++e) s += v[e];
          s += __shfl_xor(s, 1); s += __shfl_xor(s, 2); const float mean = s * (1.f / 64.f); float q = 0.f;
#pragma unroll
          for (int e = 0; e < 16; ++e) { v[e] -= mean; q += v[e] * v[e]; }
          q += __shfl_xor(q, 1); q += __shfl_xor(q, 2); const float rstd = 1.0f / sqrtf(q * (1.f / 64.f) + 1e-5f);
#pragma unroll
          for (int e = 0; e < 16; ++e) VLN[i * 64 + sub * 16 + e] = v[e] * rstd * a.in[I_ESGLNG][g * 64 + sub * 16 + e] + a.in[I_ESGLNB][g * 64 + sub * 16 + e]; }
        __syncthreads();
        float acc[16];
#pragma unroll
        for (int e = 0; e < 16; ++e) acc[e] = 0.f;
        const int smax = wave * 16 + 16;
        for (int s = 0; s < smax; ++s) {
            const float w = (s <= i) ? WS[i * 129 + s] : 0.f;
            const f32x4 v0 = *(const LAS f32x4*)(VLN + s * 64 + sub * 16), v1 = *(const LAS f32x4*)(VLN + s * 64 + sub * 16 + 4), v2 = *(const LAS f32x4*)(VLN + s * 64 + sub * 16 + 8), v3 = *(const LAS f32x4*)(VLN + s * 64 + sub * 16 + 12);
#pragma unroll
            for (int e = 0; e < 4; ++e) { acc[e] += w * v0[e]; acc[4 + e] += w * v1[e]; acc[8 + e] += w * v2[e]; acc[12 + e] += w * v3[e]; }
        }
        const float bs = a.in[I_ESGB][g * 128 + i];
        const v4u u0 = *(const v4u*)(P + rowg * EVEN_PAD + C_U + g * 64 + sub * 16), u1 = *(const v4u*)(P + rowg * EVEN_PAD + C_U + g * 64 + sub * 16 + 8);
        const v4u z0 = *(const v4u*)(P + rowg * EVEN_PAD + C_Z0 + 512 + g * 64 + sub * 16), z1 = *(const v4u*)(P + rowg * EVEN_PAD + C_Z0 + 512 + g * 64 + sub * 16 + 8);
        const float uu[16] = {bflo(u0.x), bfhi(u0.x), bflo(u0.y), bfhi(u0.y), bflo(u0.z), bfhi(u0.z), bflo(u0.w), bfhi(u0.w), bflo(u1.x), bfhi(u1.x), bflo(u1.y), bfhi(u1.y), bflo(u1.z), bfhi(u1.z), bflo(u1.w), bfhi(u1.w)};
        const float zz[16] = {bflo(z0.x), bfhi(z0.x), bflo(z0.y), bfhi(z0.y), bflo(z0.z), bfhi(z0.z), bflo(z0.w), bfhi(z0.w), bflo(z1.x), bfhi(z1.x), bflo(z1.y), bfhi(z1.y), bflo(z1.z), bfhi(z1.z), bflo(z1.w), bfhi(z1.w)};
        float o[16];
#pragma unroll
        for (int e = 0; e < 16; ++e) o[e] = uu[e] * (acc[e] + bs) * siluf(zz[e]);
        v4u w0, w1; w0.x = pk2(o[0], o[1]); w0.y = pk2(o[2], o[3]); w0.z = pk2(o[4], o[5]); w0.w = pk2(o[6], o[7]); w1.x = pk2(o[8], o[9]); w1.y = pk2(o[10], o[11]); w1.z = pk2(o[12], o[13]); w1.w = pk2(o[14], o[15]);
        *(v4u*)(MIX + rowg * D + 512 + g * 64 + sub * 16) = w0; *(v4u*)(MIX + rowg * D + 512 + g * 64 + sub * 16 + 8) = w1;
    }
}

__device__ __forceinline__ void phase_swa(const Args& a, LAS unsigned char* lds, int tid, int lane, int wave, int vcu, int G) {
    const bf16* P = (const bf16*)(a.ws + WS_P); bf16* MIX = (bf16*)(a.ws + WS_MIX);
    LAS unsigned* KB = (LAS unsigned*)lds;
    LAS unsigned* VB = KB + 256 * 33;
    for (int u = vcu; u < BATCH * 16 * 2; u += G) {
        const int b = u >> 5, n = (u >> 1) & 15, kvh = u & 1;
        __syncthreads();
        { const int kr = tid >> 1, half = tid & 1; const int tk = n * 128 - 128 + kr;
          v4u kq[4], vq[4];
#pragma unroll
          for (int e = 0; e < 4; ++e) { kq[e] = (v4u){0u, 0u, 0u, 0u}; vq[e] = kq[e]; }
          if (tk >= 0) { const bf16* pr = P + (size_t)(b * SEQ + tk) * ODD_IN;
#pragma unroll
              for (int e = 0; e < 4; ++e) { kq[e] = *(const v4u*)(pr + C_KC + kvh * 64 + half * 32 + e * 8); vq[e] = *(const v4u*)(pr + C_VC + kvh * 64 + half * 32 + e * 8); } }
#pragma unroll
          for (int e = 0; e < 4; ++e) { LAS unsigned* kd = KB + kr * 33 + half * 16 + e * 4; kd[0] = kq[e].x; kd[1] = kq[e].y; kd[2] = kq[e].z; kd[3] = kq[e].w;
              LAS unsigned* vd = VB + kr * 33 + half * 16 + e * 4; vd[0] = vq[e].x; vd[1] = vq[e].y; vd[2] = vq[e].z; vd[3] = vq[e].w; } }
        __syncthreads();
        for (int pass = 0; pass < 2; ++pass) {
            const int gq = (tid >> 7) + 4 * pass, qi = tid & 127, h = kvh * 8 + gq; const size_t rowg = (size_t)(b * SEQ + n * 128 + qi);
            float q[64], o[64];
#pragma unroll
            for (int e = 0; e < 8; ++e) { const v4u w = *(const v4u*)(P + rowg * ODD_IN + C_Q + h * 64 + e * 8);
                q[8 * e + 0] = bflo(w.x) * 0.125f; q[8 * e + 1] = bfhi(w.x) * 0.125f; q[8 * e + 2] = bflo(w.y) * 0.125f; q[8 * e + 3] = bfhi(w.y) * 0.125f;
                q[8 * e + 4] = bflo(w.z) * 0.125f; q[8 * e + 5] = bfhi(w.z) * 0.125f; q[8 * e + 6] = bflo(w.w) * 0.125f; q[8 * e + 7] = bfhi(w.w) * 0.125f; }
#pragma unroll
            for (int e = 0; e < 64; ++e) o[e] = 0.f;
            const float slope = exp2f(-0.5f * (float)(h + 1));
            float mrun = a.in[I_OSINKS][h], lrun = 1.f;
            for (int j = 0; j < 128; ++j) {
                const int kr = qi + 1 + j; const bool valid = (n > 0) || (kr >= 128);
                const LAS unsigned* kp = KB + kr * 33;
                float s0 = 0.f, s1 = 0.f;
#pragma unroll
                for (int e = 0; e < 32; ++e) { const unsigned w = kp[e]; s0 += q[2 * e] * bflo(w); s1 += q[2 * e + 1] * bfhi(w); }
                const float s = (s0 + s1) - slope * (float)(127 - j);
                const float mn = valid ? fmaxf(mrun, s) : mrun;
                const float alpha = __expf(mrun - mn); const float p = valid ? __expf(s - mn) : 0.f;
                lrun = lrun * alpha + p; mrun = mn;
                const LAS unsigned* vp = VB + kr * 33;
#pragma unroll
                for (int e = 0; e < 32; ++e) { const unsigned w = vp[e]; o[2 * e] = o[2 * e] * alpha + p * bflo(w); o[2 * e + 1] = o[2 * e + 1] * alpha + p * bfhi(w); }
            }
            const float il = 1.f / lrun;
#pragma unroll
            for (int e = 0; e < 8; ++e) { const v4u zw = *(const v4u*)(P + rowg * ODD_IN + C_Z1 + h * 64 + e * 8);
                v4u w; w.x = pk2(o[8 * e + 0] * il * siluf(bflo(zw.x)), o[8 * e + 1] * il * siluf(bfhi(zw.x))); w.y = pk2(o[8 * e + 2] * il * siluf(bflo(zw.y)), o[8 * e + 3] * il * siluf(bfhi(zw.y)));
                w.z = pk2(o[8 * e + 4] * il * siluf(bflo(zw.z)), o[8 * e + 5] * il * siluf(bfhi(zw.z))); w.w = pk2(o[8 * e + 6] * il * siluf(bflo(zw.w)), o[8 * e + 7] * il * siluf(bfhi(zw.w)));
                *(v4u*)(MIX + rowg * D + h * 64 + e * 8) = w; }
        }
    }
}


typedef float f32x16 __attribute__((ext_vector_type(16)));
__device__ __forceinline__ int crow(int r, int hi) { return (r & 3) + 8 * (r >> 2) + 4 * hi; }
typedef float f32x2_t __attribute__((ext_vector_type(2))); typedef __bf16 bf16x2_t __attribute__((ext_vector_type(2)));
__device__ __forceinline__ unsigned cvtpk(float lo, float hi) { f32x2_t v = {lo, hi}; bf16x2_t b = __builtin_convertvector(v, bf16x2_t); return __builtin_bit_cast(unsigned, b); }
__device__ __forceinline__ void phase_swa2(const Args& a, LAS unsigned char* lds, int tid, int lane, int wave, int vcu, int G) {
    const bf16* P = (const bf16*)(a.ws + WS_P); bf16* MIX = (bf16*)(a.ws + WS_MIX);
    LAS bf16* Kl = (LAS bf16*)lds;
    LAS bf16* Vt = (LAS bf16*)(lds + 36864);
    const int l31 = lane & 31, hi = lane >> 5;
    for (int u = vcu; u < BATCH * 16 * 2; u += G) {
        const int b = u >> 5, n = (u >> 1) & 15, kvh = u & 1;
        __syncthreads();
        { const int key = tid >> 1, half = tid & 1; const int tk = n * 128 - 128 + key;
          v4u kq[4];
#pragma unroll
          for (int e = 0; e < 4; ++e) kq[e] = (v4u){0u, 0u, 0u, 0u};
          if (tk >= 0) { const bf16* pr = P + (size_t)(b * SEQ + tk) * ODD_IN + C_KC + kvh * 64 + half * 32;
#pragma unroll
              for (int e = 0; e < 4; ++e) kq[e] = *(const v4u*)(pr + e * 8); }
#pragma unroll
          for (int e = 0; e < 4; ++e) *(LAS v4u*)(Kl + key * 72 + half * 32 + e * 8) = kq[e]; }
        { const int key = tid & 255, dh = tid >> 8; const int tk = n * 128 - 128 + key;
          v4u vq[4];
#pragma unroll
          for (int e = 0; e < 4; ++e) vq[e] = (v4u){0u, 0u, 0u, 0u};
          if (tk >= 0) { const bf16* pr = P + (size_t)(b * SEQ + tk) * ODD_IN + C_VC + kvh * 64 + dh * 32;
#pragma unroll
              for (int e = 0; e < 4; ++e) vq[e] = *(const v4u*)(pr + e * 8); }
#pragma unroll
          for (int e = 0; e < 4; ++e) { LAS bf16* vd = Vt + (dh * 32 + e * 8) * 260 + key;
              vd[0 * 260] = (bf16)(vq[e].x & 0xffffu); vd[1 * 260] = (bf16)(vq[e].x >> 16); vd[2 * 260] = (bf16)(vq[e].y & 0xffffu); vd[3 * 260] = (bf16)(vq[e].y >> 16);
              vd[4 * 260] = (bf16)(vq[e].z & 0xffffu); vd[5 * 260] = (bf16)(vq[e].z >> 16); vd[6 * 260] = (bf16)(vq[e].w & 0xffffu); vd[7 * 260] = (bf16)(vq[e].w >> 16); } }
        __syncthreads();
        const int h = kvh * 8 + wave;
        const float slope = exp2f(-0.5f * (float)(h + 1)), sink = a.in[I_OSINKS][h];
#pragma unroll 1
        for (int i = 0; i < 4; ++i) {
            const size_t rowq = (size_t)(b * SEQ + n * 128 + 32 * i + l31);
            bf16x8 qf[4];
#pragma unroll
            for (int ks = 0; ks < 4; ++ks) qf[ks] = *(const bf16x8*)(P + rowq * ODD_IN + C_Q + h * 64 + 16 * ks + 8 * hi);
            f32x16 st[5];
#pragma unroll
            for (int tt = 0; tt < 5; ++tt) { f32x16 acc = {0.f, 0.f, 0.f, 0.f, 0.f, 0.f, 0.f, 0.f, 0.f, 0.f, 0.f, 0.f, 0.f, 0.f, 0.f, 0.f};
#pragma unroll
                for (int ks = 0; ks < 4; ++ks) { const bf16x8 kf = *(const LAS bf16x8*)(Kl + (32 * (i + tt) + l31) * 72 + 16 * ks + 8 * hi);
                    acc = __builtin_amdgcn_mfma_f32_32x32x16_bf16(kf, qf[ks], acc, 0, 0, 0); }
                st[tt] = acc; }
            int lbv = l31 - 4 * hi; float sbv = -slope * (float)(l31 + 128 - 4 * hi);
            asm volatile("" : "+v"(lbv), "+v"(sbv));
            float mx = sink;
#pragma unroll
            for (int tt = 0; tt < 5; ++tt) { const bool tile_ok = (n > 0) || (i + tt >= 4);
#pragma unroll
                for (int r = 0; r < 16; ++r) { const int cr = (r & 3) + 8 * (r >> 2);
                    float s = fmaf(st[tt][r], 0.125f, sbv); s = fmaf(slope, (float)(32 * tt + cr), s);
                    if (tt == 0) s = (cr > lbv) ? s : -INFINITY;
                    if (tt == 4) s = (cr <= lbv) ? s : -INFINITY;
                    s = tile_ok ? s : -INFINITY;
                    st[tt][r] = s; mx = fmaxf(mx, s); } }
            { auto rr = __builtin_amdgcn_permlane32_swap(__float_as_uint(mx), __float_as_uint(mx), false, false); mx = fmaxf(__uint_as_float(rr[0]), __uint_as_float(rr[1])); }
            float ls = 0.f;
#pragma unroll
            for (int tt = 0; tt < 5; ++tt)
#pragma unroll
                for (int r = 0; r < 16; ++r) { const float p = __expf(st[tt][r] - mx); st[tt][r] = p; ls += p; }
            { auto rr = __builtin_amdgcn_permlane32_swap(__float_as_uint(ls), __float_as_uint(ls), false, false); ls = __uint_as_float(rr[0]) + __uint_as_float(rr[1]); }
            const float inv = 1.f / (ls + __expf(sink - mx));
            f32x16 o[2];
#pragma unroll
            for (int dt = 0; dt < 2; ++dt) o[dt] = (f32x16){0.f, 0.f, 0.f, 0.f, 0.f, 0.f, 0.f, 0.f, 0.f, 0.f, 0.f, 0.f, 0.f, 0.f, 0.f, 0.f};
#pragma unroll
            for (int tt = 0; tt < 5; ++tt)
#pragma unroll
                for (int s2 = 0; s2 < 2; ++s2) {
                    v4u pw; pw.x = cvtpk(st[tt][8 * s2 + 0] * inv, st[tt][8 * s2 + 1] * inv); pw.y = cvtpk(st[tt][8 * s2 + 2] * inv, st[tt][8 * s2 + 3] * inv);
                    pw.z = cvtpk(st[tt][8 * s2 + 4] * inv, st[tt][8 * s2 + 5] * inv); pw.w = cvtpk(st[tt][8 * s2 + 6] * inv, st[tt][8 * s2 + 7] * inv);
                    const bf16x8 pa = __builtin_bit_cast(bf16x8, pw);
                    const int kb = 32 * (i + tt) + 16 * s2 + 4 * hi;
#pragma unroll
                    for (int dt = 0; dt < 2; ++dt) { const LAS bf16* vp = Vt + (dt * 32 + l31) * 260 + kb;
                        const u32x2 v0 = *(const LAS u32x2*)vp, v1 = *(const LAS u32x2*)(vp + 8);
                        v4u vw; vw.x = v0.x; vw.y = v0.y; vw.z = v1.x; vw.w = v1.y;
                        o[dt] = __builtin_amdgcn_mfma_f32_32x32x16_bf16(pa, __builtin_bit_cast(bf16x8, vw), o[dt], 0, 0, 0); } }
#pragma unroll
            for (int dt = 0; dt < 2; ++dt)
#pragma unroll
                for (int r = 0; r < 16; ++r) { const size_t row = (size_t)(b * SEQ + n * 128 + 32 * i + crow(r, hi)); const int d = h * 64 + dt * 32 + l31;
                    const float z = bf2f(P[row * ODD_IN + C_Z1 + d]);
                    MIX[row * D + d] = (bf16)f2bf(o[dt][r] * siluf(z)); if ((r & 3) == 3) asm volatile("" ::: "memory"); }
        }
    }
}

__device__ __forceinline__ void phase_gmlp2(const Args& a, LAS unsigned char* lds, int tid, int lane, int wave, int vcu, int G) {
    const bf16* P = (const bf16*)(a.ws + WS_P); bf16* MIX = (bf16*)(a.ws + WS_MIX);
    LAS bf16* Wl = (LAS bf16*)lds;
    LAS bf16* Vn = (LAS bf16*)(lds + 34816);
    const int l31 = lane & 31, hi = lane >> 5;
    int gload = -1;
    for (int u = vcu; u < BATCH * 16 * 8; u += G) {
        const int b = u >> 7, ck = (u >> 3) & 15, g = u & 7;
        __syncthreads();
        if (g != gload) { for (int idx = tid; idx < 16384; idx += 512) { const int t = idx >> 7, s = idx & 127; const float w = a.in[I_ESGW][(size_t)g * 16384 + idx]; Wl[t * 136 + s] = (bf16)f2bf(s <= t ? w : 0.f); } gload = g; }
        { const int i = tid >> 2, sub = tid & 3; const size_t rowg = (size_t)(b * SEQ + ck * 128 + i);
          const v4u q0 = *(const v4u*)(P + rowg * EVEN_PAD + C_VG + g * 64 + sub * 16), q1 = *(const v4u*)(P + rowg * EVEN_PAD + C_VG + g * 64 + sub * 16 + 8);
          float v[16] = {bflo(q0.x), bfhi(q0.x), bflo(q0.y), bfhi(q0.y), bflo(q0.z), bfhi(q0.z), bflo(q0.w), bfhi(q0.w), bflo(q1.x), bfhi(q1.x), bflo(q1.y), bfhi(q1.y), bflo(q1.z), bfhi(q1.z), bflo(q1.w), bfhi(q1.w)};
          float s = 0.f;
#pragma unroll
          for (int e = 0; e < 16; ++e) s += v[e];
          s += __shfl_xor(s, 1); s += __shfl_xor(s, 2); const float mean = s * (1.f / 64.f); float q = 0.f;
#pragma unroll
          for (int e = 0; e < 16; ++e) { v[e] -= mean; q += v[e] * v[e]; }
          q += __shfl_xor(q, 1); q += __shfl_xor(q, 2); const float rstd = 1.0f / sqrtf(q * (1.f / 64.f) + 1e-5f);
#pragma unroll
          for (int e = 0; e < 16; ++e) Vn[(sub * 16 + e) * 136 + i] = (bf16)f2bf(v[e] * rstd * a.in[I_ESGLNG][g * 64 + sub * 16 + e] + a.in[I_ESGLNB][g * 64 + sub * 16 + e]); }
        __syncthreads();
        const int ti = wave >> 1, dt = wave & 1;
        f32x16 acc = {0.f, 0.f, 0.f, 0.f, 0.f, 0.f, 0.f, 0.f, 0.f, 0.f, 0.f, 0.f, 0.f, 0.f, 0.f, 0.f};
        const LAS bf16* ap = Wl + (32 * ti + l31) * 136 + 8 * hi; const LAS bf16* bp = Vn + (32 * dt + l31) * 136 + 8 * hi;
        for (int ks = 0; ks < 2 * ti + 2; ++ks) acc = __builtin_amdgcn_mfma_f32_32x32x16_bf16(*(const LAS bf16x8*)(ap + 16 * ks), *(const LAS bf16x8*)(bp + 16 * ks), acc, 0, 0, 0);
#pragma unroll
        for (int r = 0; r < 16; ++r) { const int t = 32 * ti + crow(r, hi); const size_t rowg = (size_t)(b * SEQ + ck * 128 + t); const int d = g * 64 + 32 * dt + l31;
            const float mixed = acc[r] + a.in[I_ESGB][g * 128 + t];
            const float uu = bf2f(P[rowg * EVEN_PAD + C_U + d]), zz = bf2f(P[rowg * EVEN_PAD + C_Z0 + 512 + d]);
            MIX[rowg * D + 512 + d] = (bf16)f2bf(uu * mixed * siluf(zz)); if ((r & 3) == 3) asm volatile("" ::: "memory"); }
    }
}

constexpr int RW_CHB = 13632;
constexpr int RW_O_AB = 0, RW_O_RB = 2304, RW_O_CH3 = 4608, RW_O_VT = 8704, RW_O_LAK = 11264, RW_O_GRK = 11776, RW_O_GRB = 12288, RW_O_TT = 12800, RW_O_GAM = 13312, RW_O_BON = 13568;
constexpr int RW_O_Y = 8 * RW_CHB, RW_O_PAR = RW_O_Y + 32768;
static_assert(RW_O_PAR + 7 * 64 * 4 <= LDSCTL_OFF, "rwkv LDS map");
__device__ __forceinline__ bf16x8 mkfrag(u32x2 lo, u32x2 hi) { v4u w; w.x = lo.x; w.y = lo.y; w.z = hi.x; w.w = hi.y; return __builtin_bit_cast(bf16x8, w); }
__device__ __forceinline__ u32x2 pack4(float a, float b, float c, float d) { u32x2 r; r.x = cvtpk(a, b); r.y = cvtpk(c, d); return r; }
#define DPP_SHR_ADD(x, n) x += __builtin_bit_cast(float, __builtin_amdgcn_update_dpp(0, __builtin_bit_cast(int, x), 0x110 + (n), 0xF, 0xF, true))
__device__ __forceinline__ void phase_rwkv3(const Args& a, LAS unsigned char* lds, int tid, int lane_, int wave, int unit) {
    const bf16* P = (const bf16*)(a.ws + WS_P); bf16* MIX = (bf16*)(a.ws + WS_MIX);
    const bf16* WUT = (const bf16*)(a.ws + WS_WUT); const bf16* AUT = (const bf16*)(a.ws + WS_AUT);
    const int b = unit >> 3, h = unit & 7;
    const int c_ = lane_ & 15, g_ = lane_ >> 4;
    LAS float* PAR = (LAS float*)(lds + RW_O_PAR);
    LAS float* YB = (LAS float*)(lds + RW_O_Y);
    __syncthreads();
    if (tid < 448) { const int p = tid >> 6, j = tid & 63; const int src = (p == 0 ? I_EW0 : p == 1 ? I_EA0 : p == 2 ? I_EKK : p == 3 ? I_EKA : p == 4 ? I_ERK : p == 5 ? I_ELNXG : I_ELNXB); PAR[tid] = a.in[src][h * 64 + j]; }
    f32x4 S[4];
#pragma unroll
    for (int jt = 0; jt < 4; ++jt) S[jt] = (f32x4){0.f, 0.f, 0.f, 0.f};
    const u32x2 z2 = {0u, 0u};
    __syncthreads();
    for (int bt = 0; bt < SEQ / 128; ++bt) {
        {   int c = c_, g = g_; asm volatile("" : "+v"(c), "+v"(g));
            LAS unsigned char* cb = lds + wave * RW_CHB;
            const int t0 = bt * 128 + wave * 16; const size_t rowg = (size_t)(b * SEQ + t0 + c);
            const bf16* pc = P + rowg * EVEN_PAD; const bf16* pp = pc - EVEN_PAD; const bool hasp = (t0 + c) > 0;
            const float* mu = a.in[I_EMU];
            u32x2 rc[4], rp[4], kc[4], kp_[4], vc[4], vp[4];
#pragma unroll
            for (int ni = 0; ni < 4; ++ni) { const int jb = h * 64 + 16 * ni + 4 * g;
                rc[ni] = *(const u32x2*)(pc + C_R + jb); kc[ni] = *(const u32x2*)(pc + C_K + jb); vc[ni] = *(const u32x2*)(pc + C_V + jb);
                rp[ni] = z2; kp_[ni] = z2; vp[ni] = z2;
                if (hasp) { rp[ni] = *(const u32x2*)(pp + C_R + jb); kp_[ni] = *(const u32x2*)(pp + C_K + jb); vp[ni] = *(const u32x2*)(pp + C_V + jb); } }
            f32x4 accw[4], acca[4];
#pragma unroll
            for (int ni = 0; ni < 4; ++ni) { accw[ni] = (f32x4){0.f, 0.f, 0.f, 0.f}; acca[ni] = accw[ni]; }
#pragma unroll
            for (int ks = 0; ks < 2; ++ks) { const int mb = 32 * ks + 8 * g;
                const v4u cw = *(const v4u*)(pc + C_WLO + mb), ca = *(const v4u*)(pc + C_ALO + mb); v4u pw = {0u, 0u, 0u, 0u}, pa = pw;
                if (hasp) { pw = *(const v4u*)(pp + C_WLO + mb); pa = *(const v4u*)(pp + C_ALO + mb); }
                const f32x4 mw0 = *(const f32x4*)(mu + C_WLO + mb), mw1 = *(const f32x4*)(mu + C_WLO + mb + 4), ma0 = *(const f32x4*)(mu + C_ALO + mb), ma1 = *(const f32x4*)(mu + C_ALO + mb + 4);
                const float cwf[8] = {bflo(cw.x), bfhi(cw.x), bflo(cw.y), bfhi(cw.y), bflo(cw.z), bfhi(cw.z), bflo(cw.w), bfhi(cw.w)}, pwf[8] = {bflo(pw.x), bfhi(pw.x), bflo(pw.y), bfhi(pw.y), bflo(pw.z), bfhi(pw.z), bflo(pw.w), bfhi(pw.w)};
                const float caf[8] = {bflo(ca.x), bfhi(ca.x), bflo(ca.y), bfhi(ca.y), bflo(ca.z), bfhi(ca.z), bflo(ca.w), bfhi(ca.w)}, paf[8] = {bflo(pa.x), bfhi(pa.x), bflo(pa.y), bfhi(pa.y), bflo(pa.z), bfhi(pa.z), bflo(pa.w), bfhi(pa.w)};
                const float mwf[8] = {mw0[0], mw0[1], mw0[2], mw0[3], mw1[0], mw1[1], mw1[2], mw1[3]}, maf[8] = {ma0[0], ma0[1], ma0[2], ma0[3], ma1[0], ma1[1], ma1[2], ma1[3]};
                float tw[8], al[8];
#pragma unroll
                for (int e = 0; e < 8; ++e) { tw[e] = fast_tanh(cwf[e] + mwf[e] * (pwf[e] - cwf[e])); al[e] = caf[e] + maf[e] * (paf[e] - caf[e]); }
                v4u bwv, bav; bwv.x = cvtpk(tw[0], tw[1]); bwv.y = cvtpk(tw[2], tw[3]); bwv.z = cvtpk(tw[4], tw[5]); bwv.w = cvtpk(tw[6], tw[7]);
                bav.x = cvtpk(al[0], al[1]); bav.y = cvtpk(al[2], al[3]); bav.z = cvtpk(al[4], al[5]); bav.w = cvtpk(al[6], al[7]);
                const bf16x8 bw = __builtin_bit_cast(bf16x8, bwv), ba = __builtin_bit_cast(bf16x8, bav);
#pragma unroll
                for (int ni = 0; ni < 4; ++ni) { const size_t wo = (size_t)(h * 64 + 16 * ni + c) * 64 + mb;
                    accw[ni] = __builtin_amdgcn_mfma_f32_16x16x32_bf16(*(const bf16x8*)(WUT + wo), bw, accw[ni], 0, 0, 0);
                    acca[ni] = __builtin_amdgcn_mfma_f32_16x16x32_bf16(*(const bf16x8*)(AUT + wo), ba, acca[ni], 0, 0, 0); } }
            float kraw[16]; float ssq = 0.f;
#pragma unroll
            for (int ni = 0; ni < 4; ++ni) { const int jl = 16 * ni + 4 * g; const f32x4 mk = *(const f32x4*)(mu + C_K + h * 64 + jl); const f32x4 kkp = *(const LAS f32x4*)(PAR + 2 * 64 + jl);
                const float cf[4] = {bflo(kc[ni].x), bfhi(kc[ni].x), bflo(kc[ni].y), bfhi(kc[ni].y)}, pf[4] = {bflo(kp_[ni].x), bfhi(kp_[ni].x), bflo(kp_[ni].y), bfhi(kp_[ni].y)};
#pragma unroll
                for (int e = 0; e < 4; ++e) { const float k = cf[e] + mk[e] * (pf[e] - cf[e]); kraw[ni * 4 + e] = k; const float kv = k * kkp[e]; ssq += kv * kv; } }
            ssq += __shfl_xor(ssq, 16); ssq += __shfl_xor(ssq, 32);
            const float rs = __builtin_amdgcn_rsqf(fmaxf(ssq, 1e-24f));
            u32x2 fA[4], fR[4], fB[4], fK[4]; float bon = 0.f;
#pragma unroll
            for (int ni = 0; ni < 4; ++ni) { const int jl = 16 * ni + 4 * g;
                const f32x4 mr = *(const f32x4*)(mu + C_R + h * 64 + jl), mv = *(const f32x4*)(mu + C_V + h * 64 + jl);
                const f32x4 w0 = *(const LAS f32x4*)(PAR + jl), a0 = *(const LAS f32x4*)(PAR + 64 + jl), kkp = *(const LAS f32x4*)(PAR + 128 + jl), kap = *(const LAS f32x4*)(PAR + 192 + jl), rkp = *(const LAS f32x4*)(PAR + 256 + jl);
                const float rcf[4] = {bflo(rc[ni].x), bfhi(rc[ni].x), bflo(rc[ni].y), bfhi(rc[ni].y)}, rpf[4] = {bflo(rp[ni].x), bfhi(rp[ni].x), bflo(rp[ni].y), bfhi(rp[ni].y)};
                const float vcf[4] = {bflo(vc[ni].x), bfhi(vc[ni].x), bflo(vc[ni].y), bfhi(vc[ni].y)}, vpf[4] = {bflo(vp[ni].x), bfhi(vp[ni].x), bflo(vp[ni].y), bfhi(vp[ni].y)};
                float Av[4], Rv[4], Kv[4], Bv[4]; f32x4 gam;
#pragma unroll
                for (int e = 0; e < 4; ++e) {
                    const float r = rcf[e] + mr[e] * (rpf[e] - rcf[e]); const float vv = vcf[e] + mv[e] * (vpf[e] - vcf[e]);
                    ((LAS bf16*)(cb + RW_O_VT))[(jl + e) * 20 + c] = (bf16)f2bf(vv);
                    const float nx = -(w0[e] + accw[ni][e]); const float sp = fmaxf(nx, 0.f) + __logf(1.f + __expf(-fabsf(nx)));
                    const float lw = -__expf(-sp - 0.5f);
                    const float av = __builtin_amdgcn_rcpf(1.f + __expf(-(a0[e] + acca[ni][e])));
                    const float k = kraw[ni * 4 + e]; const float kk = k * kkp[e] * rs; const float kp = k * (1.f + (av - 1.f) * kap[e]);
                    bon += r * kp * rkp[e];
                    float cum = lw; DPP_SHR_ADD(cum, 1); DPP_SHR_ADD(cum, 2); DPP_SHR_ADD(cum, 4); DPP_SHR_ADD(cum, 8);
                    const float eg = __expf(cum), egm = __expf(cum - lw), ieg = __builtin_amdgcn_rcpf(eg);
                    Av[e] = -kk * egm; Rv[e] = r * eg; Kv[e] = kp * ieg; Bv[e] = kk * av * ieg; gam[e] = eg; }
                fA[ni] = pack4(Av[0], Av[1], Av[2], Av[3]); fR[ni] = pack4(Rv[0], Rv[1], Rv[2], Rv[3]); fK[ni] = pack4(Kv[0], Kv[1], Kv[2], Kv[3]); fB[ni] = pack4(Bv[0], Bv[1], Bv[2], Bv[3]);
                if (c == 15) *(LAS f32x4*)(cb + RW_O_GAM + jl * 4) = gam;
                *(LAS u32x2*)(cb + RW_O_AB + (c * 72 + jl) * 2) = fA[ni]; *(LAS u32x2*)(cb + RW_O_RB + (c * 72 + jl) * 2) = fR[ni];
                LAS bf16* c3 = (LAS bf16*)(cb + RW_O_CH3) + ((ni * 16 + 4 * g) * 4 + (c >> 2)) * 8 + (c & 3);
                c3[0] = (bf16)(fB[ni].x & 0xffffu); c3[32] = (bf16)(fB[ni].x >> 16); c3[64] = (bf16)(fB[ni].y & 0xffffu); c3[96] = (bf16)(fB[ni].y >> 16);
                c3[4] = (bf16)(fK[ni].x & 0xffffu); c3[36] = (bf16)(fK[ni].x >> 16); c3[68] = (bf16)(fK[ni].y & 0xffffu); c3[100] = (bf16)(fK[ni].y >> 16); }
            bon += __shfl_xor(bon, 16); bon += __shfl_xor(bon, 32);
            if (g == 0) ((LAS float*)(cb + RW_O_BON))[c] = bon;
            f32x4 Lab = {0.f, 0.f, 0.f, 0.f}, Lak = Lab, Grk = Lab, Grb = Lab;
#pragma unroll
            for (int p = 0; p < 2; ++p) { const bf16x8 xa = mkfrag(fA[2 * p], fA[2 * p + 1]), xr = mkfrag(fR[2 * p], fR[2 * p + 1]), xb = mkfrag(fB[2 * p], fB[2 * p + 1]), xk = mkfrag(fK[2 * p], fK[2 * p + 1]);
                Lab = __builtin_amdgcn_mfma_f32_16x16x32_bf16(xa, xb, Lab, 0, 0, 0); Lak = __builtin_amdgcn_mfma_f32_16x16x32_bf16(xa, xk, Lak, 0, 0, 0);
                Grk = __builtin_amdgcn_mfma_f32_16x16x32_bf16(xr, xk, Grk, 0, 0, 0); Grb = __builtin_amdgcn_mfma_f32_16x16x32_bf16(xr, xb, Grb, 0, 0, 0); }
            LAS float* LT = YB + wave * 256;
            { f32x4 lt;
#pragma unroll
              for (int e = 0; e < 4; ++e) { const int tr = 4 * g + e; const bool st = c < tr, inc = c <= tr;
                  lt[e] = st ? Lab[e] : 0.f;
                  ((LAS bf16*)(cb + RW_O_LAK))[tr * 16 + c] = (bf16)f2bf(st ? Lak[e] : 0.f);
                  ((LAS bf16*)(cb + RW_O_GRK))[tr * 16 + c] = (bf16)f2bf(inc ? Grk[e] : 0.f);
                  ((LAS bf16*)(cb + RW_O_GRB))[tr * 16 + c] = (bf16)f2bf(inc ? Grb[e] : 0.f); }
              *(LAS f32x4*)(LT + c * 16 + 4 * g) = lt; }
            float Tr[16];
#pragma unroll
            for (int u = 0; u < 16; ++u) Tr[u] = (u == c) ? 1.f : 0.f;
#pragma unroll
            for (int u = 14; u >= 0; --u) { float lrow[16];
#pragma unroll
                for (int q = 0; q < 4; ++q) { const f32x4 x = *(const LAS f32x4*)(LT + u * 16 + 4 * q); lrow[4 * q] = x[0]; lrow[4 * q + 1] = x[1]; lrow[4 * q + 2] = x[2]; lrow[4 * q + 3] = x[3]; }
                float acc = 0.f;
#pragma unroll
                for (int s = u + 1; s < 16; ++s) acc += Tr[s] * lrow[s];
                Tr[u] = (u < c) ? acc : Tr[u]; }
            if (g == 0) { v4u t0v, t1v; t0v.x = cvtpk(Tr[0], Tr[1]); t0v.y = cvtpk(Tr[2], Tr[3]); t0v.z = cvtpk(Tr[4], Tr[5]); t0v.w = cvtpk(Tr[6], Tr[7]);
                t1v.x = cvtpk(Tr[8], Tr[9]); t1v.y = cvtpk(Tr[10], Tr[11]); t1v.z = cvtpk(Tr[12], Tr[13]); t1v.w = cvtpk(Tr[14], Tr[15]);
                *(LAS v4u*)(cb + RW_O_TT + c * 32) = t0v; *(LAS v4u*)(cb + RW_O_TT + c * 32 + 16) = t1v; }
        }
        __syncthreads();
        if (wave < 4) {
            int c = c_, g = g_; asm volatile("" : "+v"(c), "+v"(g));
#pragma unroll 1
            for (int ch = 0; ch < 8; ++ch) { LAS unsigned char* cb = lds + ch * RW_CHB;
                const u32x2 vfr = *(const LAS u32x2*)(cb + RW_O_VT + ((16 * wave + c) * 20 + 4 * g) * 2);
                u32x2 sb[4];
#pragma unroll
                for (int jt = 0; jt < 4; ++jt) sb[jt] = pack4(S[jt][0], S[jt][1], S[jt][2], S[jt][3]);
                f32x4 acc1 = {0.f, 0.f, 0.f, 0.f}, accY = acc1;
#pragma unroll
                for (int jt = 0; jt < 4; ++jt) { const u32x2 a1 = *(const LAS u32x2*)(cb + RW_O_AB + (c * 72 + 16 * jt + 4 * g) * 2), aY = *(const LAS u32x2*)(cb + RW_O_RB + (c * 72 + 16 * jt + 4 * g) * 2);
                    u32x2 a1x = z2, aYx = z2, bx = z2;
                    if (jt == 0) { a1x = *(const LAS u32x2*)(cb + RW_O_LAK + (c * 16 + 4 * g) * 2); aYx = *(const LAS u32x2*)(cb + RW_O_GRK + (c * 16 + 4 * g) * 2); bx = vfr; }
                    const bf16x8 bf = mkfrag(sb[jt], bx);
                    acc1 = __builtin_amdgcn_mfma_f32_16x16x32_bf16(mkfrag(a1, a1x), bf, acc1, 0, 0, 0);
                    accY = __builtin_amdgcn_mfma_f32_16x16x32_bf16(mkfrag(aY, aYx), bf, accY, 0, 0, 0); }
                const u32x2 rb = pack4(acc1[0], acc1[1], acc1[2], acc1[3]);
                f32x4 accU = {0.f, 0.f, 0.f, 0.f};
                accU = __builtin_amdgcn_mfma_f32_16x16x32_bf16(mkfrag(*(const LAS u32x2*)(cb + RW_O_TT + (c * 16 + 4 * g) * 2), z2), mkfrag(rb, z2), accU, 0, 0, 0);
                const u32x2 ub = pack4(accU[0], accU[1], accU[2], accU[3]);
                accY = __builtin_amdgcn_mfma_f32_16x16x32_bf16(mkfrag(*(const LAS u32x2*)(cb + RW_O_GRB + (c * 16 + 4 * g) * 2), z2), mkfrag(ub, z2), accY, 0, 0, 0);
#pragma unroll
                for (int e = 0; e < 4; ++e) YB[(ch * 16 + 4 * g + e) * 64 + 16 * wave + c] = accY[e];
                const bf16x8 b3 = mkfrag(ub, vfr);
#pragma unroll
                for (int jt = 0; jt < 4; ++jt) { const bf16x8 a3 = *(const LAS bf16x8*)(cb + RW_O_CH3 + (((jt * 16 + c) * 4 + g) * 8) * 2);
                    S[jt] = __builtin_amdgcn_mfma_f32_16x16x32_bf16(a3, b3, S[jt], 0, 0, 0);
                    S[jt] = S[jt] * *(const LAS f32x4*)(cb + RW_O_GAM + (16 * jt + 4 * g) * 4); }
            }
        }
        __syncthreads();
        {   int lane = lane_; asm volatile("" : "+v"(lane));
            LAS unsigned char* cb = lds + wave * RW_CHB;
            const float lng = PAR[5 * 64 + lane], lnb = PAR[6 * 64 + lane];
#pragma unroll 4
            for (int tt = 0; tt < 16; ++tt) { const size_t rowg = (size_t)(b * SEQ + bt * 128 + wave * 16 + tt);
                const float z = bf2f(P[rowg * EVEN_PAD + C_Z0 + h * 64 + lane]);
                const float y = YB[(wave * 16 + tt) * 64 + lane]; const float mean = wave_sum_fast(y) * (1.f / 64.f); const float d = y - mean; const float var = wave_sum_fast(d * d) * (1.f / 64.f);
                const float vv = bf2f(((const LAS bf16*)(cb + RW_O_VT))[lane * 20 + tt]); const float bonv = ((const LAS float*)(cb + RW_O_BON))[tt];
                const float o = d * __builtin_amdgcn_rsqf(var + 64e-5f) * lng + lnb + bonv * vv;
                MIX[rowg * D + h * 64 + lane] = (bf16)f2bf(o * siluf(z)); }
        }
        __syncthreads();
    }
}
__global__ void __launch_bounds__(NWAVES * 64, 2) mk_fwd(Args args) {
    extern __shared__ __attribute__((aligned(16))) unsigned char lds_raw[];
    LAS unsigned char* lds = (LAS unsigned char*)lds_raw;
    volatile LAS unsigned* MISC = (volatile LAS unsigned*)(lds + MISC_OFF);
    const int tid = threadIdx.x, lane = tid & 63, wave = __builtin_amdgcn_readfirstlane(tid >> 6);
    const int G = gridDim.x; const int bx = blockIdx.x; const int vcu = (G % 8 == 0) ? (bx % 8) * (G / 8) + bx / 8 : bx;
    unsigned char* ws = args.ws;
    gu32* ctl = (gu32*)(ws + WS_CTL);
    for (int u = tid; u < (LDS_BYTES - LDSCTL_OFF) / 4; u += NWAVES * 64) ((LAS unsigned*)(lds + LDSCTL_OFF))[u] = 0u;
    __syncthreads();
    XcdBarrier bar = xcd_barrier_post((unsigned*)(ctl + CW_BAR), MISC + 8);
    const int lo = args.ph_lo, hi = args.ph_hi;
#define IN(k) (lo <= (k) && (k) < hi)
#define GRID_BAR() xcd_barrier(bar)
    float* mod = (float*)(ws + WS_MOD);
    bf16* XN = (bf16*)(ws + WS_XN); bf16* MIX = (bf16*)(ws + WS_MIX); bf16* P = (bf16*)(ws + WS_P);

    if (IN(0)) { phase0(args, lds, tid, lane, wave, vcu, G); GRID_BAR(); }
    if (IN(1)) { phase_adaln_rows(args.in[I_X], args.in[I_NORMG], mod, XN, lane, wave, vcu, G); GRID_BAR(); }
    if (IN(2)) {
        pg8::Gemm g{XN, (const bf16*)(ws + WS_WIN0), M, EVEN_PAD, D}; pg8::StaticOrder S; S.init(M, EVEN_PAD, G, (int)blockIdx.x);
        pg8::EpiBf16 E{P, EVEN_PAD};
        pg8::gemm_phase<pg8::EpiBf16, pg8::StaticOrder, PG8_ALIGN, PG8_SP2>(lds, g, S, E);
        GRID_BAR();
    }
    if (IN(3)) { for (int unit = vcu; unit < BATCH * 8; unit += G) phase_rwkv3(args, lds, tid, lane, wave, unit); phase_gmlp2(args, lds, tid, lane, wave, vcu, G); GRID_BAR(); }
    if (IN(4)) {
        pg8::Gemm g{MIX, (const bf16*)(ws + WS_WOUT0), M, D, D}; pg8::StaticOrder S; S.init(M, D, G, (int)blockIdx.x);
        pg8::EpiResGate E{args.in[I_X], args.out, mod + 2048};
        pg8::gemm_phase<pg8::EpiResGate, pg8::StaticOrder, PG8_ALIGN, PG8_SP2>(lds, g, S, E);
        GRID_BAR();
    }
    if (IN(5)) { phase_adaln_rows(args.out, args.in[I_NORMG] + D, mod + 16 * 3072, XN, lane, wave, vcu, G); GRID_BAR(); }
    if (IN(6)) {
        pg8::Gemm g{XN, (const bf16*)(ws + WS_WIN1), M, ODD_IN, D}; pg8::StaticOrder S; S.init(M, ODD_IN, G, (int)blockIdx.x);
        pg8::EpiBf16 E{P, ODD_IN};
        pg8::gemm_phase<pg8::EpiBf16, pg8::StaticOrder, PG8_ALIGN, PG8_SP2>(lds, g, S, E);
        GRID_BAR();
    }
    if (IN(7)) { phase_swa2(args, lds, tid, lane, wave, vcu, G); GRID_BAR(); }
    if (IN(8)) {
        pg8::Gemm g{MIX, (const bf16*)(ws + WS_WOUT1), M, D, D}; pg8::StaticOrder S; S.init(M, D, G, (int)blockIdx.x);
        pg8::EpiResGate E{args.out, args.out, mod + 16 * 3072 + 2048};
        pg8::gemm_phase<pg8::EpiResGate, pg8::StaticOrder, PG8_ALIGN, PG8_SP2>(lds, g, S, E);
        GRID_BAR();
    }
    if (IN(9)) { phase_final_rows(args.out, args.in[I_FINALG], lane, wave, vcu, G); }
#undef IN
#undef GRID_BAR
}

extern "C" void kernel_launch(void* const* d_in, const int* in_sizes, int n_in, void* d_out, int out_size, void* d_ws, size_t ws_size, hipStream_t stream) {
    static int grid = 0;
    if (grid == 0) {
        if (n_in != N_IN || in_sizes[0] != M * D || out_size != M * D || ws_size < WS_END) { fprintf(stderr, "kernel_launch: unexpected shapes (n_in %d, in0 %d, out %d, ws %zu); nothing launched\n", n_in, n_in > 0 ? in_sizes[0] : -1, out_size, ws_size); grid = -1; return; }
        int dev = 0, cus = 0, per_cu = 0;
        if (hipGetDevice(&dev) != hipSuccess || hipDeviceGetAttribute(&cus, hipDeviceAttributeMultiprocessorCount, dev) != hipSuccess) { grid = -1; return; }
        if (hipFuncSetAttribute((const void*)mk_fwd, hipFuncAttributeMaxDynamicSharedMemorySize, LDS_BYTES) != hipSuccess) { fprintf(stderr, "kernel_launch: hipFuncSetAttribute failed\n"); grid = -1; return; }
        if (hipOccupancyMaxActiveBlocksPerMultiprocessor(&per_cu, (const void*)mk_fwd, NWAVES * 64, LDS_BYTES) != hipSuccess || per_cu < 1) fprintf(stderr, "kernel_launch: note: occupancy query reports %d\n", per_cu);
        (void)hipGetLastError();
        grid = cus;
    }
    if (grid < 0) return;
    if (hipMemsetAsync((char*)d_ws + WS_CTL, 0, CTL_ZERO_BYTES, stream) != hipSuccess) { fprintf(stderr, "kernel_launch: memset failed\n"); return; }
    Args a{};
    for (int i = 0; i < N_IN; ++i) a.in[i] = (const float*)d_in[i];
    a.out = (float*)d_out; a.ws = (unsigned char*)d_ws; a.ph_lo = 0; a.ph_hi = 10;
    hipLaunchKernelGGL(mk_fwd, dim3(grid), dim3(NWAVES * 64), LDS_BYTES, stream, a);
}
```

```cpp
#include <hip/hip_runtime.h>
#include <cstdio>
#include <cstdint>
namespace pg8 {
#define PG8_LAS __attribute__((address_space(3)))
typedef unsigned short bf16_t;
typedef short bf16x8 __attribute__((ext_vector_type(8)));
typedef float f32x4 __attribute__((ext_vector_type(4)));
typedef unsigned u32x4 __attribute__((ext_vector_type(4)));
constexpr int BM = 256, BK = 64, HALF = 128, HTB = HALF * BK * 2  , STAGE_BYTES = 8 * HTB, NXCD = 8, WGM = 8;

__host__ __device__ __forceinline__ int lds_byte(int r, int c) { const int st = (r >> 4) * 2 + (c >> 5), rr = r & 15, cc = c & 31, ob = rr * 64 + cc * 2; return st * 1024 + (ob ^ (((ob >> 9) & 1) << 5)); }
__host__ __device__ __forceinline__ void stage_rc(int b, int& R, int& C) { const int st = b / 1024, sb = b % 1024, swz = sb ^ (((sb >> 9) & 1) << 5); R = (st >> 1) * 16 + swz / 64; C = (st & 1) * 32 + (swz % 64) / 2; }
__host__ __device__ __forceinline__ int perm32(int rho) { const int n = rho >> 4, i = rho & 15; return 8 * (i >> 2) + 4 * n + (i & 3); }

struct Unit { int pm, pn; };
struct Gemm { const bf16_t* A; const bf16_t* Bt; int M, N, K; };

struct StaticOrder {
    int nM, nN, nwg, G, c;
    __host__ __device__ void init(int M, int N, int G_, int c_) { nM = M / BM; nN = N / BM; nwg = nM * nN; G = G_; c = c_; }
    __host__ __device__ bool next(int i, Unit& u) const {
        const long L = (long)i * G + c; if (L >= nwg) return false;
        int wgid = (int)L; { const int q = nwg / NXCD, r = nwg % NXCD, xcd = wgid % NXCD, off = wgid / NXCD; wgid = (xcd < r ? xcd * (q + 1) : r * (q + 1) + (xcd - r) * q) + off; }
        const int nig = WGM * nN, gid = wgid / nig, fm = gid * WGM, gsz = (nM - fm) < WGM ? (nM - fm) : WGM;
        u.pm = fm + ((wgid % nig) % gsz); u.pn = (wgid % nig) / gsz; return true;
    }
    __device__ __forceinline__ void a_ready(const Unit&) const {}
    __device__ __forceinline__ void done(const Unit&) const {}
};

__device__ __forceinline__ unsigned cvt_pk_bf16(float lo, float hi) { unsigned r; asm volatile("v_cvt_pk_bf16_f32 %0, %1, %2" : "=v"(r) : "v"(lo), "v"(hi)); return r; }
struct EpiBf16 {
    static constexpr bool PERM = true, AFTER_DRAIN = false;
    bf16_t* O; int ldc;
    __device__ __forceinline__ void operator()(const f32x4 (&acc)[2][2][4][2], const Unit& u, int wr, int wc, int fr, int fq) const {
        const int row0 = u.pm * BM + wr * 64 + fr; const int col0 = u.pn * BM + wc * 32 + 8 * fq;
#pragma unroll
        for (int ai = 0; ai < 2; ++ai)
#pragma unroll
            for (int m = 0; m < 4; ++m) { bf16_t* rowp = O + (size_t)(row0 + ai * HALF + m * 16) * ldc + col0;
#pragma unroll
                for (int bj = 0; bj < 2; ++bj) { const f32x4 v0 = acc[ai][bj][m][0], v1 = acc[ai][bj][m][1];
                    u32x4 w; w.x = cvt_pk_bf16(v0[0], v0[1]); w.y = cvt_pk_bf16(v0[2], v0[3]); w.z = cvt_pk_bf16(v1[0], v1[1]); w.w = cvt_pk_bf16(v1[2], v1[3]);
                    *(u32x4*)(rowp + bj * HALF) = w; } }
    }
};
struct EpiResGate {
    static constexpr bool PERM = false, AFTER_DRAIN = false;
    const float* base; float* out; const float* gate;
    __device__ __forceinline__ void operator()(const f32x4 (&acc)[2][2][4][2], const Unit& u, int wr, int wc, int fr, int fq) const {
        const int col0 = u.pn * BM + wc * 32 + 4 * fq; const int b = (u.pm * BM) >> 11;
        f32x4 gv[2][2];
#pragma unroll
        for (int bj = 0; bj < 2; ++bj)
#pragma unroll
            for (int n = 0; n < 2; ++n) gv[bj][n] = *(const f32x4*)(gate + (size_t)b * 3072 + col0 + bj * HALF + n * 16);
#pragma unroll
        for (int ai = 0; ai < 2; ++ai)
#pragma unroll
            for (int m = 0; m < 4; ++m) { const size_t off = (size_t)(u.pm * BM + ai * HALF + wr * 64 + m * 16 + fr) * 1024 + col0;
#pragma unroll
                for (int bj = 0; bj < 2; ++bj)
#pragma unroll
                    for (int n = 0; n < 2; ++n) { const f32x4 bs = *(const f32x4*)(base + off + bj * HALF + n * 16);
                        *(f32x4*)(out + off + bj * HALF + n * 16) = bs + gv[bj][n] * acc[ai][bj][m][n]; } }
    }
};

struct EpiResGateNext {
    static constexpr bool PERM = false, AFTER_DRAIN = false;
    const float* base; float* out; const float* gate; const float* g1; const float* scale1; bf16_t* xn; float* rowss;
    __device__ __forceinline__ void operator()(const f32x4 (&acc)[2][2][4][2], const Unit& u, int wr, int wc, int fr, int fq) const {
        const int col0 = u.pn * BM + wc * 32 + 4 * fq; const int b = (u.pm * BM) >> 11;
        f32x4 gv[2][2], gs[2][2];
#pragma unroll
        for (int bj = 0; bj < 2; ++bj)
#pragma unroll
            for (int n = 0; n < 2; ++n) { const int c = col0 + bj * HALF + n * 16; gv[bj][n] = *(const f32x4*)(gate + (size_t)b * 3072 + c);
                gs[bj][n] = *(const f32x4*)(g1 + c) * (*(const f32x4*)(scale1 + (size_t)b * 3072 + c) + 1.0f); }
#pragma unroll
        for (int ai = 0; ai < 2; ++ai)
#pragma unroll
            for (int m = 0; m < 4; ++m) { const int r = u.pm * BM + ai * HALF + wr * 64 + m * 16 + fr; const size_t off = (size_t)r * 1024 + col0; float ss = 0.f;
#pragma unroll
                for (int bj = 0; bj < 2; ++bj)
#pragma unroll
                    for (int n = 0; n < 2; ++n) { const f32x4 bs = *(const f32x4*)(base + off + bj * HALF + n * 16); const f32x4 x1 = bs + gv[bj][n] * acc[ai][bj][m][n];
                        *(f32x4*)(out + off + bj * HALF + n * 16) = x1; ss += (x1[0] * x1[0] + x1[1] * x1[1]) + (x1[2] * x1[2] + x1[3] * x1[3]);
                        const f32x4 hq = x1 * gs[bj][n]; typedef unsigned u32x2v __attribute__((ext_vector_type(2))); u32x2v w; w.x = cvt_pk_bf16(hq[0], hq[1]); w.y = cvt_pk_bf16(hq[2], hq[3]);
                        *(u32x2v*)(xn + off + bj * HALF + n * 16) = w; }
                ss += __shfl_xor(ss, 16); ss += __shfl_xor(ss, 32);
                if (fq == 0) rowss[(size_t)r * 16 + u.pn * 4 + wc] = ss; }
    }
};
struct EpiBf16RowScale {
    static constexpr bool PERM = true, AFTER_DRAIN = false;
    bf16_t* O; int ldc; const float* rowss; const float* bias;
    __device__ __forceinline__ void operator()(const f32x4 (&acc)[2][2][4][2], const Unit& u, int wr, int wc, int fr, int fq) const {
        const int row0 = u.pm * BM + wr * 64 + fr; const int col0 = u.pn * BM + wc * 32 + 8 * fq; const int b = (u.pm * BM) >> 11;
        f32x4 bv[2][2];
#pragma unroll
        for (int bj = 0; bj < 2; ++bj)
#pragma unroll
            for (int n = 0; n < 2; ++n) bv[bj][n] = *(const f32x4*)(bias + (size_t)b * ldc + col0 + bj * HALF + 4 * n);
#pragma unroll
        for (int ai = 0; ai < 2; ++ai)
#pragma unroll
            for (int m = 0; m < 4; ++m) { const int r = row0 + ai * HALF + m * 16; const f32x4* rp = (const f32x4*)(rowss + (size_t)r * 16);
                const f32x4 q0 = rp[0], q1 = rp[1], q2 = rp[2], q3 = rp[3]; const f32x4 qs = (q0 + q1) + (q2 + q3);
                const float rr = 1.0f / sqrtf(((qs[0] + qs[1]) + (qs[2] + qs[3])) * (1.0f / 1024.0f) + 1e-6f);
                bf16_t* rowp = O + (size_t)r * ldc + col0;
#pragma unroll
                for (int bj = 0; bj < 2; ++bj) { const f32x4 v0 = acc[ai][bj][m][0] * rr + bv[bj][0], v1 = acc[ai][bj][m][1] * rr + bv[bj][1];
                    u32x4 w; w.x = cvt_pk_bf16(v0[0], v0[1]); w.y = cvt_pk_bf16(v0[2], v0[3]); w.z = cvt_pk_bf16(v1[0], v1[1]); w.w = cvt_pk_bf16(v1[2], v1[3]);
                    *(u32x4*)(rowp + bj * HALF) = w; } }
    }
};
template <class Epi, class Sched, bool ALIGN_EPI = false, bool SP2 = false>
__device__ __forceinline__ void gemm_phase(PG8_LAS unsigned char* lds, const Gemm g, const Sched& S, const Epi& E) {
    const int tid = threadIdx.x, wid = __builtin_amdgcn_readfirstlane(tid >> 6), lane = tid & 63, wr = wid >> 2, wc = wid & 3, fr = lane & 15, fq = lane >> 4;
    const int K = g.K, nt = K / BK;
    unsigned voffA[2], voffB[2];
#pragma unroll
    for (int i = 0; i < 2; ++i) { int R, C; stage_rc(tid * 16 + i * 8192, R, C); const int Rb = Epi::PERM ? ((R & ~31) + perm32(R & 31)) : R;
        voffA[i] = (unsigned)(R * K + C) * 2u; voffB[i] = (unsigned)(Rb * K + C) * 2u; }
    const size_t kstep = (size_t)(BK * 2);
    const size_t hstep = (size_t)HALF * K * 2;
    const size_t tstep = 2 * hstep;
    const unsigned ldsw = (unsigned)wid * 1024u;
    const int aoff = lds_byte(wr * 64 + fr, fq * 8), boff = lds_byte(wc * 32 + fr, fq * 8);
#define PG8_SA(b, h) (((b) * 2 + (h)) * HTB)
#define PG8_SB(b, h) ((4 + (b) * 2 + (h)) * HTB)
#define PG8_STAGE(bufoff, gbase, voff) do { _Pragma("unroll") for (int _i = 0; _i < 2; ++_i) \
        __builtin_amdgcn_global_load_lds((const unsigned*)((const char*)(gbase) + (voff)[_i]), (PG8_LAS unsigned*)(lds + (bufoff) + ldsw + _i * 8192), 16, 0, 0); } while (0)
#define PG8_LDA(dst, b, h) do { _Pragma("unroll") for (int m = 0; m < 4; ++m) _Pragma("unroll") for (int k = 0; k < 2; ++k) dst[m][k] = *(const PG8_LAS bf16x8*)(lds + PG8_SA(b, h) + aoff + m * 2048 + k * 1024); } while (0)
#define PG8_LDB(dst, b, h) do { _Pragma("unroll") for (int n = 0; n < 2; ++n) _Pragma("unroll") for (int k = 0; k < 2; ++k) dst[n][k] = *(const PG8_LAS bf16x8*)(lds + PG8_SB(b, h) + boff + n * 2048 + k * 1024); } while (0)
#define PG8_MMA(ai, bj, At, Bt) do { __builtin_amdgcn_s_setprio(1); _Pragma("unroll") for (int m = 0; m < 4; ++m) _Pragma("unroll") for (int n = 0; n < 2; ++n) _Pragma("unroll") for (int k = 0; k < 2; ++k) \
        acc[ai][bj][m][n] = __builtin_amdgcn_mfma_f32_16x16x32_bf16(Bt[n][k], At[m][k], acc[ai][bj][m][n], 0, 0, 0); __builtin_amdgcn_s_setprio(0); } while (0)
#define PG8_WAIT_V(n) asm volatile("s_waitcnt vmcnt(" #n ")" ::: "memory")
#define PG8_WAIT_L(n) asm volatile("s_waitcnt lgkmcnt(" #n ")" ::: "memory")
#define PG8_BAR __builtin_amdgcn_s_barrier()
#define PG8_SCHED __builtin_amdgcn_sched_barrier(0)
    Unit cur, nxt; int ui = 0;
    if (!S.next(0, cur)) return;
    f32x4 acc[2][2][4][2];
#pragma unroll
    for (int a = 0; a < 2; ++a)
#pragma unroll
        for (int b = 0; b < 2; ++b)
#pragma unroll
            for (int m = 0; m < 4; ++m)
#pragma unroll
                for (int n = 0; n < 2; ++n) acc[a][b][m][n] = (f32x4){0.f, 0.f, 0.f, 0.f};
    bf16x8 At[4][2], B0[2][2], B1[2][2];
    const char* cA = (const char*)g.A + (size_t)cur.pm * tstep; const char* cB = (const char*)g.Bt + (size_t)cur.pn * tstep;
    S.a_ready(cur);
    if constexpr (SP2) {
        PG8_STAGE(PG8_SB(0, 0), cB, voffB); PG8_STAGE(PG8_SB(0, 1), cB + hstep, voffB); PG8_STAGE(PG8_SA(0, 0), cA, voffA); PG8_STAGE(PG8_SA(0, 1), cA + hstep, voffA);
        if (wr == 1) PG8_BAR;
        PG8_WAIT_V(2); PG8_BAR;
        PG8_STAGE(PG8_SB(1, 0), cB + kstep, voffB); PG8_STAGE(PG8_SA(1, 0), cA + kstep, voffA); PG8_STAGE(PG8_SB(1, 1), cB + hstep + kstep, voffB);
        PG8_WAIT_V(6); PG8_BAR;
    } else {
        PG8_STAGE(PG8_SB(0, 0), cB, voffB); PG8_STAGE(PG8_SA(0, 0), cA, voffA); PG8_STAGE(PG8_SB(0, 1), cB + hstep, voffB); PG8_STAGE(PG8_SA(0, 1), cA + hstep, voffA);
        if (wr == 1) PG8_BAR;
        PG8_WAIT_V(4); PG8_BAR;
        PG8_STAGE(PG8_SB(1, 0), cB + kstep, voffB); PG8_STAGE(PG8_SA(1, 0), cA + kstep, voffA); PG8_STAGE(PG8_SB(1, 1), cB + hstep + kstep, voffB);
        PG8_WAIT_V(6); PG8_BAR;
    }
    for (;;) {
        const bool has_next = S.next(ui + 1, nxt);
        const char* nA = has_next ? (const char*)g.A + (size_t)nxt.pm * tstep : cA; const char* nB = has_next ? (const char*)g.Bt + (size_t)nxt.pn * tstep : cB;
        for (int t = 0; t < nt; t += 2) {
            const bool last = (t == nt - 2);
            const char* a1 = cA + (size_t)(t + 1) * kstep;
            const char* a2 = last ? nA : cA + (size_t)(t + 2) * kstep; const char* b2 = last ? nB : cB + (size_t)(t + 2) * kstep;
            const char* a3 = a2 + kstep; const char* b3 = b2 + kstep;
            if (last && has_next) S.a_ready(nxt);
            if constexpr (SP2) {
            PG8_LDB(B0, 0, 0); PG8_LDB(B1, 0, 1); PG8_SCHED; PG8_LDA(At, 0, 0); PG8_STAGE(PG8_SA(1, 1), a1 + hstep, voffA);
            PG8_WAIT_V(8); PG8_WAIT_L(0); PG8_BAR; PG8_MMA(0, 0, At, B0); PG8_MMA(0, 1, At, B1); PG8_BAR; PG8_SCHED;
            PG8_LDA(At, 0, 1); PG8_STAGE(PG8_SB(0, 0), b2, voffB); PG8_STAGE(PG8_SB(0, 1), b2 + hstep, voffB); PG8_STAGE(PG8_SA(0, 0), a2, voffA);
            PG8_WAIT_V(8); PG8_WAIT_L(0); PG8_BAR; PG8_MMA(1, 0, At, B0); PG8_MMA(1, 1, At, B1); PG8_BAR; PG8_SCHED;
            PG8_LDB(B0, 1, 0); PG8_LDB(B1, 1, 1); PG8_SCHED; PG8_LDA(At, 1, 0); PG8_STAGE(PG8_SA(0, 1), a2 + hstep, voffA);
            PG8_WAIT_V(8); PG8_WAIT_L(0); PG8_BAR; PG8_MMA(0, 0, At, B0); PG8_MMA(0, 1, At, B1); PG8_BAR; PG8_SCHED;
            PG8_LDA(At, 1, 1); PG8_STAGE(PG8_SB(1, 0), b3, voffB); PG8_STAGE(PG8_SB(1, 1), b3 + hstep, voffB); PG8_STAGE(PG8_SA(1, 0), a3, voffA);
            PG8_WAIT_V(8); PG8_WAIT_L(0); PG8_BAR; PG8_MMA(1, 0, At, B0); PG8_MMA(1, 1, At, B1); PG8_BAR; PG8_SCHED;
            } else {
            PG8_LDB(B0, 0, 0); PG8_SCHED; PG8_LDA(At, 0, 0); PG8_STAGE(PG8_SA(1, 1), a1 + hstep, voffA);
            PG8_WAIT_L(8); PG8_BAR; PG8_WAIT_L(0); PG8_MMA(0, 0, At, B0); PG8_BAR; PG8_SCHED;
            PG8_LDB(B1, 0, 1); PG8_STAGE(PG8_SB(0, 0), b2, voffB);
            PG8_BAR; PG8_WAIT_L(0); PG8_MMA(0, 1, At, B1); PG8_BAR;
            PG8_LDA(At, 0, 1); PG8_STAGE(PG8_SA(0, 0), a2, voffA);
            PG8_BAR; PG8_WAIT_L(0); PG8_MMA(1, 0, At, B0); PG8_BAR; PG8_SCHED;
            PG8_STAGE(PG8_SB(0, 1), b2 + hstep, voffB);
            PG8_WAIT_V(6); PG8_BAR; PG8_MMA(1, 1, At, B1); PG8_BAR;
            PG8_LDB(B0, 1, 0); PG8_SCHED; PG8_LDA(At, 1, 0); PG8_STAGE(PG8_SA(0, 1), a2 + hstep, voffA);
            PG8_WAIT_L(8); PG8_BAR; PG8_WAIT_L(0); PG8_MMA(0, 0, At, B0); PG8_BAR; PG8_SCHED;
            PG8_LDB(B1, 1, 1); PG8_STAGE(PG8_SB(1, 0), b3, voffB);
            PG8_BAR; PG8_WAIT_L(0); PG8_MMA(0, 1, At, B1); PG8_BAR;
            PG8_LDA(At, 1, 1); PG8_STAGE(PG8_SA(1, 0), a3, voffA);
            PG8_BAR; PG8_WAIT_L(0); PG8_MMA(1, 0, At, B0); PG8_BAR; PG8_SCHED;
            PG8_STAGE(PG8_SB(1, 1), b3 + hstep, voffB);
            PG8_WAIT_V(6); PG8_BAR; PG8_MMA(1, 1, At, B1); PG8_BAR;
            }
        }
        if constexpr (ALIGN_EPI) { if (wr == 0) PG8_BAR; }
        if constexpr (!Epi::AFTER_DRAIN) { E(acc, cur, wr, wc, fr, fq); S.done(cur); }
        if (!has_next) break;
#pragma unroll
        for (int a = 0; a < 2; ++a)
#pragma unroll
            for (int b = 0; b < 2; ++b)
#pragma unroll
                for (int m = 0; m < 4; ++m)
#pragma unroll
                    for (int n = 0; n < 2; ++n) acc[a][b][m][n] = (f32x4){0.f, 0.f, 0.f, 0.f};
        cur = nxt; cA = nA; cB = nB; ++ui;
        if constexpr (ALIGN_EPI) { if (wr == 1) PG8_BAR; }
    }
    PG8_WAIT_V(0);
    if constexpr (!ALIGN_EPI) { if (wr == 0) PG8_BAR; }
    PG8_BAR;
    if constexpr (Epi::AFTER_DRAIN) { E.fused(acc, cur, wr, wc, fr, fq, lds, wid, lane); S.done(cur); }
#undef PG8_SA
#undef PG8_SB
#undef PG8_STAGE
#undef PG8_LDA
#undef PG8_LDB
#undef PG8_MMA
#undef PG8_WAIT_V
#undef PG8_WAIT_L
#undef PG8_BAR
#undef PG8_SCHED
}
}

#ifndef PG8_SP2
#define PG8_SP2 true
#endif
#ifndef PG8_ALIGN
#define PG8_ALIGN true
#endif
#define GAS __attribute__((address_space(1)))
#define LAS __attribute__((address_space(3)))
typedef unsigned short bf16;
typedef unsigned v4u __attribute__((ext_vector_type(4)));
typedef float f32x4 __attribute__((ext_vector_type(4)));
typedef short bf16x8 __attribute__((ext_vector_type(8)));
typedef GAS unsigned gu32;
typedef GAS unsigned long long gu64;
#define RLX_AGENT __ATOMIC_RELAXED, __HIP_MEMORY_SCOPE_AGENT
#define LDS_WAIT() asm volatile("s_waitcnt lgkmcnt(0)" ::: "memory")
#define VM_WAIT() asm volatile("s_waitcnt vmcnt(0)" ::: "memory")
__device__ __forceinline__ unsigned long long rt() { return __builtin_amdgcn_s_memrealtime(); }
__device__ __forceinline__ unsigned f2bf(float f) { unsigned u = __builtin_bit_cast(unsigned, f); return (u + 0x7fffu + ((u >> 16) & 1u)) >> 16; }
__device__ __forceinline__ unsigned pk2(float lo, float hi) { return f2bf(lo) | (f2bf(hi) << 16); }

#define XB_TMO      128
#define XB_XCNT(j)  (256  + 64 * (j))
#define XB_XSUB(j)  (1280 + 64 * (j))
#define XB_XGEN(j)  (2304 + 64 * (j))
#define XB_TOP      3328
#define XB_TOPGEN   3392
#define XCD_BAR_WORDS 3456
#define XB_SPIN_CAP (1u << 22)

__device__ __forceinline__ unsigned xb_ld(unsigned* p)              { return __hip_atomic_load(p, __ATOMIC_RELAXED, __HIP_MEMORY_SCOPE_AGENT); }
__device__ __forceinline__ unsigned xb_add(unsigned* p, unsigned v) { return __hip_atomic_fetch_add(p, v, __ATOMIC_RELAXED, __HIP_MEMORY_SCOPE_AGENT); }
__device__ __forceinline__ unsigned xb_xcc_id() { return (unsigned)__builtin_amdgcn_s_getreg((3 << 11) | 20) & 0xFu; }
#define XB_SPIN(cond, bar) do { unsigned _sp = 0; while (cond) { __builtin_amdgcn_s_sleep(1); \
    if ((++_sp & 255u) == 0u) { if (xb_ld(&(bar)[XB_TMO])) break; if (_sp > XB_SPIN_CAP) { atomicAdd(&(bar)[XB_TMO], 1u); break; } } } } while (0)

struct XcdBarrier {
    unsigned* bar; unsigned x;
    volatile LAS unsigned* st;
};

__device__ __forceinline__ XcdBarrier xcd_barrier_post(unsigned* bar, volatile LAS unsigned* st) {
    XcdBarrier b; b.bar = bar; b.x = xb_xcc_id(); b.st = st;
    if (threadIdx.x == 0) (void)xb_add(&bar[XB_XCNT(b.x)], 1u);
    return b;
}
__device__ __forceinline__ void xcd_barrier_complete(unsigned* bar, unsigned x, unsigned& nloc, unsigned& nx) {
    const unsigned G = gridDim.x * gridDim.y * gridDim.z;
    unsigned sum, cnt, mine, sp = 0u;
    for (;;) {
        sum = 0u; cnt = 0u; mine = 0u;
#pragma unroll
        for (unsigned j = 0; j < 16; ++j) { const unsigned c = xb_ld(&bar[XB_XCNT(j)]); sum += c; cnt += (c > 0u) ? 1u : 0u; mine = (j == x) ? c : mine; }
        if (sum == G) break;
        __builtin_amdgcn_s_sleep(1);
        if ((++sp & 255u) == 0u) { if (xb_ld(&bar[XB_TMO])) break; if (sp > XB_SPIN_CAP) { atomicAdd(&bar[XB_TMO], 1u); break; } }
    }
    nloc = mine > 0u ? mine : 1u; nx = cnt > 0u ? cnt : 1u;
}

__device__ __forceinline__ void xcd_barrier(const XcdBarrier& b) {
    asm volatile("s_waitcnt vmcnt(0)" ::: "memory");
    __syncthreads();
    if (threadIdx.x == 0) {
        unsigned* bar = b.bar;
        __builtin_amdgcn_s_waitcnt(0);
        unsigned nloc = b.st[0], nx = b.st[1];
        if (nloc == 0u) { xcd_barrier_complete(bar, b.x, nloc, nx); b.st[0] = nloc; b.st[1] = nx; }
        const unsigned old = xb_add(&bar[XB_XSUB(b.x)], 1u);
        const unsigned gen = old / nloc;
        if (old + 1u == (gen + 1u) * nloc) {
            __builtin_amdgcn_fence(__ATOMIC_RELEASE, "agent");
            asm volatile("s_waitcnt vmcnt(0)" ::: "memory");
            const unsigned og = xb_add(&bar[XB_TOP], 1u);
            const unsigned tg = og / nx;
            if (og + 1u == (tg + 1u) * nx) xb_add(&bar[XB_TOPGEN], 1u);
            else XB_SPIN(xb_ld(&bar[XB_TOPGEN]) == tg, bar);
            __builtin_amdgcn_fence(__ATOMIC_ACQUIRE, "agent");
            xb_add(&bar[XB_XGEN(b.x)], 1u);
            asm volatile("s_waitcnt vmcnt(0)" ::: "memory");
        } else {
            XB_SPIN(xb_ld(&bar[XB_XGEN(b.x)]) == gen, bar);
            __builtin_amdgcn_fence(__ATOMIC_ACQUIRE, "agent");
            asm volatile("s_waitcnt vmcnt(0)" ::: "memory");
        }
    }
    __syncthreads();
}


constexpr int NWAVES = 8;
constexpr int BATCH = 16, SEQ = 2048, D = 1024, M = BATCH * SEQ;
constexpr int EVEN_IN = 3712, EVEN_PAD = 3840, ODD_IN = 2304;
constexpr int C_R = 0, C_K = 512, C_V = 1024, C_WLO = 1536, C_ALO = 1600, C_U = 1664, C_VG = 2176, C_Z0 = 2688;
constexpr int C_Q = 0, C_KC = 1024, C_VC = 1152, C_Z1 = 1280;
enum { I_X = 0, I_C, I_ADAW, I_ADAB, I_NORMG, I_EWIN, I_EMU, I_EW0, I_EWUP, I_EA0, I_EAUP, I_EKK, I_EKA, I_ERK, I_ELNXG, I_ELNXB, I_ESGLNG, I_ESGLNB, I_ESGW, I_ESGB, I_EWOUT, I_OWIN, I_OSINKS, I_OWOUT, I_FINALG, N_IN };

constexpr size_t MiB = 1u << 20;
constexpr size_t WS_CTL = 0, CTL_ZERO_BYTES = 64 * 1024;
constexpr size_t WS_MOD = 1 * MiB;
constexpr size_t WS_WIN0 = 2 * MiB, WS_WOUT0 = 10 * MiB, WS_WIN1 = 12 * MiB, WS_WOUT1 = 17 * MiB;
constexpr size_t WS_XN = 32 * MiB, WS_MIX = 96 * MiB, WS_P = 160 * MiB, WS_YRAW = 400 * MiB, WS_BON = 464 * MiB, WS_END = 507 * MiB;
constexpr size_t WS_RING = 400 * MiB;
constexpr size_t WS_ROWSS = 22 * MiB, WS_BIAS3 = 25 * MiB;
constexpr size_t WS_WUT = 20 * MiB, WS_AUT = 21 * MiB;
constexpr int CW_BAR = 4096;

constexpr int RING_BYTES = 131072, LDS_BYTES = 147456, LDSCTL_OFF = LDS_BYTES - 512, MISC_OFF = LDSCTL_OFF;

__device__ __forceinline__ float bf2f(unsigned short h) { return __builtin_bit_cast(float, (unsigned)h << 16); }
__device__ __forceinline__ float bflo(unsigned w) { return __builtin_bit_cast(float, w << 16); }
__device__ __forceinline__ float bfhi(unsigned w) { return __builtin_bit_cast(float, w & 0xffff0000u); }
__device__ __forceinline__ float wave_sum(float v) {
#pragma unroll
    for (int o = 1; o < 64; o <<= 1) v += __shfl_xor(v, o);
    return v;
}
__device__ __forceinline__ float siluf(float x) { return x / (1.f + __expf(-x)); }

struct Args { const float* in[N_IN]; float* out; unsigned char* ws; int ph_lo, ph_hi; };

__device__ __forceinline__ void p0_transpose_item(const float* W, int K, int N, bf16* WT, LAS float* scr, int item, int lane) {
    const int nblk = N / 32, kb = item / nblk, nb = item % nblk, k0 = 64 * kb, n0 = 32 * nb;
#pragma unroll 8
    for (int i = 0; i < 32; ++i) { const int kk = 2 * i + (lane >> 5); scr[kk * 33 + (lane & 31)] = W[(size_t)(k0 + kk) * N + n0 + (lane & 31)]; }
    LDS_WAIT(); asm volatile("" ::: "memory");
    const int c = lane & 7;
#pragma unroll
    for (int j = 0; j < 4; ++j) { const int n = (lane >> 3) + 8 * j; const LAS float* s = scr + (8 * c) * 33 + n;
        v4u o; o.x = pk2(s[0 * 33], s[1 * 33]); o.y = pk2(s[2 * 33], s[3 * 33]); o.z = pk2(s[4 * 33], s[5 * 33]); o.w = pk2(s[6 * 33], s[7 * 33]);
        *(GAS v4u*)(WT + (size_t)(n0 + n) * K + k0 + 8 * c) = o; }
    LDS_WAIT(); asm volatile("" ::: "memory");
}
__device__ __forceinline__ void phase0(const Args& a, LAS unsigned char* lds, int tid, int lane, int wave, int vcu, int G) {
    unsigned char* ws = a.ws;
    if (vcu < 96) {
        LAS float* condT = (LAS float*)lds;
        LAS float* part = (LAS float*)(lds + 65536);
        const float* c = a.in[I_C];
        for (int idx = tid; idx < 16384; idx += 512) { const int b = idx >> 10, k = idx & 1023; condT[k * 16 + b] = siluf(c[idx]); }
        __syncthreads();
        for (int it = vcu; it < 96; it += G) {
            const int l = it / 48, n0 = (it % 48) * 64;
            const float* W = a.in[I_ADAW] + (size_t)l * 1024 * 3072 + n0 + lane;
            float acc[16];
#pragma unroll
            for (int b = 0; b < 16; ++b) acc[b] = 0.f;
            const int kbeg = wave * 128;
#pragma unroll 32
            for (int k = kbeg; k < kbeg + 128; ++k) {
                const float w = W[(size_t)k * 3072];
                const LAS f32x4* cv = (const LAS f32x4*)(condT + k * 16);
                const f32x4 c0 = cv[0], c1 = cv[1], c2 = cv[2], c3 = cv[3];
                acc[0] += c0[0] * w; acc[1] += c0[1] * w; acc[2] += c0[2] * w; acc[3] += c0[3] * w;
                acc[4] += c1[0] * w; acc[5] += c1[1] * w; acc[6] += c1[2] * w; acc[7] += c1[3] * w;
                acc[8] += c2[0] * w; acc[9] += c2[1] * w; acc[10] += c2[2] * w; acc[11] += c2[3] * w;
                acc[12] += c3[0] * w; acc[13] += c3[1] * w; acc[14] += c3[2] * w; acc[15] += c3[3] * w;
            }
#pragma unroll
            for (int b = 0; b < 16; ++b) part[(wave * 16 + b) * 64 + lane] = acc[b];
            __syncthreads();
            float* mod = (float*)(ws + WS_MOD);
#pragma unroll
            for (int q = 0; q < 2; ++q) { const int b = (tid >> 6) + 8 * q; float s = 0.f;
#pragma unroll
                for (int w8 = 0; w8 < 8; ++w8) s += part[(w8 * 16 + b) * 64 + lane];
                mod[(size_t)(l * 16 + b) * 3072 + n0 + lane] = s + a.in[I_ADAB][l * 3072 + n0 + lane]; }
            __syncthreads();
        }
    }
    __syncthreads();
    LAS float* scr = (LAS float*)(lds + wave * 16384);
    const int gw = vcu * NWAVES + wave, NGW = G * NWAVES;
    constexpr int I0 = (D / 64) * (EVEN_IN / 32), I1 = (D / 64) * (D / 32), I2 = (D / 64) * (ODD_IN / 32), I3 = I1, IZ = EVEN_PAD - EVEN_IN;
    for (int it = gw; it < I0 + I1 + I2 + I3 + IZ; it += NGW) {
        int r = it;
        if (r < I0) { p0_transpose_item(a.in[I_EWIN], D, EVEN_IN, (bf16*)(ws + WS_WIN0), scr, r, lane); continue; } r -= I0;
        if (r < I1) { p0_transpose_item(a.in[I_EWOUT], D, D, (bf16*)(ws + WS_WOUT0), scr, r, lane); continue; } r -= I1;
        if (r < I2) { p0_transpose_item(a.in[I_OWIN], D, ODD_IN, (bf16*)(ws + WS_WIN1), scr, r, lane); continue; } r -= I2;
        if (r < I3) { p0_transpose_item(a.in[I_OWOUT], D, D, (bf16*)(ws + WS_WOUT1), scr, r, lane); continue; } r -= I3;
        { GAS v4u* o = (GAS v4u*)((bf16*)(ws + WS_WIN0) + (size_t)(EVEN_IN + r) * D); const v4u z = {0u, 0u, 0u, 0u}; o[lane] = z; o[lane + 64] = z; }
    }
    for (int idx = (vcu * NWAVES + wave) * 64 + lane; idx < 512 * 64; idx += G * NWAVES * 64) { const int n = idx >> 6, m = idx & 63;
        ((bf16*)(ws + WS_WUT))[idx] = (bf16)f2bf(a.in[I_EWUP][m * 512 + n]); ((bf16*)(ws + WS_AUT))[idx] = (bf16)f2bf(a.in[I_EAUP][m * 512 + n]); }
}

__device__ __forceinline__ void phase_adaln_rows(const float* xin, const float* g, const float* modl, bf16* XN, int lane, int wave, int vcu, int G) {
    const int gw = vcu * NWAVES + wave, NGW = G * NWAVES;
    for (int r0 = gw * 16; r0 < M; r0 += NGW * 16) {
        const int b = r0 >> 11;
        f32x4 gs[4], sh[4];
#pragma unroll
        for (int j = 0; j < 4; ++j) { const int c = 4 * lane + 256 * j;
            const f32x4 gg = *(const f32x4*)(g + c), sc = *(const f32x4*)(modl + (size_t)b * 3072 + 1024 + c);
            gs[j] = gg * (sc + 1.0f); sh[j] = *(const f32x4*)(modl + (size_t)b * 3072 + c); }
        for (int r = r0; r < r0 + 16; ++r) {
            const GAS f32x4* xr = (const GAS f32x4*)(xin + (size_t)r * D) + lane;
            f32x4 v[4]; float s = 0.f;
#pragma unroll
            for (int j = 0; j < 4; ++j) { v[j] = xr[64 * j]; s += (v[j].x * v[j].x + v[j].y * v[j].y) + (v[j].z * v[j].z + v[j].w * v[j].w); }
            const float rs = 1.0f / sqrtf(wave_sum(s) * (1.f / D) + 1e-6f);
            GAS unsigned long long* o8 = (GAS unsigned long long*)(XN + (size_t)r * D) + lane;
#pragma unroll
            for (int j = 0; j < 4; ++j) { const f32x4 o = v[j] * rs * gs[j] + sh[j];
                o8[64 * j] = (unsigned long long)pk2(o.x, o.y) | ((unsigned long long)pk2(o.z, o.w) << 32); }
        }
    }
}
__device__ __forceinline__ void phase_bias3(const Args& a, LAS unsigned char* lds, int tid, int lane, int wave, int vcu, int G) {
    if (vcu >= ODD_IN / 64) return;
    LAS float* shT = (LAS float*)lds;
    LAS float* part = (LAS float*)(lds + 65536);
    const float* mod1 = (const float*)(a.ws + WS_MOD) + 16 * 3072;
    __syncthreads();
    for (int idx = tid; idx < 16384; idx += 512) { const int b = idx >> 10, k = idx & 1023; shT[k * 16 + b] = mod1[(size_t)b * 3072 + k]; }
    __syncthreads();
    for (int it = vcu; it < ODD_IN / 64; it += G) {
        const int n0 = it * 64; const float* W = a.in[I_OWIN] + n0 + lane;
        float acc[16];
#pragma unroll
        for (int b = 0; b < 16; ++b) acc[b] = 0.f;
        const int kbeg = wave * 128;
#pragma unroll 32
        for (int k = kbeg; k < kbeg + 128; ++k) {
            const float w = W[(size_t)k * ODD_IN];
            const LAS f32x4* cv = (const LAS f32x4*)(shT + k * 16);
            const f32x4 c0 = cv[0], c1 = cv[1], c2 = cv[2], c3 = cv[3];
            acc[0] += c0[0] * w; acc[1] += c0[1] * w; acc[2] += c0[2] * w; acc[3] += c0[3] * w;
            acc[4] += c1[0] * w; acc[5] += c1[1] * w; acc[6] += c1[2] * w; acc[7] += c1[3] * w;
            acc[8] += c2[0] * w; acc[9] += c2[1] * w; acc[10] += c2[2] * w; acc[11] += c2[3] * w;
            acc[12] += c3[0] * w; acc[13] += c3[1] * w; acc[14] += c3[2] * w; acc[15] += c3[3] * w;
        }
#pragma unroll
        for (int b = 0; b < 16; ++b) part[(wave * 16 + b) * 64 + lane] = acc[b];
        __syncthreads();
        float* bias3 = (float*)(a.ws + WS_BIAS3);
#pragma unroll
        for (int q = 0; q < 2; ++q) { const int b = (tid >> 6) + 8 * q; float s = 0.f;
#pragma unroll
            for (int w8 = 0; w8 < 8; ++w8) s += part[(w8 * 16 + b) * 64 + lane];
            bias3[(size_t)b * ODD_IN + n0 + lane] = s; }
        __syncthreads();
    }
}
__device__ __forceinline__ void phase_final_rows(float* xio, const float* g, int lane, int wave, int vcu, int G) {
    const int gw = vcu * NWAVES + wave, NGW = G * NWAVES;
    f32x4 gs[4];
#pragma unroll
    for (int j = 0; j < 4; ++j) gs[j] = *(const f32x4*)(g + 4 * lane + 256 * j);
    for (int r = gw; r < M; r += NGW) {
        GAS f32x4* xr = (GAS f32x4*)(xio + (size_t)r * D) + lane;
        f32x4 v[4]; float s = 0.f;
#pragma unroll
        for (int j = 0; j < 4; ++j) { v[j] = xr[64 * j]; s += (v[j].x * v[j].x + v[j].y * v[j].y) + (v[j].z * v[j].z + v[j].w * v[j].w); }
        const float rs = 1.0f / sqrtf(wave_sum(s) * (1.f / D) + 1e-6f);
#pragma unroll
        for (int j = 0; j < 4; ++j) xr[64 * j] = v[j] * rs * gs[j];
    }
}

__device__ __forceinline__ void phase_rwkv(const Args& a, LAS unsigned char* lds, int tid, int lane, int wave, int vcu, int G) {
    const bf16* P = (const bf16*)(a.ws + WS_P); bf16* MIX = (bf16*)(a.ws + WS_MIX);
    LAS float* WUP = (LAS float*)lds;
    LAS float* AUP = WUP + 4096;
    LAS float* TW = AUP + 4096;
    LAS float* AL = TW + 2048;
    LAS float* Rr = AL + 2048;
    LAS float* KR = Rr + 2048;
    LAS float* Vv = KR + 2048;
    LAS float* Wd = Vv + 2048;
    LAS float* KK = Wd + 2048;
    LAS float* Bb = KK + 2048;
    LAS float* Yy = Bb + 2048;
    LAS float* BON = Yy + 2048;
    for (int unit = vcu; unit < BATCH * 8; unit += G) {
        const int b = unit >> 3, h = unit & 7;
        __syncthreads();
        for (int idx = tid; idx < 4096; idx += 512) { const int m = idx >> 6, j = idx & 63; WUP[idx] = a.in[I_EWUP][m * 512 + h * 64 + j]; AUP[idx] = a.in[I_EAUP][m * 512 + h * 64 + j]; }
        float S[8];
#pragma unroll
        for (int j = 0; j < 8; ++j) S[j] = 0.f;
        const int hj = h * 64 + lane;
        const float w0 = a.in[I_EW0][hj], a0 = a.in[I_EA0][hj], k_k = a.in[I_EKK][hj], k_a = a.in[I_EKA][hj], r_k = a.in[I_ERK][hj], lng = a.in[I_ELNXG][hj], lnb = a.in[I_ELNXB][hj];
        for (int ck = 0; ck < SEQ / 32; ++ck) {
            const int t0 = ck * 32;
            { const int i = tid >> 4, sub = tid & 15; const int t = t0 + i; const bf16* pc = P + (size_t)(b * SEQ + t) * EVEN_PAD; const bf16* pp = pc - EVEN_PAD; const bool hasp = t > 0;
#pragma unroll
              for (int grp = 0; grp < 5; ++grp) {
                  const int col = (grp == 0 ? C_R + h * 64 : grp == 1 ? C_K + h * 64 : grp == 2 ? C_V + h * 64 : grp == 3 ? C_WLO : C_ALO) + 4 * sub;
                  const uint2 cu = *(const uint2*)(pc + col); uint2 pu = {0u, 0u}; if (hasp) pu = *(const uint2*)(pp + col);
                  const f32x4 mu = *(const f32x4*)(a.in[I_EMU] + col);
                  float cv[4] = {bflo(cu.x), bfhi(cu.x), bflo(cu.y), bfhi(cu.y)}, pv[4] = {bflo(pu.x), bfhi(pu.x), bflo(pu.y), bfhi(pu.y)};
                  f32x4 xs;
#pragma unroll
                  for (int e = 0; e < 4; ++e) xs[e] = cv[e] + mu[e] * (pv[e] - cv[e]);
                  if (grp == 3) { xs[0] = tanhf(xs[0]); xs[1] = tanhf(xs[1]); xs[2] = tanhf(xs[2]); xs[3] = tanhf(xs[3]); }
                  LAS float* dst = (grp == 0 ? Rr : grp == 1 ? KR : grp == 2 ? Vv : grp == 3 ? TW : AL) + i * 64 + 4 * sub;
                  *(LAS f32x4*)dst = xs;
              } }
            __syncthreads();
            { float accw[4] = {0.f, 0.f, 0.f, 0.f}, acca[4] = {0.f, 0.f, 0.f, 0.f};
              for (int m4 = 0; m4 < 16; ++m4) {
                  f32x4 tw[4], al[4];
#pragma unroll
                  for (int q = 0; q < 4; ++q) { tw[q] = *(const LAS f32x4*)(TW + (wave + 8 * q) * 64 + 4 * m4); al[q] = *(const LAS f32x4*)(AL + (wave + 8 * q) * 64 + 4 * m4); }
#pragma unroll
                  for (int e = 0; e < 4; ++e) { const float wu = WUP[(4 * m4 + e) * 64 + lane], au = AUP[(4 * m4 + e) * 64 + lane];
#pragma unroll
                      for (int q = 0; q < 4; ++q) { accw[q] += tw[q][e] * wu; acca[q] += al[q][e] * au; } }
              }
#pragma unroll
              for (int q = 0; q < 4; ++q) { const int i = wave + 8 * q;
                  const float wv = w0 + accw[q];
                  const float nx = -wv; const float sp = fmaxf(nx, 0.f) + log1pf(__expf(-fabsf(nx)));
                  const float wl = -sp - 0.5f; const float decay = __expf(-__expf(wl));
                  const float av = 1.f / (1.f + __expf(-(a0 + acca[q])));
                  const float kraw = KR[i * 64 + lane]; const float kkv = kraw * k_k;
                  const float ss = wave_sum(kkv * kkv); const float kk = kkv / fmaxf(sqrtf(ss), 1e-12f);
                  const float kp = kraw * (1.f + (av - 1.f) * k_a);
                  const float bon = wave_sum(Rr[i * 64 + lane] * kp * r_k);
                  Wd[i * 64 + lane] = decay; KR[i * 64 + lane] = kp; KK[i * 64 + lane] = kk; Bb[i * 64 + lane] = kk * av; if (lane == 0) BON[i] = bon; } }
            __syncthreads();
            { const int row = wave * 8 + (lane >> 3), c8 = (lane & 7) * 8;
              for (int i = 0; i < 32; ++i) {
                  const f32x4 k0 = *(const LAS f32x4*)(KK + i * 64 + c8), k1 = *(const LAS f32x4*)(KK + i * 64 + c8 + 4);
                  const f32x4 w0v = *(const LAS f32x4*)(Wd + i * 64 + c8), w1v = *(const LAS f32x4*)(Wd + i * 64 + c8 + 4);
                  const f32x4 b0 = *(const LAS f32x4*)(Bb + i * 64 + c8), b1 = *(const LAS f32x4*)(Bb + i * 64 + c8 + 4);
                  const f32x4 p0 = *(const LAS f32x4*)(KR + i * 64 + c8), p1 = *(const LAS f32x4*)(KR + i * 64 + c8 + 4);
                  const f32x4 r0 = *(const LAS f32x4*)(Rr + i * 64 + c8), r1 = *(const LAS f32x4*)(Rr + i * 64 + c8 + 4);
                  const float vv = Vv[i * 64 + row];
                  float sa = (S[0] * k0[0] + S[1] * k0[1]) + (S[2] * k0[2] + S[3] * k0[3]) + (S[4] * k1[0] + S[5] * k1[1]) + (S[6] * k1[2] + S[7] * k1[3]);
                  sa += __shfl_xor(sa, 1); sa += __shfl_xor(sa, 2); sa += __shfl_xor(sa, 4); sa = -sa;
                  S[0] = S[0] * w0v[0] + sa * b0[0] + vv * p0[0]; S[1] = S[1] * w0v[1] + sa * b0[1] + vv * p0[1];
                  S[2] = S[2] * w0v[2] + sa * b0[2] + vv * p0[2]; S[3] = S[3] * w0v[3] + sa * b0[3] + vv * p0[3];
                  S[4] = S[4] * w1v[0] + sa * b1[0] + vv * p1[0]; S[5] = S[5] * w1v[1] + sa * b1[1] + vv * p1[1];
                  S[6] = S[6] * w1v[2] + sa * b1[2] + vv * p1[2]; S[7] = S[7] * w1v[3] + sa * b1[3] + vv * p1[3];
                  float y = (S[0] * r0[0] + S[1] * r0[1]) + (S[2] * r0[2] + S[3] * r0[3]) + (S[4] * r1[0] + S[5] * r1[1]) + (S[6] * r1[2] + S[7] * r1[3]);
                  y += __shfl_xor(y, 1); y += __shfl_xor(y, 2); y += __shfl_xor(y, 4);
                  if ((lane & 7) == 0) Yy[i * 64 + row] = y;
              } }
            __syncthreads();
#pragma unroll
            for (int q = 0; q < 4; ++q) { const int i = wave * 4 + q; const size_t rowg = (size_t)(b * SEQ + t0 + i);
                const float y = Yy[i * 64 + lane]; const float mean = wave_sum(y) * (1.f / 64.f); const float d = y - mean; const float var = wave_sum(d * d) * (1.f / 64.f);
                const float o = d * (1.0f / sqrtf(var + 64e-5f)) * lng + lnb + BON[i] * Vv[i * 64 + lane];
                const float z = bf2f(P[rowg * EVEN_PAD + C_Z0 + hj]);
                MIX[rowg * D + hj] = (bf16)f2bf(o * siluf(z)); }
            __syncthreads();
        }
    }
}

typedef unsigned u32x2 __attribute__((ext_vector_type(2)));
#define DPP_ADD(x, ctrl) x += __builtin_bit_cast(float, __builtin_amdgcn_update_dpp(0, __builtin_bit_cast(int, x), ctrl, 0xF, 0xF, true))
__device__ __forceinline__ float row_sum16(float x) { DPP_ADD(x, 0xB1); DPP_ADD(x, 0x4E); DPP_ADD(x, 0x124); DPP_ADD(x, 0x128); return x; }
__device__ __forceinline__ void split_bf(float x, unsigned& hi, unsigned& lo) { hi = f2bf(x); lo = f2bf(x - __builtin_bit_cast(float, hi << 16)); }
__device__ __forceinline__ float wave_sum_fast(float x) { x = row_sum16(x);
    const int xi = __builtin_bit_cast(int, x);
    return (__builtin_bit_cast(float, __builtin_amdgcn_readlane(xi, 0)) + __builtin_bit_cast(float, __builtin_amdgcn_readlane(xi, 16))) + (__builtin_bit_cast(float, __builtin_amdgcn_readlane(xi, 32)) + __builtin_bit_cast(float, __builtin_amdgcn_readlane(xi, 48))); }
__device__ __forceinline__ float fast_tanh(float x) { const float t = __expf(2.f * x); return 1.f - 2.f * __builtin_amdgcn_rcpf(t + 1.f); }
__device__ __forceinline__ void phase_rwkv2(const Args& a, LAS unsigned char* lds, int tid, int lane, int wave, int vcu, int G) {
    const bf16* P = (const bf16*)(a.ws + WS_P); float* YRAW = (float*)(a.ws + WS_YRAW); float* BONG = (float*)(a.ws + WS_BON);
    LAS float* Rr = (LAS float*)lds;
    LAS float* KR = Rr + 2048;
    LAS float* KK = KR + 2048;
    LAS float* Wd = KK + 2048;
    LAS float* Bb = Wd + 2048;
    LAS float* Vv = (LAS float*)(lds + 40960);
    LAS float* Yy = (LAS float*)(lds + 45056);
    LAS bf16* TWh = (LAS bf16*)(lds + 49152);
    LAS bf16* TWl = TWh + 32 * 72;
    LAS bf16* ALh = TWl + 32 * 72;
    LAS bf16* ALl = ALh + 32 * 72;
    LAS bf16* WUh = (LAS bf16*)(lds + 67584);
    LAS bf16* WUl = WUh + 64 * 72;
    LAS bf16* AUh = WUl + 64 * 72;
    LAS bf16* AUl = AUh + 64 * 72;
    for (int unit = vcu; unit < BATCH * 16; unit += G) {
        const int bh = unit >> 1, half = unit & 1, b = bh >> 3, h = bh & 7;
        __syncthreads();
        for (int idx = tid; idx < 4096; idx += 512) { const int m = idx >> 6, j = idx & 63; unsigned hi, lo;
            split_bf(a.in[I_EWUP][m * 512 + h * 64 + j], hi, lo); WUh[j * 72 + m] = (bf16)hi; WUl[j * 72 + m] = (bf16)lo;
            split_bf(a.in[I_EAUP][m * 512 + h * 64 + j], hi, lo); AUh[j * 72 + m] = (bf16)hi; AUl[j * 72 + m] = (bf16)lo; }
        float S[4] = {0.f, 0.f, 0.f, 0.f};
        const int hj = h * 64 + lane;
        const float w0 = a.in[I_EW0][hj], a0 = a.in[I_EA0][hj], k_k = a.in[I_EKK][hj], k_a = a.in[I_EKA][hj], r_k = a.in[I_ERK][hj];
        const int c4 = (lane & 15) * 4, rowl = wave * 4 + (lane >> 4);
        const int i1 = tid >> 4, sub = tid & 15;
        const int col0 = C_R + h * 64 + 4 * sub, col1 = C_K + h * 64 + 4 * sub, col2 = C_V + h * 64 + 4 * sub, col3 = C_WLO + 4 * sub, col4 = C_ALO + 4 * sub;
        const f32x4 mu0 = *(const f32x4*)(a.in[I_EMU] + col0), mu1 = *(const f32x4*)(a.in[I_EMU] + col1), mu2 = *(const f32x4*)(a.in[I_EMU] + col2), mu3 = *(const f32x4*)(a.in[I_EMU] + col3), mu4 = *(const f32x4*)(a.in[I_EMU] + col4);
        const bf16* prow = P + (size_t)(b * SEQ + i1) * EVEN_PAD;
        u32x2 c0v, c1v, c2v, c3v, c4v, p0v, p1v, p2v, p3v, p4v;
#define RW_PREFETCH(t0_) do { const bf16* pc_ = prow + (size_t)(t0_) * EVEN_PAD; \
            c0v = *(const u32x2*)(pc_ + col0); c1v = *(const u32x2*)(pc_ + col1); c2v = *(const u32x2*)(pc_ + col2); c3v = *(const u32x2*)(pc_ + col3); c4v = *(const u32x2*)(pc_ + col4); \
            if ((t0_) + i1 > 0) { const bf16* pp_ = pc_ - EVEN_PAD; p0v = *(const u32x2*)(pp_ + col0); p1v = *(const u32x2*)(pp_ + col1); p2v = *(const u32x2*)(pp_ + col2); p3v = *(const u32x2*)(pp_ + col3); p4v = *(const u32x2*)(pp_ + col4); } \
            else { p0v = (u32x2){0u, 0u}; p1v = p0v; p2v = p0v; p3v = p0v; p4v = p0v; } } while (0)
#define RW_XS(cv_, pv_, mu_) ({ f32x4 x_; const float a0_ = bflo(cv_.x), a1_ = bfhi(cv_.x), a2_ = bflo(cv_.y), a3_ = bfhi(cv_.y); \
            x_[0] = a0_ + mu_[0] * (bflo(pv_.x) - a0_); x_[1] = a1_ + mu_[1] * (bfhi(pv_.x) - a1_); x_[2] = a2_ + mu_[2] * (bflo(pv_.y) - a2_); x_[3] = a3_ + mu_[3] * (bfhi(pv_.y) - a3_); x_; })
        RW_PREFETCH(0);
        for (int ck = 0; ck < SEQ / 32; ++ck) {
            const int t0 = ck * 32;
            { *(LAS f32x4*)(Rr + i1 * 64 + 4 * sub) = RW_XS(c0v, p0v, mu0);
              *(LAS f32x4*)(KR + i1 * 64 + 4 * sub) = RW_XS(c1v, p1v, mu1);
              { const f32x4 xv = RW_XS(c2v, p2v, mu2); if ((sub >> 3) == half) *(LAS f32x4*)(Vv + i1 * 32 + 4 * (sub & 7)) = xv; }
              { f32x4 xs = RW_XS(c3v, p3v, mu3); xs[0] = fast_tanh(xs[0]); xs[1] = fast_tanh(xs[1]); xs[2] = fast_tanh(xs[2]); xs[3] = fast_tanh(xs[3]);
                unsigned h0, l0, h1, l1, h2, l2, h3, l3; split_bf(xs[0], h0, l0); split_bf(xs[1], h1, l1); split_bf(xs[2], h2, l2); split_bf(xs[3], h3, l3);
                u32x2 hv, lv; hv.x = h0 | (h1 << 16); hv.y = h2 | (h3 << 16); lv.x = l0 | (l1 << 16); lv.y = l2 | (l3 << 16);
                *(LAS u32x2*)(TWh + i1 * 72 + 4 * sub) = hv; *(LAS u32x2*)(TWl + i1 * 72 + 4 * sub) = lv; }
              { const f32x4 xs = RW_XS(c4v, p4v, mu4);
                unsigned h0, l0, h1, l1, h2, l2, h3, l3; split_bf(xs[0], h0, l0); split_bf(xs[1], h1, l1); split_bf(xs[2], h2, l2); split_bf(xs[3], h3, l3);
                u32x2 hv, lv; hv.x = h0 | (h1 << 16); hv.y = h2 | (h3 << 16); lv.x = l0 | (l1 << 16); lv.y = l2 | (l3 << 16);
                *(LAS u32x2*)(ALh + i1 * 72 + 4 * sub) = hv; *(LAS u32x2*)(ALl + i1 * 72 + 4 * sub) = lv; } }
            if (ck + 1 < SEQ / 32) RW_PREFETCH(t0 + 32);
            __syncthreads();
            { const int mi = wave >> 2, ni = wave & 3, fr = lane & 15, fq = lane >> 4;
              f32x4 accw = {0.f, 0.f, 0.f, 0.f}, acca = {0.f, 0.f, 0.f, 0.f};
#pragma unroll
              for (int ks = 0; ks < 2; ++ks) { const int ao = (16 * mi + fr) * 72 + 32 * ks + 8 * fq, bo = (16 * ni + fr) * 72 + 32 * ks + 8 * fq;
                  const bf16x8 ah = *(const LAS bf16x8*)(TWh + ao), al = *(const LAS bf16x8*)(TWl + ao), bh_ = *(const LAS bf16x8*)(WUh + bo), bl = *(const LAS bf16x8*)(WUl + bo);
                  accw = __builtin_amdgcn_mfma_f32_16x16x32_bf16(ah, bh_, accw, 0, 0, 0); accw = __builtin_amdgcn_mfma_f32_16x16x32_bf16(ah, bl, accw, 0, 0, 0); accw = __builtin_amdgcn_mfma_f32_16x16x32_bf16(al, bh_, accw, 0, 0, 0);
                  const bf16x8 ch = *(const LAS bf16x8*)(ALh + ao), cl = *(const LAS bf16x8*)(ALl + ao), dh = *(const LAS bf16x8*)(AUh + bo), dl = *(const LAS bf16x8*)(AUl + bo);
                  acca = __builtin_amdgcn_mfma_f32_16x16x32_bf16(ch, dh, acca, 0, 0, 0); acca = __builtin_amdgcn_mfma_f32_16x16x32_bf16(ch, dl, acca, 0, 0, 0); acca = __builtin_amdgcn_mfma_f32_16x16x32_bf16(cl, dh, acca, 0, 0, 0); }
#pragma unroll
              for (int rg = 0; rg < 4; ++rg) { Wd[(16 * mi + 4 * fq + rg) * 64 + 16 * ni + fr] = accw[rg]; Bb[(16 * mi + 4 * fq + rg) * 64 + 16 * ni + fr] = acca[rg]; } }
            __syncthreads();
#pragma unroll
            for (int q = 0; q < 4; ++q) { const int i = wave + 8 * q;
                const float nx = -(w0 + Wd[i * 64 + lane]); const float sp = fmaxf(nx, 0.f) + __logf(1.f + __expf(-fabsf(nx)));
                const float decay = __expf(-__expf(-sp - 0.5f));
                const float av = __builtin_amdgcn_rcpf(1.f + __expf(-(a0 + Bb[i * 64 + lane])));
                const float kraw = KR[i * 64 + lane]; const float kkv = kraw * k_k;
                const float ss = wave_sum_fast(kkv * kkv); const float kk = kkv * __builtin_amdgcn_rsqf(fmaxf(ss, 1e-24f));
                const float kp = kraw * (1.f + (av - 1.f) * k_a);
                const float bon = wave_sum_fast(Rr[i * 64 + lane] * kp * r_k);
                Wd[i * 64 + lane] = decay; KR[i * 64 + lane] = kp; KK[i * 64 + lane] = kk; Bb[i * 64 + lane] = kk * av;
                if (half == 0 && lane == 0) BONG[(size_t)(b * SEQ + t0 + i) * 8 + h] = bon; }
            __syncthreads();
            { f32x4 kk4 = *(const LAS f32x4*)(KK + c4), w4 = *(const LAS f32x4*)(Wd + c4), b4 = *(const LAS f32x4*)(Bb + c4), k4 = *(const LAS f32x4*)(KR + c4), r4 = *(const LAS f32x4*)(Rr + c4);
              float vv = Vv[rowl];
#pragma unroll 4
              for (int i = 0; i < 32; ++i) {
                const int in = (i + 1) & 31;
                const f32x4 nkk = *(const LAS f32x4*)(KK + in * 64 + c4), nw = *(const LAS f32x4*)(Wd + in * 64 + c4), nb = *(const LAS f32x4*)(Bb + in * 64 + c4), nk = *(const LAS f32x4*)(KR + in * 64 + c4), nr = *(const LAS f32x4*)(Rr + in * 64 + c4);
                const float nv = Vv[in * 32 + rowl];
                float sa = (S[0] * kk4[0] + S[1] * kk4[1]) + (S[2] * kk4[2] + S[3] * kk4[3]);
                const float p0 = S[0] * w4[0] + vv * k4[0], p1 = S[1] * w4[1] + vv * k4[1], p2 = S[2] * w4[2] + vv * k4[2], p3 = S[3] * w4[3] + vv * k4[3];
                sa = -row_sum16(sa);
                S[0] = sa * b4[0] + p0; S[1] = sa * b4[1] + p1; S[2] = sa * b4[2] + p2; S[3] = sa * b4[3] + p3;
                float y = (S[0] * r4[0] + S[1] * r4[1]) + (S[2] * r4[2] + S[3] * r4[3]);
                y = row_sum16(y);
                Yy[i * 32 + rowl] = y;
                kk4 = nkk; w4 = nw; b4 = nb; k4 = nk; r4 = nr; vv = nv;
              } }
            __syncthreads();
            for (int idx = tid; idx < 1024; idx += 512) { const int i = idx >> 5, rl = idx & 31; YRAW[(size_t)(b * SEQ + t0 + i) * 512 + h * 64 + half * 32 + rl] = Yy[idx]; }
        }
#undef RW_PREFETCH
#undef RW_XS
    }
}
__device__ __forceinline__ void phase_finish(const Args& a, int lane, int wave, int vcu, int G) {
    const bf16* P = (const bf16*)(a.ws + WS_P); bf16* MIX = (bf16*)(a.ws + WS_MIX); const float* YRAW = (const float*)(a.ws + WS_YRAW); const float* BONG = (const float*)(a.ws + WS_BON);
    const int gw = vcu * NWAVES + wave, NGW = G * NWAVES; const int c0 = 8 * lane;
    const f32x4 g0 = *(const f32x4*)(a.in[I_ELNXG] + c0), g1 = *(const f32x4*)(a.in[I_ELNXG] + c0 + 4), e0 = *(const f32x4*)(a.in[I_ELNXB] + c0), e1 = *(const f32x4*)(a.in[I_ELNXB] + c0 + 4);
    const f32x4 m0 = *(const f32x4*)(a.in[I_EMU] + C_V + c0), m1 = *(const f32x4*)(a.in[I_EMU] + C_V + c0 + 4);
    for (int row = gw; row < M; row += NGW) {
        const f32x4 y0 = *(const f32x4*)(YRAW + (size_t)row * 512 + c0), y1 = *(const f32x4*)(YRAW + (size_t)row * 512 + c0 + 4);
        float y[8] = {y0[0], y0[1], y0[2], y0[3], y1[0], y1[1], y1[2], y1[3]};
        float s = 0.f;
#pragma unroll
        for (int e = 0; e < 8; ++e) s += y[e];
        s += __shfl_xor(s, 1); s += __shfl_xor(s, 2); s += __shfl_xor(s, 4); const float mean = s * (1.f / 64.f); float q = 0.f;
#pragma unroll
        for (int e = 0; e < 8; ++e) { y[e] -= mean; q += y[e] * y[e]; }
        q += __shfl_xor(q, 1); q += __shfl_xor(q, 2); q += __shfl_xor(q, 4); const float rstd = 1.0f / sqrtf(q * (1.f / 64.f) + 64e-5f);
        const bf16* pc = P + (size_t)row * EVEN_PAD; const v4u cu = *(const v4u*)(pc + C_V + c0); v4u pu = {0u, 0u, 0u, 0u}; if ((row & (SEQ - 1)) != 0) pu = *(const v4u*)(pc - EVEN_PAD + C_V + c0);
        const v4u zu = *(const v4u*)(pc + C_Z0 + c0);
        const float cv[8] = {bflo(cu.x), bfhi(cu.x), bflo(cu.y), bfhi(cu.y), bflo(cu.z), bfhi(cu.z), bflo(cu.w), bfhi(cu.w)};
        const float pv[8] = {bflo(pu.x), bfhi(pu.x), bflo(pu.y), bfhi(pu.y), bflo(pu.z), bfhi(pu.z), bflo(pu.w), bfhi(pu.w)};
        const float zz[8] = {bflo(zu.x), bfhi(zu.x), bflo(zu.y), bfhi(zu.y), bflo(zu.z), bfhi(zu.z), bflo(zu.w), bfhi(zu.w)};
        const float mu[8] = {m0[0], m0[1], m0[2], m0[3], m1[0], m1[1], m1[2], m1[3]}, gg[8] = {g0[0], g0[1], g0[2], g0[3], g1[0], g1[1], g1[2], g1[3]}, ee[8] = {e0[0], e0[1], e0[2], e0[3], e1[0], e1[1], e1[2], e1[3]};
        const float bon = BONG[(size_t)row * 8 + (lane >> 3)];
        float o[8];
#pragma unroll
        for (int e = 0; e < 8; ++e) { const float v = cv[e] + mu[e] * (pv[e] - cv[e]); o[e] = (y[e] * rstd * gg[e] + ee[e] + bon * v) * siluf(zz[e]); }
        v4u w; w.x = pk2(o[0], o[1]); w.y = pk2(o[2], o[3]); w.z = pk2(o[4], o[5]); w.w = pk2(o[6], o[7]);
        *(v4u*)(MIX + (size_t)row * D + c0) = w;
    }
}
__device__ __forceinline__ void phase_gmlp(const Args& a, LAS unsigned char* lds, int tid, int lane, int wave, int vcu, int G) {
    const bf16* P = (const bf16*)(a.ws + WS_P); bf16* MIX = (bf16*)(a.ws + WS_MIX);
    LAS float* WS = (LAS float*)lds;
    LAS float* VLN = (LAS float*)(lds + 128 * 129 * 4);
    int gload = -1;
    for (int u = vcu; u < BATCH * 16 * 8; u += G) {
        const int b = u >> 7, ck = (u >> 3) & 15, g = u & 7;
        __syncthreads();
        if (g != gload) { for (int idx = tid; idx < 16384; idx += 512) WS[(idx >> 7) * 129 + (idx & 127)] = a.in[I_ESGW][(size_t)g * 16384 + idx]; gload = g; }
        const int i = tid >> 2, sub = tid & 3; const size_t rowg = (size_t)(b * SEQ + ck * 128 + i);
        { const v4u q0 = *(const v4u*)(P + rowg * EVEN_PAD + C_VG + g * 64 + sub * 16), q1 = *(const v4u*)(P + rowg * EVEN_PAD + C_VG + g * 64 + sub * 16 + 8);
          float v[16] = {bflo(q0.x), bfhi(q0.x), bflo(q0.y), bfhi(q0.y), bflo(q0.z), bfhi(q0.z), bflo(q0.w), bfhi(q0.w), bflo(q1.x), bfhi(q1.x), bflo(q1.y), bfhi(q1.y), bflo(q1.z), bfhi(q1.z), bflo(q1.w), bfhi(q1.w)};
          float s = 0.f;
#pragma unroll
          for (int e = 0; e < 16; ++e) s += v[e];
          s += __shfl_xor(s, 1); s += __shfl_xor(s, 2); const float mean = s * (1.f / 64.f); float q = 0.f;
#pragma unroll
          for (int e = 0; e < 16; ++e) { v[e] -= mean; q += v[e] * v[e]; }
          q += __shfl_xor(q, 1); q += __shfl_xor(q, 2); const float rstd = 1.0f / sqrtf(q * (1.f / 64.f) + 1e-5f);
#pragma unroll
          for (int e = 0; e < 16; ++e) VLN[i * 64 + sub * 16 + e] = v[e] * rstd * a.in[I_ESGLNG][g * 64 + sub * 16 + e] + a.in[I_ESGLNB][g * 64 + sub * 16 + e]; }
        __syncthreads();
        float acc[16];
#pragma unroll
        for (int e = 0; e < 16; ++e) acc[e] = 0.f;
        const int smax = wave * 16 + 16;
        for (int s = 0; s < smax; ++s) {
            const float w = (s <= i) ? WS[i * 129 + s] : 0.f;
            const f32x4 v0 = *(const LAS f32x4*)(VLN + s * 64 + sub * 16), v1 = *(const LAS f32x4*)(VLN + s * 64 + sub * 16 + 4), v2 = *(const LAS f32x4*)(VLN + s * 64 + sub * 16 + 8), v3 = *(const LAS f32x4*)(VLN + s * 64 + sub * 16 + 12);
#pragma unroll
            for (int e = 0; e < 4; ++e) { acc[e] += w * v0[e]; acc[4 + e] += w * v1[e]; acc[8 + e] += w * v2[e]; acc[12 + e] += w * v3[e]; }
        }
        const float bs = a.in[I_ESGB][g * 128 + i];
        const v4u u0 = *(const v4u*)(P + rowg * EVEN_PAD + C_U + g * 64 + sub * 16), u1 = *(const v4u*)(P + rowg * EVEN_PAD + C_U + g * 64 + sub * 16 + 8);
        const v4u z0 = *(const v4u*)(P + rowg * EVEN_PAD + C_Z0 + 512 + g * 64 + sub * 16), z1 = *(const v4u*)(P + rowg * EVEN_PAD + C_Z0 + 512 + g * 64 + sub * 16 + 8);
        const float uu[16] = {bflo(u0.x), bfhi(u0.x), bflo(u0.y), bfhi(u0.y), bflo(u0.z), bfhi(u0.z), bflo(u0.w), bfhi(u0.w), bflo(u1.x), bfhi(u1.x), bflo(u1.y), bfhi(u1.y), bflo(u1.z), bfhi(u1.z), bflo(u1.w), bfhi(u1.w)};
        const float zz[16] = {bflo(z0.x), bfhi(z0.x), bflo(z0.y), bfhi(z0.y), bflo(z0.z), bfhi(z0.z), bflo(z0.w), bfhi(z0.w), bflo(z1.x), bfhi(z1.x), bflo(z1.y), bfhi(z1.y), bflo(z1.z), bfhi(z1.z), bflo(z1.w), bfhi(z1.w)};
        float o[16];
#pragma unroll
        for (int e = 0; e < 16; ++e) o[e] = uu[e] * (acc[e] + bs) * siluf(zz[e]);
        v4u w0, w1; w0.x = pk2(o[0], o[1]); w0.y = pk2(o[2], o[3]); w0.z = pk2(o[4], o[5]); w0.w = pk2(o[6], o[7]); w1.x = pk2(o[8], o[9]); w1.y = pk2(o[10], o[11]); w1.z = pk2(o[12], o[13]); w1.w = pk2(o[14], o[15]);
        *(v4u*)(MIX + rowg * D + 512 + g * 64 + sub * 16) = w0; *(v4u*)(MIX + rowg * D + 512 + g * 64 + sub * 16 + 8) = w1;
    }
}

__device__ __forceinline__ void phase_swa(const Args& a, LAS unsigned char* lds, int tid, int lane, int wave, int vcu, int G) {
    const bf16* P = (const bf16*)(a.ws + WS_P); bf16* MIX = (bf16*)(a.ws + WS_MIX);
    LAS unsigned* KB = (LAS unsigned*)lds;
    LAS unsigned* VB = KB + 256 * 33;
    for (int u = vcu; u < BATCH * 16 * 2; u += G) {
        const int b = u >> 5, n = (u >> 1) & 15, kvh = u & 1;
        __syncthreads();
        { const int kr = tid >> 1, half = tid & 1; const int tk = n * 128 - 128 + kr;
          v4u kq[4], vq[4];
#pragma unroll
          for (int e = 0; e < 4; ++e) { kq[e] = (v4u){0u, 0u, 0u, 0u}; vq[e] = kq[e]; }
          if (tk >= 0) { const bf16* pr = P + (size_t)(b * SEQ + tk) * ODD_IN;
#pragma unroll
              for (int e = 0; e < 4; ++e) { kq[e] = *(const v4u*)(pr + C_KC + kvh * 64 + half * 32 + e * 8); vq[e] = *(const v4u*)(pr + C_VC + kvh * 64 + half * 32 + e * 8); } }
#pragma unroll
          for (int e = 0; e < 4; ++e) { LAS unsigned* kd = KB + kr * 33 + half * 16 + e * 4; kd[0] = kq[e].x; kd[1] = kq[e].y; kd[2] = kq[e].z; kd[3] = kq[e].w;
              LAS unsigned* vd = VB + kr * 33 + half * 16 + e * 4; vd[0] = vq[e].x; vd[1] = vq[e].y; vd[2] = vq[e].z; vd[3] = vq[e].w; } }
        __syncthreads();
        for (int pass = 0; pass < 2; ++pass) {
            const int gq = (tid >> 7) + 4 * pass, qi = tid & 127, h = kvh * 8 + gq; const size_t rowg = (size_t)(b * SEQ + n * 128 + qi);
            float q[64], o[64];
#pragma unroll
            for (int e = 0; e < 8; ++e) { const v4u w = *(const v4u*)(P + rowg * ODD_IN + C_Q + h * 64 + e * 8);
                q[8 * e + 0] = bflo(w.x) * 0.125f; q[8 * e + 1] = bfhi(w.x) * 0.125f; q[8 * e + 2] = bflo(w.y) * 0.125f; q[8 * e + 3] = bfhi(w.y) * 0.125f;
                q[8 * e + 4] = bflo(w.z) * 0.125f; q[8 * e + 5] = bfhi(w.z) * 0.125f; q[8 * e + 6] = bflo(w.w) * 0.125f; q[8 * e + 7] = bfhi(w.w) * 0.125f; }
#pragma unroll
            for (int e = 0; e < 64; ++e) o[e] = 0.f;
            const float slope = exp2f(-0.5f * (float)(h + 1));
            float mrun = a.in[I_OSINKS][h], lrun = 1.f;
            for (int j = 0; j < 128; ++j) {
                const int kr = qi + 1 + j; const bool valid = (n > 0) || (kr >= 128);
                const LAS unsigned* kp = KB + kr * 33;
                float s0 = 0.f, s1 = 0.f;
#pragma unroll
                for (int e = 0; e < 32; ++e) { const unsigned w = kp[e]; s0 += q[2 * e] * bflo(w); s1 += q[2 * e + 1] * bfhi(w); }
                const float s = (s0 + s1) - slope * (float)(127 - j);
                const float mn = valid ? fmaxf(mrun, s) : mrun;
                const float alpha = __expf(mrun - mn); const float p = valid ? __expf(s - mn) : 0.f;
                lrun = lrun * alpha + p; mrun = mn;
                const LAS unsigned* vp = VB + kr * 33;
#pragma unroll
                for (int e = 0; e < 32; ++e) { const unsigned w = vp[e]; o[2 * e] = o[2 * e] * alpha + p * bflo(w); o[2 * e + 1] = o[2 * e + 1] * alpha + p * bfhi(w); }
            }
            const float il = 1.f / lrun;
#pragma unroll
            for (int e = 0; e < 8; ++e) { const v4u zw = *(const v4u*)(P + rowg * ODD_IN + C_Z1 + h * 64 + e * 8);
                v4u w; w.x = pk2(o[8 * e + 0] * il * siluf(bflo(zw.x)), o[8 * e + 1] * il * siluf(bfhi(zw.x))); w.y = pk2(o[8 * e + 2] * il * siluf(bflo(zw.y)), o[8 * e + 3] * il * siluf(bfhi(zw.y)));
                w.z = pk2(o[8 * e + 4] * il * siluf(bflo(zw.z)), o[8 * e + 5] * il * siluf(bfhi(zw.z))); w.w = pk2(o[8 * e + 6] * il * siluf(bflo(zw.w)), o[8 * e + 7] * il * siluf(bfhi(zw.w)));
                *(v4u*)(MIX + rowg * D + h * 64 + e * 8) = w; }
        }
    }
}


typedef float f32x16 __attribute__((ext_vector_type(16)));
__device__ __forceinline__ int crow(int r, int hi) { return (r & 3) + 8 * (r >> 2) + 4 * hi; }
typedef float f32x2_t __attribute__((ext_vector_type(2))); typedef __bf16 bf16x2_t __attribute__((ext_vector_type(2)));
__device__ __forceinline__ unsigned cvtpk(float lo, float hi) { f32x2_t v = {lo, hi}; bf16x2_t b = __builtin_convertvector(v, bf16x2_t); return __builtin_bit_cast(unsigned, b); }
__device__ __forceinline__ void phase_swa2(const Args& a, LAS unsigned char* lds, int tid, int lane, int wave, int vcu, int G) {
    const bf16* P = (const bf16*)(a.ws + WS_P); bf16* MIX = (bf16*)(a.ws + WS_MIX);
    LAS bf16* Kl = (LAS bf16*)lds;
    LAS bf16* Vt = (LAS bf16*)(lds + 36864);
    const int l31 = lane & 31, hi = lane >> 5;
    for (int u = vcu; u < BATCH * 16 * 2; u += G) {
        const int b = u >> 5, n = (u >> 1) & 15, kvh = u & 1;
        __syncthreads();
        { const int key = tid >> 1, half = tid & 1; const int tk = n * 128 - 128 + key;
          v4u kq[4];
#pragma unroll
          for (int e = 0; e < 4; ++e) kq[e] = (v4u){0u, 0u, 0u, 0u};
          if (tk >= 0) { const bf16* pr = P + (size_t)(b * SEQ + tk) * ODD_IN + C_KC + kvh * 64 + half * 32;
#pragma unroll
              for (int e = 0; e < 4; ++e) kq[e] = *(const v4u*)(pr + e * 8); }
#pragma unroll
          for (int e = 0; e < 4; ++e) *(LAS v4u*)(Kl + key * 72 + half * 32 + e * 8) = kq[e]; }
        { const int key = tid & 255, dh = tid >> 8; const int tk = n * 128 - 128 + key;
          v4u vq[4];
#pragma unroll
          for (int e = 0; e < 4; ++e) vq[e] = (v4u){0u, 0u, 0u, 0u};
          if (tk >= 0) { const bf16* pr = P + (size_t)(b * SEQ + tk) * ODD_IN + C_VC + kvh * 64 + dh * 32;
#pragma unroll
              for (int e = 0; e < 4; ++e) vq[e] = *(const v4u*)(pr + e * 8); }
#pragma unroll
          for (int e = 0; e < 4; ++e) { LAS bf16* vd = Vt + (dh * 32 + e * 8) * 260 + key;
              vd[0 * 260] = (bf16)(vq[e].x & 0xffffu); vd[1 * 260] = (bf16)(vq[e].x >> 16); vd[2 * 260] = (bf16)(vq[e].y & 0xffffu); vd[3 * 260] = (bf16)(vq[e].y >> 16);
              vd[4 * 260] = (bf16)(vq[e].z & 0xffffu); vd[5 * 260] = (bf16)(vq[e].z >> 16); vd[6 * 260] = (bf16)(vq[e].w & 0xffffu); vd[7 * 260] = (bf16)(vq[e].w >> 16); } }
        __syncthreads();
        const int h = kvh * 8 + wave;
        const float slope = exp2f(-0.5f * (float)(h + 1)), sink = a.in[I_OSINKS][h];
#pragma unroll 1
        for (int i = 0; i < 4; ++i) {
            const size_t rowq = (size_t)(b * SEQ + n * 128 + 32 * i + l31);
            bf16x8 qf[4];
#pragma unroll
            for (int ks = 0; ks < 4; ++ks) qf[ks] = *(const bf16x8*)(P + rowq * ODD_IN + C_Q + h * 64 + 16 * ks + 8 * hi);
            f32x16 st[5];
#pragma unroll
            for (int tt = 0; tt < 5; ++tt) { f32x16 acc = {0.f, 0.f, 0.f, 0.f, 0.f, 0.f, 0.f, 0.f, 0.f, 0.f, 0.f, 0.f, 0.f, 0.f, 0.f, 0.f};
#pragma unroll
                for (int ks = 0; ks < 4; ++ks) { const bf16x8 kf = *(const LAS bf16x8*)(Kl + (32 * (i + tt) + l31) * 72 + 16 * ks + 8 * hi);
                    acc = __builtin_amdgcn_mfma_f32_32x32x16_bf16(kf, qf[ks], acc, 0, 0, 0); }
                st[tt] = acc; }
            int lbv = l31 - 4 * hi; float sbv = -slope * (float)(l31 + 128 - 4 * hi);
            asm volatile("" : "+v"(lbv), "+v"(sbv));
            float mx = sink;
#pragma unroll
            for (int tt = 0; tt < 5; ++tt) { const bool tile_ok = (n > 0) || (i + tt >= 4);
#pragma unroll
                for (int r = 0; r < 16; ++r) { const int cr = (r & 3) + 8 * (r >> 2);
                    float s = fmaf(st[tt][r], 0.125f, sbv); s = fmaf(slope, (float)(32 * tt + cr), s);
                    if (tt == 0) s = (cr > lbv) ? s : -INFINITY;
                    if (tt == 4) s = (cr <= lbv) ? s : -INFINITY;
                    s = tile_ok ? s : -INFINITY;
                    st[tt][r] = s; mx = fmaxf(mx, s); } }
            { auto rr = __builtin_amdgcn_permlane32_swap(__float_as_uint(mx), __float_as_uint(mx), false, false); mx = fmaxf(__uint_as_float(rr[0]), __uint_as_float(rr[1])); }
            float ls = 0.f;
#pragma unroll
            for (int tt = 0; tt < 5; ++tt)
#pragma unroll
                for (int r = 0; r < 16; ++r) { const float p = __expf(st[tt][r] - mx); st[tt][r] = p; ls += p; }
            { auto rr = __builtin_amdgcn_permlane32_swap(__float_as_uint(ls), __float_as_uint(ls), false, false); ls = __uint_as_float(rr[0]) + __uint_as_float(rr[1]); }
            const float inv = 1.f / (ls + __expf(sink - mx));
            f32x16 o[2];
#pragma unroll
            for (int dt = 0; dt < 2; ++dt) o[dt] = (f32x16){0.f, 0.f, 0.f, 0.f, 0.f, 0.f, 0.f, 0.f, 0.f, 0.f, 0.f, 0.f, 0.f, 0.f, 0.f, 0.f};
#pragma unroll
            for (int tt = 0; tt < 5; ++tt)
#pragma unroll
                for (int s2 = 0; s2 < 2; ++s2) {
                    v4u pw; pw.x = cvtpk(st[tt][8 * s2 + 0] * inv, st[tt][8 * s2 + 1] * inv); pw.y = cvtpk(st[tt][8 * s2 + 2] * inv, st[tt][8 * s2 + 3] * inv);
                    pw.z = cvtpk(st[tt][8 * s2 + 4] * inv, st[tt][8 * s2 + 5] * inv); pw.w = cvtpk(st[tt][8 * s2 + 6] * inv, st[tt][8 * s2 + 7] * inv);
                    const bf16x8 pa = __builtin_bit_cast(bf16x8, pw);
                    const int kb = 32 * (i + tt) + 16 * s2 + 4 * hi;
#pragma unroll
                    for (int dt = 0; dt < 2; ++dt) { const LAS bf16* vp = Vt + (dt * 32 + l31) * 260 + kb;
                        const u32x2 v0 = *(const LAS u32x2*)vp, v1 = *(const LAS u32x2*)(vp + 8);
                        v4u vw; vw.x = v0.x; vw.y = v0.y; vw.z = v1.x; vw.w = v1.y;
                        o[dt] = __builtin_amdgcn_mfma_f32_32x32x16_bf16(pa, __builtin_bit_cast(bf16x8, vw), o[dt], 0, 0, 0); } }
#pragma unroll
            for (int dt = 0; dt < 2; ++dt)
#pragma unroll
                for (int r = 0; r < 16; ++r) { const size_t row = (size_t)(b * SEQ + n * 128 + 32 * i + crow(r, hi)); const int d = h * 64 + dt * 32 + l31;
                    const float z = bf2f(P[row * ODD_IN + C_Z1 + d]);
                    MIX[row * D + d] = (bf16)f2bf(o[dt][r] * siluf(z)); if ((r & 3) == 3) asm volatile("" ::: "memory"); }
        }
    }
}

__device__ __forceinline__ void phase_gmlp2(const Args& a, LAS unsigned char* lds, int tid, int lane, int wave, int vcu, int G) {
    const bool paired = (G == 256); const int n_units = paired ? ((vcu & 1) ? 14 : 2) : 8;
    const bf16* P = (const bf16*)(a.ws + WS_P); bf16* MIX = (bf16*)(a.ws + WS_MIX);
    LAS bf16* Wl = (LAS bf16*)lds;
    LAS bf16* Vn = (LAS bf16*)(lds + 34816);
    const int l31 = lane & 31, hi = lane >> 5;
    int gload = -1;
    for (int it = 0; it < n_units; ++it) {
        const int u = !paired ? vcu + G * it : (it < 8 && (vcu & 1)) ? vcu + 256 * it : (vcu & 1) ? (vcu - 1) + 256 * (it - 6) : vcu + 256 * it;
        if (u >= BATCH * 16 * 8) break;
        const int b = u >> 7, ck = (u >> 3) & 15, g = u & 7;
        __syncthreads();
        if (g != gload) { for (int idx = tid; idx < 16384; idx += 512) { const int t = idx >> 7, s = idx & 127; const float w = a.in[I_ESGW][(size_t)g * 16384 + idx]; Wl[t * 136 + s] = (bf16)f2bf(s <= t ? w : 0.f); } gload = g; }
        { const int i = tid >> 2, sub = tid & 3; const size_t rowg = (size_t)(b * SEQ + ck * 128 + i);
          const v4u q0 = *(const v4u*)(P + rowg * EVEN_PAD + C_VG + g * 64 + sub * 16), q1 = *(const v4u*)(P + rowg * EVEN_PAD + C_VG + g * 64 + sub * 16 + 8);
          float v[16] = {bflo(q0.x), bfhi(q0.x), bflo(q0.y), bfhi(q0.y), bflo(q0.z), bfhi(q0.z), bflo(q0.w), bfhi(q0.w), bflo(q1.x), bfhi(q1.x), bflo(q1.y), bfhi(q1.y), bflo(q1.z), bfhi(q1.z), bflo(q1.w), bfhi(q1.w)};
          float s = 0.f;
#pragma unroll
          for (int e = 0; e < 16; ++e) s += v[e];
          s += __shfl_xor(s, 1); s += __shfl_xor(s, 2); const float mean = s * (1.f / 64.f); float q = 0.f;
#pragma unroll
          for (int e = 0; e < 16; ++e) { v[e] -= mean; q += v[e] * v[e]; }
          q += __shfl_xor(q, 1); q += __shfl_xor(q, 2); const float rstd = 1.0f / sqrtf(q * (1.f / 64.f) + 1e-5f);
#pragma unroll
          for (int e = 0; e < 16; ++e) Vn[(sub * 16 + e) * 136 + i] = (bf16)f2bf(v[e] * rstd * a.in[I_ESGLNG][g * 64 + sub * 16 + e] + a.in[I_ESGLNB][g * 64 + sub * 16 + e]); }
        __syncthreads();
        const int ti = wave >> 1, dt = wave & 1;
        f32x16 acc = {0.f, 0.f, 0.f, 0.f, 0.f, 0.f, 0.f, 0.f, 0.f, 0.f, 0.f, 0.f, 0.f, 0.f, 0.f, 0.f};
        const LAS bf16* ap = Wl + (32 * ti + l31) * 136 + 8 * hi; const LAS bf16* bp = Vn + (32 * dt + l31) * 136 + 8 * hi;
        for (int ks = 0; ks < 2 * ti + 2; ++ks) acc = __builtin_amdgcn_mfma_f32_32x32x16_bf16(*(const LAS bf16x8*)(ap + 16 * ks), *(const LAS bf16x8*)(bp + 16 * ks), acc, 0, 0, 0);
#pragma unroll
        for (int r = 0; r < 16; ++r) { const int t = 32 * ti + crow(r, hi); const size_t rowg = (size_t)(b * SEQ + ck * 128 + t); const int d = g * 64 + 32 * dt + l31;
            const float mixed = acc[r] + a.in[I_ESGB][g * 128 + t];
            const float uu = bf2f(P[rowg * EVEN_PAD + C_U + d]), zz = bf2f(P[rowg * EVEN_PAD + C_Z0 + 512 + d]);
            MIX[rowg * D + 512 + d] = (bf16)f2bf(uu * mixed * siluf(zz)); if ((r & 3) == 3) asm volatile("" ::: "memory"); }
    }
}

constexpr int RW_CHB = 13632;
constexpr int RW_O_AB = 0, RW_O_RB = 2304, RW_O_CH3 = 4608, RW_O_VT = 8704, RW_O_LAK = 11264, RW_O_GRK = 11776, RW_O_GRB = 12288, RW_O_TT = 12800, RW_O_GAM = 13312, RW_O_BON = 13568;
constexpr int RW_O_Y = 8 * RW_CHB, RW_O_PAR = RW_O_Y + 32768;
static_assert(RW_O_PAR + 12 * 64 * 4 <= LDSCTL_OFF, "rwkv LDS map");
__device__ __forceinline__ bf16x8 mkfrag(u32x2 lo, u32x2 hi) { v4u w; w.x = lo.x; w.y = lo.y; w.z = hi.x; w.w = hi.y; return __builtin_bit_cast(bf16x8, w); }
__device__ __forceinline__ u32x2 pack4(float a, float b, float c, float d) { u32x2 r; r.x = cvtpk(a, b); r.y = cvtpk(c, d); return r; }
#define DPP_SHR_ADD(x, n) x += __builtin_bit_cast(float, __builtin_amdgcn_update_dpp(0, __builtin_bit_cast(int, x), 0x110 + (n), 0xF, 0xF, true))
constexpr int RW_SLOT = 8 * RW_CHB;
constexpr int CW_RWFLAG = 8192;
__device__ __forceinline__ void phase_rwkv3(const Args& a, LAS unsigned char* lds, int tid, int lane_, int wave, int unit, int role) {
    const bf16* P = (const bf16*)(a.ws + WS_P); bf16* MIX = (bf16*)(a.ws + WS_MIX);
    const bf16* WUT = (const bf16*)(a.ws + WS_WUT); const bf16* AUT = (const bf16*)(a.ws + WS_AUT);
    const int b = unit >> 3, h = unit & 7;
    const int c_ = lane_ & 15, g_ = lane_ >> 4;
    LAS float* PAR = (LAS float*)(lds + RW_O_PAR);
    LAS float* MUL = PAR + 7 * 64;
    LAS float* YB = (LAS float*)(lds + RW_O_Y);
    __syncthreads();
    if (tid < 448) { const int p = tid >> 6, j = tid & 63; const int src = (p == 0 ? I_EW0 : p == 1 ? I_EA0 : p == 2 ? I_EKK : p == 3 ? I_EKA : p == 4 ? I_ERK : p == 5 ? I_ELNXG : I_ELNXB); PAR[tid] = a.in[src][h * 64 + j]; }
    if (tid < 320) { const int p = tid >> 6, j = tid & 63; const int col = (p == 0 ? C_R + h * 64 : p == 1 ? C_K + h * 64 : p == 2 ? C_V + h * 64 : p == 3 ? C_WLO : C_ALO) + j; MUL[tid] = a.in[I_EMU][col]; }
    f32x4 S[4];
#pragma unroll
    for (int jt = 0; jt < 4; ++jt) S[jt] = (f32x4){0.f, 0.f, 0.f, 0.f};
    const u32x2 z2 = {0u, 0u};
    u32x2 rc[4], kc[4], vc[4]; v4u cw[2], ca[2];
#define RW_LOADS(bt_) do { int cq_ = c_, gq_ = g_; asm volatile("" : "+v"(cq_), "+v"(gq_)); const int tl_ = (bt_) * 128 + wave * 16 + cq_; \
        const bf16* q_ = P + (size_t)(b * SEQ + tl_) * EVEN_PAD + h * 64 + 4 * gq_; const bf16* w_ = P + (size_t)(b * SEQ + tl_) * EVEN_PAD + C_WLO + 8 * gq_; \
        _Pragma("unroll") for (int ni = 0; ni < 4; ++ni) { rc[ni] = *(const u32x2*)(q_ + C_R + 16 * ni); kc[ni] = *(const u32x2*)(q_ + C_K + 16 * ni); vc[ni] = *(const u32x2*)(q_ + C_V + 16 * ni); } \
        _Pragma("unroll") for (int ks = 0; ks < 2; ++ks) { cw[ks] = *(const v4u*)(w_ + 32 * ks); ca[ks] = *(const v4u*)(w_ + 64 + 32 * ks); } } while (0)
#define DPP_PREV(old_, cur_) ((unsigned)__builtin_amdgcn_update_dpp((int)(old_), (int)(cur_), 0x111, 0xF, 0xF, false))
    RW_LOADS(role);
    __syncthreads();
    gu32* flags = (gu32*)(a.ws + WS_CTL) + CW_RWFLAG + unit * 8;
    for (int bt = role; bt < SEQ / 128; bt += (role ? 2 : 1)) {
        v4u zr0, zr1;
        const bool mine = (bt & 1) == role;
        if (mine) {
        {   int c = c_, g = g_; asm volatile("" : "+v"(c), "+v"(g));
            LAS unsigned char* cb = lds + wave * RW_CHB;
            u32x2 rp[4], kp_[4], vp[4]; v4u pw[2], pa[2];
            { const int tl = bt * 128 + wave * 16 + c;
#pragma unroll
              for (int ni = 0; ni < 4; ++ni) { rp[ni] = z2; kp_[ni] = z2; vp[ni] = z2; }
              pw[0] = (v4u){0u, 0u, 0u, 0u}; pw[1] = pw[0]; pa[0] = pw[0]; pa[1] = pw[0];
              if (c == 0 && tl > 0) { const bf16* qp = P + (size_t)(b * SEQ + tl - 1) * EVEN_PAD + h * 64 + 4 * g; const bf16* wp = P + (size_t)(b * SEQ + tl - 1) * EVEN_PAD + C_WLO + 8 * g;
#pragma unroll
                  for (int ni = 0; ni < 4; ++ni) { rp[ni] = *(const u32x2*)(qp + C_R + 16 * ni); kp_[ni] = *(const u32x2*)(qp + C_K + 16 * ni); vp[ni] = *(const u32x2*)(qp + C_V + 16 * ni); }
#pragma unroll
                  for (int ks = 0; ks < 2; ++ks) { pw[ks] = *(const v4u*)(wp + 32 * ks); pa[ks] = *(const v4u*)(wp + 64 + 32 * ks); } }
#pragma unroll
              for (int ni = 0; ni < 4; ++ni) { rp[ni].x = DPP_PREV(rp[ni].x, rc[ni].x); rp[ni].y = DPP_PREV(rp[ni].y, rc[ni].y); kp_[ni].x = DPP_PREV(kp_[ni].x, kc[ni].x); kp_[ni].y = DPP_PREV(kp_[ni].y, kc[ni].y);
                  vp[ni].x = DPP_PREV(vp[ni].x, vc[ni].x); vp[ni].y = DPP_PREV(vp[ni].y, vc[ni].y); }
#pragma unroll
              for (int ks = 0; ks < 2; ++ks) { pw[ks].x = DPP_PREV(pw[ks].x, cw[ks].x); pw[ks].y = DPP_PREV(pw[ks].y, cw[ks].y); pw[ks].z = DPP_PREV(pw[ks].z, cw[ks].z); pw[ks].w = DPP_PREV(pw[ks].w, cw[ks].w);
                  pa[ks].x = DPP_PREV(pa[ks].x, ca[ks].x); pa[ks].y = DPP_PREV(pa[ks].y, ca[ks].y); pa[ks].z = DPP_PREV(pa[ks].z, ca[ks].z); pa[ks].w = DPP_PREV(pa[ks].w, ca[ks].w); } }
            bf16x8 wfr[4], afr[4];
#pragma unroll
            for (int ni = 0; ni < 4; ++ni) { const size_t wo = (size_t)(h * 64 + 16 * ni + c) * 64 + 8 * g; wfr[ni] = *(const bf16x8*)(WUT + wo); afr[ni] = *(const bf16x8*)(AUT + wo); }
            float kraw[16]; float ssq = 0.f;
#pragma unroll
            for (int ni = 0; ni < 4; ++ni) { const int jl = 16 * ni + 4 * g; const f32x4 mk = *(const LAS f32x4*)(MUL + 64 + jl); const f32x4 kkp = *(const LAS f32x4*)(PAR + 2 * 64 + jl);
                const float cf[4] = {bflo(kc[ni].x), bfhi(kc[ni].x), bflo(kc[ni].y), bfhi(kc[ni].y)}, pf[4] = {bflo(kp_[ni].x), bfhi(kp_[ni].x), bflo(kp_[ni].y), bfhi(kp_[ni].y)};
#pragma unroll
                for (int e = 0; e < 4; ++e) { const float k = cf[e] + mk[e] * (pf[e] - cf[e]); kraw[ni * 4 + e] = k; const float kv = k * kkp[e]; ssq += kv * kv; } }
            ssq += __shfl_xor(ssq, 16); ssq += __shfl_xor(ssq, 32);
            const float rs = __builtin_amdgcn_rsqf(fmaxf(ssq, 1e-24f));
            f32x4 accw[4], acca[4];
#pragma unroll
            for (int ni = 0; ni < 4; ++ni) { accw[ni] = (f32x4){0.f, 0.f, 0.f, 0.f}; acca[ni] = accw[ni]; }
#pragma unroll
            for (int ks = 0; ks < 2; ++ks) { const int mb = 32 * ks + 8 * g;
                const f32x4 mw0 = *(const LAS f32x4*)(MUL + 192 + mb), mw1 = *(const LAS f32x4*)(MUL + 192 + mb + 4), ma0 = *(const LAS f32x4*)(MUL + 256 + mb), ma1 = *(const LAS f32x4*)(MUL + 256 + mb + 4);
                const v4u cwv = cw[ks], cav = ca[ks], pwv = pw[ks], pav = pa[ks];
                const float cwf[8] = {bflo(cwv.x), bfhi(cwv.x), bflo(cwv.y), bfhi(cwv.y), bflo(cwv.z), bfhi(cwv.z), bflo(cwv.w), bfhi(cwv.w)}, pwf[8] = {bflo(pwv.x), bfhi(pwv.x), bflo(pwv.y), bfhi(pwv.y), bflo(pwv.z), bfhi(pwv.z), bflo(pwv.w), bfhi(pwv.w)};
                const float caf[8] = {bflo(cav.x), bfhi(cav.x), bflo(cav.y), bfhi(cav.y), bflo(cav.z), bfhi(cav.z), bflo(cav.w), bfhi(cav.w)}, paf[8] = {bflo(pav.x), bfhi(pav.x), bflo(pav.y), bfhi(pav.y), bflo(pav.z), bfhi(pav.z), bflo(pav.w), bfhi(pav.w)};
                const float mwf[8] = {mw0[0], mw0[1], mw0[2], mw0[3], mw1[0], mw1[1], mw1[2], mw1[3]}, maf[8] = {ma0[0], ma0[1], ma0[2], ma0[3], ma1[0], ma1[1], ma1[2], ma1[3]};
                float tw[8], al[8];
#pragma unroll
                for (int e = 0; e < 8; ++e) { tw[e] = fast_tanh(cwf[e] + mwf[e] * (pwf[e] - cwf[e])); al[e] = caf[e] + maf[e] * (paf[e] - caf[e]); }
                v4u bwv, bav; bwv.x = cvtpk(tw[0], tw[1]); bwv.y = cvtpk(tw[2], tw[3]); bwv.z = cvtpk(tw[4], tw[5]); bwv.w = cvtpk(tw[6], tw[7]);
                bav.x = cvtpk(al[0], al[1]); bav.y = cvtpk(al[2], al[3]); bav.z = cvtpk(al[4], al[5]); bav.w = cvtpk(al[6], al[7]);
                const bf16x8 bw = __builtin_bit_cast(bf16x8, bwv), ba = __builtin_bit_cast(bf16x8, bav);
#pragma unroll
                for (int ni = 0; ni < 4; ++ni) { accw[ni] = __builtin_amdgcn_mfma_f32_16x16x32_bf16(wfr[ni], bw, accw[ni], 0, 0, 0); acca[ni] = __builtin_amdgcn_mfma_f32_16x16x32_bf16(afr[ni], ba, acca[ni], 0, 0, 0); }
                if (ks == 0) {
#pragma unroll
                    for (int ni = 0; ni < 4; ++ni) { const size_t wo = (size_t)(h * 64 + 16 * ni + c) * 64 + 32 + 8 * g; wfr[ni] = *(const bf16x8*)(WUT + wo); afr[ni] = *(const bf16x8*)(AUT + wo); } } }
            { int lq = lane_; asm volatile("" : "+v"(lq)); const bf16* zp = P + (size_t)(b * SEQ + bt * 128 + wave * 16 + (lq >> 2)) * EVEN_PAD + C_Z0 + h * 64 + 16 * (lq & 3);
              zr0 = *(const v4u*)zp; zr1 = *(const v4u*)(zp + 8); }
            u32x2 fA[4], fR[4], fB[4], fK[4]; float bon = 0.f;
#pragma unroll
            for (int ni = 0; ni < 4; ++ni) { const int jl = 16 * ni + 4 * g;
                const f32x4 mr = *(const LAS f32x4*)(MUL + jl), mv = *(const LAS f32x4*)(MUL + 128 + jl);
                const f32x4 w0 = *(const LAS f32x4*)(PAR + jl), a0 = *(const LAS f32x4*)(PAR + 64 + jl), kkp = *(const LAS f32x4*)(PAR + 128 + jl), kap = *(const LAS f32x4*)(PAR + 192 + jl), rkp = *(const LAS f32x4*)(PAR + 256 + jl);
                const float rcf[4] = {bflo(rc[ni].x), bfhi(rc[ni].x), bflo(rc[ni].y), bfhi(rc[ni].y)}, rpf[4] = {bflo(rp[ni].x), bfhi(rp[ni].x), bflo(rp[ni].y), bfhi(rp[ni].y)};
                const float vcf[4] = {bflo(vc[ni].x), bfhi(vc[ni].x), bflo(vc[ni].y), bfhi(vc[ni].y)}, vpf[4] = {bflo(vp[ni].x), bfhi(vp[ni].x), bflo(vp[ni].y), bfhi(vp[ni].y)};
                float Av[4], Rv[4], Kv[4], Bv[4], Vq[4]; f32x4 gam;
#pragma unroll
                for (int e = 0; e < 4; ++e) {
                    const float r = rcf[e] + mr[e] * (rpf[e] - rcf[e]); const float vv = vcf[e] + mv[e] * (vpf[e] - vcf[e]);
                    Vq[e] = vv;
                    const float lw = -0.60653066f * __builtin_amdgcn_rcpf(1.f + __expf(-(w0[e] + accw[ni][e])));
                    const float av = __builtin_amdgcn_rcpf(1.f + __expf(-(a0[e] + acca[ni][e])));
                    const float k = kraw[ni * 4 + e]; const float kk = k * kkp[e] * rs; const float kp = k * (1.f + (av - 1.f) * kap[e]);
                    bon += r * kp * rkp[e];
                    float cum = lw; DPP_SHR_ADD(cum, 1); DPP_SHR_ADD(cum, 2); DPP_SHR_ADD(cum, 4); DPP_SHR_ADD(cum, 8);
                    const float eg = __expf(cum), ieg = __builtin_amdgcn_rcpf(eg);
                    const float egm = __builtin_bit_cast(float, __builtin_amdgcn_update_dpp(0x3f800000, __builtin_bit_cast(int, eg), 0x111, 0xF, 0xF, false));
                    Av[e] = -kk * egm; Rv[e] = r * eg; Kv[e] = kp * ieg; Bv[e] = kk * av * ieg; gam[e] = eg; }
                fA[ni] = pack4(Av[0], Av[1], Av[2], Av[3]); fR[ni] = pack4(Rv[0], Rv[1], Rv[2], Rv[3]); fK[ni] = pack4(Kv[0], Kv[1], Kv[2], Kv[3]); fB[ni] = pack4(Bv[0], Bv[1], Bv[2], Bv[3]);
                *(LAS u32x2*)(cb + RW_O_VT + (c * 64 + jl) * 2) = pack4(Vq[0], Vq[1], Vq[2], Vq[3]);
                if (c == 15) *(LAS f32x4*)(cb + RW_O_GAM + jl * 4) = gam;
                *(LAS u32x2*)(cb + RW_O_AB + (c * 72 + jl) * 2) = fA[ni]; *(LAS u32x2*)(cb + RW_O_RB + (c * 72 + jl) * 2) = fR[ni];
                LAS bf16* c3 = (LAS bf16*)(cb + RW_O_CH3) + ((ni * 16 + 4 * g) * 4 + (c >> 2)) * 8 + (c & 3);
                c3[0] = (bf16)(fB[ni].x & 0xffffu); c3[32] = (bf16)(fB[ni].x >> 16); c3[64] = (bf16)(fB[ni].y & 0xffffu); c3[96] = (bf16)(fB[ni].y >> 16);
                c3[4] = (bf16)(fK[ni].x & 0xffffu); c3[36] = (bf16)(fK[ni].x >> 16); c3[68] = (bf16)(fK[ni].y & 0xffffu); c3[100] = (bf16)(fK[ni].y >> 16); }
            bon += __shfl_xor(bon, 16); bon += __shfl_xor(bon, 32);
            if (g == 0) ((LAS float*)(cb + RW_O_BON))[c] = bon;
            f32x4 Lab = {0.f, 0.f, 0.f, 0.f}, Lak = Lab, Grk = Lab, Grb = Lab;
#pragma unroll
            for (int p = 0; p < 2; ++p) { const bf16x8 xa = mkfrag(fA[2 * p], fA[2 * p + 1]), xr = mkfrag(fR[2 * p], fR[2 * p + 1]), xb = mkfrag(fB[2 * p], fB[2 * p + 1]), xk = mkfrag(fK[2 * p], fK[2 * p + 1]);
                Lab = __builtin_amdgcn_mfma_f32_16x16x32_bf16(xa, xb, Lab, 0, 0, 0); Lak = __builtin_amdgcn_mfma_f32_16x16x32_bf16(xa, xk, Lak, 0, 0, 0);
                Grk = __builtin_amdgcn_mfma_f32_16x16x32_bf16(xr, xk, Grk, 0, 0, 0); Grb = __builtin_amdgcn_mfma_f32_16x16x32_bf16(xr, xb, Grb, 0, 0, 0); }
            LAS float* LT = YB + wave * 256;
            { f32x4 lt;
#pragma unroll
              for (int e = 0; e < 4; ++e) { const int tr = 4 * g + e; const bool st = c < tr, inc = c <= tr;
                  lt[e] = st ? Lab[e] : 0.f;
                  ((LAS bf16*)(cb + RW_O_LAK))[tr * 16 + c] = (bf16)f2bf(st ? Lak[e] : 0.f);
                  ((LAS bf16*)(cb + RW_O_GRK))[tr * 16 + c] = (bf16)f2bf(inc ? Grk[e] : 0.f);
                  ((LAS bf16*)(cb + RW_O_GRB))[tr * 16 + c] = (bf16)f2bf(inc ? Grb[e] : 0.f); }
              *(LAS f32x4*)(LT + c * 16 + 4 * g) = lt; }
            float Tr[16];
#pragma unroll
            for (int u = 0; u < 16; ++u) Tr[u] = (u == c) ? 1.f : 0.f;
#pragma unroll
            for (int u = 14; u >= 0; --u) { float lrow[16];
#pragma unroll
                for (int q = 0; q < 4; ++q) { const f32x4 x = *(const LAS f32x4*)(LT + u * 16 + 4 * q); lrow[4 * q] = x[0]; lrow[4 * q + 1] = x[1]; lrow[4 * q + 2] = x[2]; lrow[4 * q + 3] = x[3]; }
                float acc = 0.f;
#pragma unroll
                for (int s = u + 1; s < 16; ++s) acc += Tr[s] * lrow[s];
                Tr[u] = (u < c) ? acc : Tr[u]; }
            if (g == 0) { v4u t0v, t1v; t0v.x = cvtpk(Tr[0], Tr[1]); t0v.y = cvtpk(Tr[2], Tr[3]); t0v.z = cvtpk(Tr[4], Tr[5]); t0v.w = cvtpk(Tr[6], Tr[7]);
                t1v.x = cvtpk(Tr[8], Tr[9]); t1v.y = cvtpk(Tr[10], Tr[11]); t1v.z = cvtpk(Tr[12], Tr[13]); t1v.w = cvtpk(Tr[14], Tr[15]);
                *(LAS v4u*)(cb + RW_O_TT + c * 32) = t0v; *(LAS v4u*)(cb + RW_O_TT + c * 32 + 16) = t1v; }
        }
        } else {
            { int lq = lane_; asm volatile("" : "+v"(lq)); const bf16* zp = P + (size_t)(b * SEQ + bt * 128 + wave * 16 + (lq >> 2)) * EVEN_PAD + C_Z0 + h * 64 + 16 * (lq & 3);
              zr0 = *(const v4u*)zp; zr1 = *(const v4u*)(zp + 8); }
            if (tid == 0) { unsigned sp = 0; while (__hip_atomic_load(flags + (bt >> 1), __ATOMIC_RELAXED, __HIP_MEMORY_SCOPE_AGENT) == 0u && ++sp < (1u << 24)) __builtin_amdgcn_s_sleep(2);
                __builtin_amdgcn_fence(__ATOMIC_ACQUIRE, "agent"); asm volatile("s_waitcnt vmcnt(0)" ::: "memory"); }
            __syncthreads();
            { const unsigned char* gsrc = a.ws + WS_RING + ((size_t)unit * 8 + (bt >> 1)) * RW_SLOT; int tq = tid; asm volatile("" : "+v"(tq));
              v4u buf[7];
#pragma unroll
              for (int hh = 0; hh < 2; ++hh) {
#pragma unroll
                  for (int k = 0; k < 7; ++k) { const int i = tq + 512 * (7 * hh + k); if (i < RW_SLOT / 16) buf[k] = *(const v4u*)(gsrc + (size_t)i * 16); }
#pragma unroll
                  for (int k = 0; k < 7; ++k) { const int i = tq + 512 * (7 * hh + k); if (i < RW_SLOT / 16) *(LAS v4u*)(lds + i * 16) = buf[k]; } } }
        }
        __syncthreads();
        if (role == 1) {
            unsigned char* gdst = a.ws + WS_RING + ((size_t)unit * 8 + (bt >> 1)) * RW_SLOT; int tq = tid; asm volatile("" : "+v"(tq));
#pragma unroll
            for (int k = 0; k < 14; ++k) { const int i = tq + 512 * k; if (i < RW_SLOT / 16) *(v4u*)(gdst + (size_t)i * 16) = *(const LAS v4u*)(lds + i * 16); }
            asm volatile("s_waitcnt vmcnt(0)" ::: "memory");
            if (bt + 2 < SEQ / 128) RW_LOADS(bt + 2);
            __syncthreads();
            if (tid == 0) { __builtin_amdgcn_fence(__ATOMIC_RELEASE, "agent"); asm volatile("s_waitcnt vmcnt(0)" ::: "memory"); __hip_atomic_store(flags + (bt >> 1), 1u, __ATOMIC_RELAXED, __HIP_MEMORY_SCOPE_AGENT); }
            continue;
        }
        if (mine && bt + 2 < SEQ / 128) RW_LOADS(bt + 2);
        if (wave < 4) {
            int c = c_, g = g_; asm volatile("" : "+v"(c), "+v"(g));
#pragma unroll 1
            for (int ch = 0; ch < 8; ++ch) { LAS unsigned char* cb = lds + ch * RW_CHB;
                u32x2 vfr; { const LAS bf16* vp_ = (const LAS bf16*)(cb + RW_O_VT) + (4 * g) * 64 + 16 * wave + c; vfr.x = (unsigned)vp_[0] | ((unsigned)vp_[64] << 16); vfr.y = (unsigned)vp_[128] | ((unsigned)vp_[192] << 16); }
                u32x2 sb[4];
#pragma unroll
                for (int jt = 0; jt < 4; ++jt) sb[jt] = pack4(S[jt][0], S[jt][1], S[jt][2], S[jt][3]);
                f32x4 acc1 = {0.f, 0.f, 0.f, 0.f}, accY = acc1;
#pragma unroll
                for (int jt = 0; jt < 4; ++jt) { const u32x2 a1 = *(const LAS u32x2*)(cb + RW_O_AB + (c * 72 + 16 * jt + 4 * g) * 2), aY = *(const LAS u32x2*)(cb + RW_O_RB + (c * 72 + 16 * jt + 4 * g) * 2);
                    u32x2 a1x = z2, aYx = z2, bx = z2;
                    if (jt == 0) { a1x = *(const LAS u32x2*)(cb + RW_O_LAK + (c * 16 + 4 * g) * 2); aYx = *(const LAS u32x2*)(cb + RW_O_GRK + (c * 16 + 4 * g) * 2); bx = vfr; }
                    const bf16x8 bf = mkfrag(sb[jt], bx);
                    acc1 = __builtin_amdgcn_mfma_f32_16x16x32_bf16(mkfrag(a1, a1x), bf, acc1, 0, 0, 0);
                    accY = __builtin_amdgcn_mfma_f32_16x16x32_bf16(mkfrag(aY, aYx), bf, accY, 0, 0, 0); }
                const u32x2 rb = pack4(acc1[0], acc1[1], acc1[2], acc1[3]);
                f32x4 accU = {0.f, 0.f, 0.f, 0.f};
                accU = __builtin_amdgcn_mfma_f32_16x16x32_bf16(mkfrag(*(const LAS u32x2*)(cb + RW_O_TT + (c * 16 + 4 * g) * 2), z2), mkfrag(rb, z2), accU, 0, 0, 0);
                const u32x2 ub = pack4(accU[0], accU[1], accU[2], accU[3]);
                accY = __builtin_amdgcn_mfma_f32_16x16x32_bf16(mkfrag(*(const LAS u32x2*)(cb + RW_O_GRB + (c * 16 + 4 * g) * 2), z2), mkfrag(ub, z2), accY, 0, 0, 0);
#pragma unroll
                for (int e = 0; e < 4; ++e) YB[(ch * 16 + 4 * g + e) * 64 + 16 * wave + c] = accY[e];
                const bf16x8 b3 = mkfrag(ub, vfr);
#pragma unroll
                for (int jt = 0; jt < 4; ++jt) { const bf16x8 a3 = *(const LAS bf16x8*)(cb + RW_O_CH3 + (((jt * 16 + c) * 4 + g) * 8) * 2);
                    S[jt] = __builtin_amdgcn_mfma_f32_16x16x32_bf16(a3, b3, S[jt], 0, 0, 0);
                    S[jt] = S[jt] * *(const LAS f32x4*)(cb + RW_O_GAM + (16 * jt + 4 * g) * 4); }
            }
        }
        __syncthreads();

        {   int lane = lane_; asm volatile("" : "+v"(lane));
            LAS unsigned char* cb = lds + wave * RW_CHB; const int tt = lane >> 2, q16 = 16 * (lane & 3);
            float y[16];
#pragma unroll
            for (int e4 = 0; e4 < 4; ++e4) { const f32x4 x = *(const LAS f32x4*)(YB + (wave * 16 + tt) * 64 + q16 + 4 * e4); y[4 * e4] = x[0]; y[4 * e4 + 1] = x[1]; y[4 * e4 + 2] = x[2]; y[4 * e4 + 3] = x[3]; }
            float s = 0.f;
#pragma unroll
            for (int e = 0; e < 16; ++e) s += y[e];
            DPP_ADD(s, 0xB1); DPP_ADD(s, 0x4E); const float mean = s * (1.f / 64.f); float qq = 0.f;
#pragma unroll
            for (int e = 0; e < 16; ++e) { y[e] -= mean; qq += y[e] * y[e]; }
            DPP_ADD(qq, 0xB1); DPP_ADD(qq, 0x4E); const float rstd = __builtin_amdgcn_rsqf(qq * (1.f / 64.f) + 64e-5f);
            const float bonv = ((const LAS float*)(cb + RW_O_BON))[tt];
            const v4u vq0 = *(const LAS v4u*)(cb + RW_O_VT + (tt * 64 + q16) * 2), vq1 = *(const LAS v4u*)(cb + RW_O_VT + (tt * 64 + q16 + 8) * 2);
            const unsigned vw[8] = {vq0.x, vq0.y, vq0.z, vq0.w, vq1.x, vq1.y, vq1.z, vq1.w}, zw[8] = {zr0.x, zr0.y, zr0.z, zr0.w, zr1.x, zr1.y, zr1.z, zr1.w};
            unsigned ow[8];
#pragma unroll
            for (int e2 = 0; e2 < 8; ++e2) { const f32x2_t lg = *(const LAS f32x2_t*)(PAR + 5 * 64 + q16 + 2 * e2), lb = *(const LAS f32x2_t*)(PAR + 6 * 64 + q16 + 2 * e2);
                const float o0 = (y[2 * e2] * rstd * lg[0] + lb[0] + bonv * bflo(vw[e2])) * siluf(bflo(zw[e2])), o1 = (y[2 * e2 + 1] * rstd * lg[1] + lb[1] + bonv * bfhi(vw[e2])) * siluf(bfhi(zw[e2]));
                ow[e2] = cvtpk(o0, o1); }
            bf16* mp = MIX + (size_t)(b * SEQ + bt * 128 + wave * 16 + tt) * D + h * 64 + q16;
            *(v4u*)mp = (v4u){ow[0], ow[1], ow[2], ow[3]}; *(v4u*)(mp + 8) = (v4u){ow[4], ow[5], ow[6], ow[7]};
        }
        __syncthreads();
    }
#undef RW_LOADS
#undef DPP_PREV
}
__global__ void __launch_bounds__(NWAVES * 64, 2) mk_fwd(Args args) {
    extern __shared__ __attribute__((aligned(16))) unsigned char lds_raw[];
    LAS unsigned char* lds = (LAS unsigned char*)lds_raw;
    volatile LAS unsigned* MISC = (volatile LAS unsigned*)(lds + MISC_OFF);
    const int tid = threadIdx.x, lane = tid & 63, wave = __builtin_amdgcn_readfirstlane(tid >> 6);
    const int G = gridDim.x; const int bx = blockIdx.x; const int vcu = (G % 8 == 0) ? (bx % 8) * (G / 8) + bx / 8 : bx;
    unsigned char* ws = args.ws;
    gu32* ctl = (gu32*)(ws + WS_CTL);
    for (int u = tid; u < (LDS_BYTES - LDSCTL_OFF) / 4; u += NWAVES * 64) ((LAS unsigned*)(lds + LDSCTL_OFF))[u] = 0u;
    __syncthreads();
    XcdBarrier bar = xcd_barrier_post((unsigned*)(ctl + CW_BAR), MISC + 8);
    const int lo = args.ph_lo, hi = args.ph_hi;
#define IN(k) (lo <= (k) && (k) < hi)
#define GRID_BAR() xcd_barrier(bar)
    float* mod = (float*)(ws + WS_MOD);
    bf16* XN = (bf16*)(ws + WS_XN); bf16* MIX = (bf16*)(ws + WS_MIX); bf16* P = (bf16*)(ws + WS_P);

    if (IN(0)) { phase0(args, lds, tid, lane, wave, vcu, G); GRID_BAR(); }
    if (IN(1)) { phase_adaln_rows(args.in[I_X], args.in[I_NORMG], mod, XN, lane, wave, vcu, G); phase_bias3(args, lds, tid, lane, wave, vcu, G); GRID_BAR(); }
    if (IN(2)) {
        pg8::Gemm g{XN, (const bf16*)(ws + WS_WIN0), M, EVEN_PAD, D}; pg8::StaticOrder S; S.init(M, EVEN_PAD, G, (int)blockIdx.x);
        pg8::EpiBf16 E{P, EVEN_PAD};
        pg8::gemm_phase<pg8::EpiBf16, pg8::StaticOrder, PG8_ALIGN, PG8_SP2>(lds, g, S, E);
        GRID_BAR();
    }
    if (IN(3)) { if (G == 256) phase_rwkv3(args, lds, tid, lane, wave, vcu >> 1, vcu & 1); phase_gmlp2(args, lds, tid, lane, wave, vcu, G); GRID_BAR(); }
    if (IN(4)) {
        pg8::Gemm g{MIX, (const bf16*)(ws + WS_WOUT0), M, D, D}; pg8::StaticOrder S; S.init(M, D, G, (int)blockIdx.x);
        pg8::EpiResGateNext E{args.in[I_X], args.out, mod + 2048, args.in[I_NORMG] + D, mod + 16 * 3072 + 1024, XN, (float*)(ws + WS_ROWSS)};
        pg8::gemm_phase<pg8::EpiResGateNext, pg8::StaticOrder, PG8_ALIGN, PG8_SP2>(lds, g, S, E);
        GRID_BAR();
    }
    if (IN(6)) {
        pg8::Gemm g{XN, (const bf16*)(ws + WS_WIN1), M, ODD_IN, D}; pg8::StaticOrder S; S.init(M, ODD_IN, G, (int)blockIdx.x);
        pg8::EpiBf16RowScale E{P, ODD_IN, (const float*)(ws + WS_ROWSS), (const float*)(ws + WS_BIAS3)};
        pg8::gemm_phase<pg8::EpiBf16RowScale, pg8::StaticOrder, PG8_ALIGN, PG8_SP2>(lds, g, S, E);
        GRID_BAR();
    }
    if (IN(7)) { phase_swa2(args, lds, tid, lane, wave, vcu, G); GRID_BAR(); }
    if (IN(8)) {
        pg8::Gemm g{MIX, (const bf16*)(ws + WS_WOUT1), M, D, D}; pg8::StaticOrder S; S.init(M, D, G, (int)blockIdx.x);
        pg8::EpiResGate E{args.out, args.out, mod + 16 * 3072 + 2048};
        pg8::gemm_phase<pg8::EpiResGate, pg8::StaticOrder, PG8_ALIGN, PG8_SP2>(lds, g, S, E);
        GRID_BAR();
    }
    if (IN(9)) { phase_final_rows(args.out, args.in[I_FINALG], lane, wave, vcu, G); }
#undef IN
#undef GRID_BAR
}

extern "C" void kernel_launch(void* const* d_in, const int* in_sizes, int n_in, void* d_out, int out_size, void* d_ws, size_t ws_size, hipStream_t stream) {
    static int grid = 0;
    if (grid == 0) {
        if (n_in != N_IN || in_sizes[0] != M * D || out_size != M * D || ws_size < WS_END) { fprintf(stderr, "kernel_launch: unexpected shapes (n_in %d, in0 %d, out %d, ws %zu); nothing launched\n", n_in, n_in > 0 ? in_sizes[0] : -1, out_size, ws_size); grid = -1; return; }
        int dev = 0, cus = 0, per_cu = 0;
        if (hipGetDevice(&dev) != hipSuccess || hipDeviceGetAttribute(&cus, hipDeviceAttributeMultiprocessorCount, dev) != hipSuccess) { grid = -1; return; }
        if (hipFuncSetAttribute((const void*)mk_fwd, hipFuncAttributeMaxDynamicSharedMemorySize, LDS_BYTES) != hipSuccess) { fprintf(stderr, "kernel_launch: hipFuncSetAttribute failed\n"); grid = -1; return; }
        if (hipOccupancyMaxActiveBlocksPerMultiprocessor(&per_cu, (const void*)mk_fwd, NWAVES * 64, LDS_BYTES) != hipSuccess || per_cu < 1) fprintf(stderr, "kernel_launch: note: occupancy query reports %d\n", per_cu);
        (void)hipGetLastError();
        grid = cus;
    }
    if (grid < 0) return;
    if (hipMemsetAsync((char*)d_ws + WS_CTL, 0, CTL_ZERO_BYTES, stream) != hipSuccess) { fprintf(stderr, "kernel_launch: memset failed\n"); return; }
    Args a{};
    for (int i = 0; i < N_IN; ++i) a.in[i] = (const float*)d_in[i];
    a.out = (float*)d_out; a.ws = (unsigned char*)d_ws; a.ph_lo = 0; a.ph_hi = 10;
    hipLaunchKernelGGL(mk_fwd, dim3(grid), dim3(NWAVES * 64), LDS_BYTES, stream, a);
}
```

```cpp
#include <hip/hip_runtime.h>
#include <cstdio>
#include <cstdint>
namespace pg8 {
#define PG8_LAS __attribute__((address_space(3)))
typedef unsigned short bf16_t;
typedef short bf16x8 __attribute__((ext_vector_type(8)));
typedef float f32x4 __attribute__((ext_vector_type(4)));
typedef unsigned u32x4 __attribute__((ext_vector_type(4)));
constexpr int BM = 256, BK = 64, HALF = 128, HTB = HALF * BK * 2  , STAGE_BYTES = 8 * HTB, NXCD = 8, WGM = 8;

__host__ __device__ __forceinline__ int lds_byte(int r, int c) { const int st = (r >> 4) * 2 + (c >> 5), rr = r & 15, cc = c & 31, ob = rr * 64 + cc * 2; return st * 1024 + (ob ^ (((ob >> 9) & 1) << 5)); }
__host__ __device__ __forceinline__ void stage_rc(int b, int& R, int& C) { const int st = b / 1024, sb = b % 1024, swz = sb ^ (((sb >> 9) & 1) << 5); R = (st >> 1) * 16 + swz / 64; C = (st & 1) * 32 + (swz % 64) / 2; }
__host__ __device__ __forceinline__ int perm32(int rho) { const int n = rho >> 4, i = rho & 15; return 8 * (i >> 2) + 4 * n + (i & 3); }

struct Unit { int pm, pn; };
struct Gemm { const bf16_t* A; const bf16_t* Bt; int M, N, K; };

struct StaticOrder {
    int nM, nN, nwg, G, c;
    __host__ __device__ void init(int M, int N, int G_, int c_) { nM = M / BM; nN = N / BM; nwg = nM * nN; G = G_; c = c_; }
    __host__ __device__ bool next(int i, Unit& u) const {
        const long L = (long)i * G + c; if (L >= nwg) return false;
        int wgid = (int)L; { const int q = nwg / NXCD, r = nwg % NXCD, xcd = wgid % NXCD, off = wgid / NXCD; wgid = (xcd < r ? xcd * (q + 1) : r * (q + 1) + (xcd - r) * q) + off; }
        const int nig = WGM * nN, gid = wgid / nig, fm = gid * WGM, gsz = (nM - fm) < WGM ? (nM - fm) : WGM;
        u.pm = fm + ((wgid % nig) % gsz); u.pn = (wgid % nig) / gsz; return true;
    }
    __device__ __forceinline__ void a_ready(const Unit&) const {}
    __device__ __forceinline__ void done(const Unit&) const {}
};

__device__ __forceinline__ unsigned cvt_pk_bf16(float lo, float hi) { unsigned r; asm volatile("v_cvt_pk_bf16_f32 %0, %1, %2" : "=v"(r) : "v"(lo), "v"(hi)); return r; }
struct EpiBf16 {
    static constexpr bool PERM = true, AFTER_DRAIN = false;
    bf16_t* O; int ldc;
    __device__ __forceinline__ void operator()(const f32x4 (&acc)[2][2][4][2], const Unit& u, int wr, int wc, int fr, int fq) const {
        const int row0 = u.pm * BM + wr * 64 + fr; const int col0 = u.pn * BM + wc * 32 + 8 * fq;
#pragma unroll
        for (int ai = 0; ai < 2; ++ai)
#pragma unroll
            for (int m = 0; m < 4; ++m) { bf16_t* rowp = O + (size_t)(row0 + ai * HALF + m * 16) * ldc + col0;
#pragma unroll
                for (int bj = 0; bj < 2; ++bj) { const f32x4 v0 = acc[ai][bj][m][0], v1 = acc[ai][bj][m][1];
                    u32x4 w; w.x = cvt_pk_bf16(v0[0], v0[1]); w.y = cvt_pk_bf16(v0[2], v0[3]); w.z = cvt_pk_bf16(v1[0], v1[1]); w.w = cvt_pk_bf16(v1[2], v1[3]);
                    *(u32x4*)(rowp + bj * HALF) = w; } }
    }
};
struct EpiResGate {
    static constexpr bool PERM = false, AFTER_DRAIN = false;
    const float* base; float* out; const float* gate;
    __device__ __forceinline__ void operator()(const f32x4 (&acc)[2][2][4][2], const Unit& u, int wr, int wc, int fr, int fq) const {
        const int col0 = u.pn * BM + wc * 32 + 4 * fq; const int b = (u.pm * BM) >> 11;
        f32x4 gv[2][2];
#pragma unroll
        for (int bj = 0; bj < 2; ++bj)
#pragma unroll
            for (int n = 0; n < 2; ++n) gv[bj][n] = *(const f32x4*)(gate + (size_t)b * 3072 + col0 + bj * HALF + n * 16);
#pragma unroll
        for (int ai = 0; ai < 2; ++ai)
#pragma unroll
            for (int m = 0; m < 4; ++m) { const size_t off = (size_t)(u.pm * BM + ai * HALF + wr * 64 + m * 16 + fr) * 1024 + col0;
#pragma unroll
                for (int bj = 0; bj < 2; ++bj)
#pragma unroll
                    for (int n = 0; n < 2; ++n) { const f32x4 bs = *(const f32x4*)(base + off + bj * HALF + n * 16);
                        *(f32x4*)(out + off + bj * HALF + n * 16) = bs + gv[bj][n] * acc[ai][bj][m][n]; } }
    }
};

struct EpiResGateNext {
    static constexpr bool PERM = false, AFTER_DRAIN = false;
    const float* base; float* out; const float* gate; const float* g1; const float* scale1; bf16_t* xn; float* rowss;
    __device__ __forceinline__ void operator()(const f32x4 (&acc)[2][2][4][2], const Unit& u, int wr, int wc, int fr, int fq) const {
        const int col0 = u.pn * BM + wc * 32 + 4 * fq; const int b = (u.pm * BM) >> 11;
        f32x4 gv[2][2], gs[2][2];
#pragma unroll
        for (int bj = 0; bj < 2; ++bj)
#pragma unroll
            for (int n = 0; n < 2; ++n) { const int c = col0 + bj * HALF + n * 16; gv[bj][n] = *(const f32x4*)(gate + (size_t)b * 3072 + c);
                gs[bj][n] = *(const f32x4*)(g1 + c) * (*(const f32x4*)(scale1 + (size_t)b * 3072 + c) + 1.0f); }
#pragma unroll
        for (int ai = 0; ai < 2; ++ai)
#pragma unroll
            for (int m = 0; m < 4; ++m) { const int r = u.pm * BM + ai * HALF + wr * 64 + m * 16 + fr; const size_t off = (size_t)r * 1024 + col0; float ss = 0.f;
#pragma unroll
                for (int bj = 0; bj < 2; ++bj)
#pragma unroll
                    for (int n = 0; n < 2; ++n) { const f32x4 bs = *(const f32x4*)(base + off + bj * HALF + n * 16); const f32x4 x1 = bs + gv[bj][n] * acc[ai][bj][m][n];
                        *(f32x4*)(out + off + bj * HALF + n * 16) = x1; ss += (x1[0] * x1[0] + x1[1] * x1[1]) + (x1[2] * x1[2] + x1[3] * x1[3]);
                        const f32x4 hq = x1 * gs[bj][n]; typedef unsigned u32x2v __attribute__((ext_vector_type(2))); u32x2v w; w.x = cvt_pk_bf16(hq[0], hq[1]); w.y = cvt_pk_bf16(hq[2], hq[3]);
                        *(u32x2v*)(xn + off + bj * HALF + n * 16) = w; }
                ss += __shfl_xor(ss, 16); ss += __shfl_xor(ss, 32);
                if (fq == 0) rowss[(size_t)r * 16 + u.pn * 4 + wc] = ss; }
    }
};
struct EpiBf16RowScale {
    static constexpr bool PERM = true, AFTER_DRAIN = false;
    bf16_t* O; int ldc; const float* rowss; const float* bias;
    __device__ __forceinline__ void operator()(const f32x4 (&acc)[2][2][4][2], const Unit& u, int wr, int wc, int fr, int fq) const {
        const int row0 = u.pm * BM + wr * 64 + fr; const int col0 = u.pn * BM + wc * 32 + 8 * fq; const int b = (u.pm * BM) >> 11;
        f32x4 bv[2][2];
#pragma unroll
        for (int bj = 0; bj < 2; ++bj)
#pragma unroll
            for (int n = 0; n < 2; ++n) bv[bj][n] = *(const f32x4*)(bias + (size_t)b * ldc + col0 + bj * HALF + 4 * n);
#pragma unroll
        for (int ai = 0; ai < 2; ++ai)
#pragma unroll
            for (int m = 0; m < 4; ++m) { const int r = row0 + ai * HALF + m * 16; const f32x4* rp = (const f32x4*)(rowss + (size_t)r * 16);
                const f32x4 q0 = rp[0], q1 = rp[1], q2 = rp[2], q3 = rp[3]; const f32x4 qs = (q0 + q1) + (q2 + q3);
                const float rr = 1.0f / sqrtf(((qs[0] + qs[1]) + (qs[2] + qs[3])) * (1.0f / 1024.0f) + 1e-6f);
                bf16_t* rowp = O + (size_t)r * ldc + col0;
#pragma unroll
                for (int bj = 0; bj < 2; ++bj) { const f32x4 v0 = acc[ai][bj][m][0] * rr + bv[bj][0], v1 = acc[ai][bj][m][1] * rr + bv[bj][1];
                    u32x4 w; w.x = cvt_pk_bf16(v0[0], v0[1]); w.y = cvt_pk_bf16(v0[2], v0[3]); w.z = cvt_pk_bf16(v1[0], v1[1]); w.w = cvt_pk_bf16(v1[2], v1[3]);
                    *(u32x4*)(rowp + bj * HALF) = w; } }
    }
};
template <class Epi, class Sched, bool ALIGN_EPI = false, bool SP2 = false>
__device__ __forceinline__ void gemm_phase(PG8_LAS unsigned char* lds, const Gemm g, const Sched& S, const Epi& E) {
    const int tid = threadIdx.x, wid = __builtin_amdgcn_readfirstlane(tid >> 6), lane = tid & 63, wr = wid >> 2, wc = wid & 3, fr = lane & 15, fq = lane >> 4;
    const int K = g.K, nt = K / BK;
    unsigned voffA[2], voffB[2];
#pragma unroll
    for (int i = 0; i < 2; ++i) { int R, C; stage_rc(tid * 16 + i * 8192, R, C); const int Rb = Epi::PERM ? ((R & ~31) + perm32(R & 31)) : R;
        voffA[i] = (unsigned)(R * K + C) * 2u; voffB[i] = (unsigned)(Rb * K + C) * 2u; }
    const size_t kstep = (size_t)(BK * 2);
    const size_t hstep = (size_t)HALF * K * 2;
    const size_t tstep = 2 * hstep;
    const unsigned ldsw = (unsigned)wid * 1024u;
    const int aoff = lds_byte(wr * 64 + fr, fq * 8), boff = lds_byte(wc * 32 + fr, fq * 8);
#define PG8_SA(b, h) (((b) * 2 + (h)) * HTB)
#define PG8_SB(b, h) ((4 + (b) * 2 + (h)) * HTB)
#define PG8_STAGE(bufoff, gbase, voff) do { _Pragma("unroll") for (int _i = 0; _i < 2; ++_i) \
        __builtin_amdgcn_global_load_lds((const unsigned*)((const char*)(gbase) + (voff)[_i]), (PG8_LAS unsigned*)(lds + (bufoff) + ldsw + _i * 8192), 16, 0, 0); } while (0)
#define PG8_LDA(dst, b, h) do { _Pragma("unroll") for (int m = 0; m < 4; ++m) _Pragma("unroll") for (int k = 0; k < 2; ++k) dst[m][k] = *(const PG8_LAS bf16x8*)(lds + PG8_SA(b, h) + aoff + m * 2048 + k * 1024); } while (0)
#define PG8_LDB(dst, b, h) do { _Pragma("unroll") for (int n = 0; n < 2; ++n) _Pragma("unroll") for (int k = 0; k < 2; ++k) dst[n][k] = *(const PG8_LAS bf16x8*)(lds + PG8_SB(b, h) + boff + n * 2048 + k * 1024); } while (0)
#define PG8_MMA(ai, bj, At, Bt) do { __builtin_amdgcn_s_setprio(1); _Pragma("unroll") for (int m = 0; m < 4; ++m) _Pragma("unroll") for (int n = 0; n < 2; ++n) _Pragma("unroll") for (int k = 0; k < 2; ++k) \
        acc[ai][bj][m][n] = __builtin_amdgcn_mfma_f32_16x16x32_bf16(Bt[n][k], At[m][k], acc[ai][bj][m][n], 0, 0, 0); __builtin_amdgcn_s_setprio(0); } while (0)
#define PG8_WAIT_V(n) asm volatile("s_waitcnt vmcnt(" #n ")" ::: "memory")
#define PG8_WAIT_L(n) asm volatile("s_waitcnt lgkmcnt(" #n ")" ::: "memory")
#define PG8_BAR __builtin_amdgcn_s_barrier()
#define PG8_SCHED __builtin_amdgcn_sched_barrier(0)
    Unit cur, nxt; int ui = 0;
    if (!S.next(0, cur)) return;
    f32x4 acc[2][2][4][2];
#pragma unroll
    for (int a = 0; a < 2; ++a)
#pragma unroll
        for (int b = 0; b < 2; ++b)
#pragma unroll
            for (int m = 0; m < 4; ++m)
#pragma unroll
                for (int n = 0; n < 2; ++n) acc[a][b][m][n] = (f32x4){0.f, 0.f, 0.f, 0.f};
    bf16x8 At[4][2], B0[2][2], B1[2][2];
    const char* cA = (const char*)g.A + (size_t)cur.pm * tstep; const char* cB = (const char*)g.Bt + (size_t)cur.pn * tstep;
    S.a_ready(cur);
    if constexpr (SP2) {
        PG8_STAGE(PG8_SB(0, 0), cB, voffB); PG8_STAGE(PG8_SB(0, 1), cB + hstep, voffB); PG8_STAGE(PG8_SA(0, 0), cA, voffA); PG8_STAGE(PG8_SA(0, 1), cA + hstep, voffA);
        if (wr == 1) PG8_BAR;
        PG8_WAIT_V(2); PG8_BAR;
        PG8_STAGE(PG8_SB(1, 0), cB + kstep, voffB); PG8_STAGE(PG8_SA(1, 0), cA + kstep, voffA); PG8_STAGE(PG8_SB(1, 1), cB + hstep + kstep, voffB);
        PG8_WAIT_V(6); PG8_BAR;
    } else {
        PG8_STAGE(PG8_SB(0, 0), cB, voffB); PG8_STAGE(PG8_SA(0, 0), cA, voffA); PG8_STAGE(PG8_SB(0, 1), cB + hstep, voffB); PG8_STAGE(PG8_SA(0, 1), cA + hstep, voffA);
        if (wr == 1) PG8_BAR;
        PG8_WAIT_V(4); PG8_BAR;
        PG8_STAGE(PG8_SB(1, 0), cB + kstep, voffB); PG8_STAGE(PG8_SA(1, 0), cA + kstep, voffA); PG8_STAGE(PG8_SB(1, 1), cB + hstep + kstep, voffB);
        PG8_WAIT_V(6); PG8_BAR;
    }
    for (;;) {
        const bool has_next = S.next(ui + 1, nxt);
        const char* nA = has_next ? (const char*)g.A + (size_t)nxt.pm * tstep : cA; const char* nB = has_next ? (const char*)g.Bt + (size_t)nxt.pn * tstep : cB;
        for (int t = 0; t < nt; t += 2) {
            const bool last = (t == nt - 2);
            const char* a1 = cA + (size_t)(t + 1) * kstep;
            const char* a2 = last ? nA : cA + (size_t)(t + 2) * kstep; const char* b2 = last ? nB : cB + (size_t)(t + 2) * kstep;
            const char* a3 = a2 + kstep; const char* b3 = b2 + kstep;
            if (last && has_next) S.a_ready(nxt);
            if constexpr (SP2) {
            PG8_LDB(B0, 0, 0); PG8_LDB(B1, 0, 1); PG8_SCHED; PG8_LDA(At, 0, 0); PG8_STAGE(PG8_SA(1, 1), a1 + hstep, voffA);
            PG8_WAIT_V(8); PG8_WAIT_L(0); PG8_BAR; PG8_MMA(0, 0, At, B0); PG8_MMA(0, 1, At, B1); PG8_BAR; PG8_SCHED;
            PG8_LDA(At, 0, 1); PG8_STAGE(PG8_SB(0, 0), b2, voffB); PG8_STAGE(PG8_SB(0, 1), b2 + hstep, voffB); PG8_STAGE(PG8_SA(0, 0), a2, voffA);
            PG8_WAIT_V(8); PG8_WAIT_L(0); PG8_BAR; PG8_MMA(1, 0, At, B0); PG8_MMA(1, 1, At, B1); PG8_BAR; PG8_SCHED;
            PG8_LDB(B0, 1, 0); PG8_LDB(B1, 1, 1); PG8_SCHED; PG8_LDA(At, 1, 0); PG8_STAGE(PG8_SA(0, 1), a2 + hstep, voffA);
            PG8_WAIT_V(8); PG8_WAIT_L(0); PG8_BAR; PG8_MMA(0, 0, At, B0); PG8_MMA(0, 1, At, B1); PG8_BAR; PG8_SCHED;
            PG8_LDA(At, 1, 1); PG8_STAGE(PG8_SB(1, 0), b3, voffB); PG8_STAGE(PG8_SB(1, 1), b3 + hstep, voffB); PG8_STAGE(PG8_SA(1, 0), a3, voffA);
            PG8_WAIT_V(8); PG8_WAIT_L(0); PG8_BAR; PG8_MMA(1, 0, At, B0); PG8_MMA(1, 1, At, B1); PG8_BAR; PG8_SCHED;
            } else {
            PG8_LDB(B0, 0, 0); PG8_SCHED; PG8_LDA(At, 0, 0); PG8_STAGE(PG8_SA(1, 1), a1 + hstep, voffA);
            PG8_WAIT_L(8); PG8_BAR; PG8_WAIT_L(0); PG8_MMA(0, 0, At, B0); PG8_BAR; PG8_SCHED;
            PG8_LDB(B1, 0, 1); PG8_STAGE(PG8_SB(0, 0), b2, voffB);
            PG8_BAR; PG8_WAIT_L(0); PG8_MMA(0, 1, At, B1); PG8_BAR;
            PG8_LDA(At, 0, 1); PG8_STAGE(PG8_SA(0, 0), a2, voffA);
            PG8_BAR; PG8_WAIT_L(0); PG8_MMA(1, 0, At, B0); PG8_BAR; PG8_SCHED;
            PG8_STAGE(PG8_SB(0, 1), b2 + hstep, voffB);
            PG8_WAIT_V(6); PG8_BAR; PG8_MMA(1, 1, At, B1); PG8_BAR;
            PG8_LDB(B0, 1, 0); PG8_SCHED; PG8_LDA(At, 1, 0); PG8_STAGE(PG8_SA(0, 1), a2 + hstep, voffA);
            PG8_WAIT_L(8); PG8_BAR; PG8_WAIT_L(0); PG8_MMA(0, 0, At, B0); PG8_BAR; PG8_SCHED;
            PG8_LDB(B1, 1, 1); PG8_STAGE(PG8_SB(1, 0), b3, voffB);
            PG8_BAR; PG8_WAIT_L(0); PG8_MMA(0, 1, At, B1); PG8_BAR;
            PG8_LDA(At, 1, 1); PG8_STAGE(PG8_SA(1, 0), a3, voffA);
            PG8_BAR; PG8_WAIT_L(0); PG8_MMA(1, 0, At, B0); PG8_BAR; PG8_SCHED;
            PG8_STAGE(PG8_SB(1, 1), b3 + hstep, voffB);
            PG8_WAIT_V(6); PG8_BAR; PG8_MMA(1, 1, At, B1); PG8_BAR;
            }
        }
        if constexpr (ALIGN_EPI) { if (wr == 0) PG8_BAR; }
        if constexpr (!Epi::AFTER_DRAIN) { E(acc, cur, wr, wc, fr, fq); S.done(cur); }
        if (!has_next) break;
#pragma unroll
        for (int a = 0; a < 2; ++a)
#pragma unroll
            for (int b = 0; b < 2; ++b)
#pragma unroll
                for (int m = 0; m < 4; ++m)
#pragma unroll
                    for (int n = 0; n < 2; ++n) acc[a][b][m][n] = (f32x4){0.f, 0.f, 0.f, 0.f};
        cur = nxt; cA = nA; cB = nB; ++ui;
        if constexpr (ALIGN_EPI) { if (wr == 1) PG8_BAR; }
    }
    PG8_WAIT_V(0);
    if constexpr (!ALIGN_EPI) { if (wr == 0) PG8_BAR; }
    PG8_BAR;
    if constexpr (Epi::AFTER_DRAIN) { E.fused(acc, cur, wr, wc, fr, fq, lds, wid, lane); S.done(cur); }
#undef PG8_SA
#undef PG8_SB
#undef PG8_STAGE
#undef PG8_LDA
#undef PG8_LDB
#undef PG8_MMA
#undef PG8_WAIT_V
#undef PG8_WAIT_L
#undef PG8_BAR
#undef PG8_SCHED
}
}

#ifndef PG8_SP2
#define PG8_SP2 true
#endif
#ifndef PG8_ALIGN
#define PG8_ALIGN true
#endif
#define GAS __attribute__((address_space(1)))
#define LAS __attribute__((address_space(3)))
typedef unsigned short bf16;
typedef unsigned v4u __attribute__((ext_vector_type(4)));
typedef float f32x4 __attribute__((ext_vector_type(4)));
typedef short bf16x8 __attribute__((ext_vector_type(8)));
typedef GAS unsigned gu32;
typedef GAS unsigned long long gu64;
#define RLX_AGENT __ATOMIC_RELAXED, __HIP_MEMORY_SCOPE_AGENT
#define LDS_WAIT() asm volatile("s_waitcnt lgkmcnt(0)" ::: "memory")
#define VM_WAIT() asm volatile("s_waitcnt vmcnt(0)" ::: "memory")
__device__ __forceinline__ unsigned long long rt() { return __builtin_amdgcn_s_memrealtime(); }
__device__ __forceinline__ unsigned f2bf(float f) { unsigned u = __builtin_bit_cast(unsigned, f); return (u + 0x7fffu + ((u >> 16) & 1u)) >> 16; }
__device__ __forceinline__ unsigned pk2(float lo, float hi) { return f2bf(lo) | (f2bf(hi) << 16); }

#define XB_TMO      128
#define XB_XCNT(j)  (256  + 64 * (j))
#define XB_XSUB(j)  (1280 + 64 * (j))
#define XB_XGEN(j)  (2304 + 64 * (j))
#define XB_TOP      3328
#define XB_TOPGEN   3392
#define XCD_BAR_WORDS 3456
#define XB_SPIN_CAP (1u << 22)

__device__ __forceinline__ unsigned xb_ld(unsigned* p)              { return __hip_atomic_load(p, __ATOMIC_RELAXED, __HIP_MEMORY_SCOPE_AGENT); }
__device__ __forceinline__ unsigned xb_add(unsigned* p, unsigned v) { return __hip_atomic_fetch_add(p, v, __ATOMIC_RELAXED, __HIP_MEMORY_SCOPE_AGENT); }
__device__ __forceinline__ unsigned xb_xcc_id() { return (unsigned)__builtin_amdgcn_s_getreg((3 << 11) | 20) & 0xFu; }
#define XB_SPIN(cond, bar) do { unsigned _sp = 0; while (cond) { __builtin_amdgcn_s_sleep(1); \
    if ((++_sp & 255u) == 0u) { if (xb_ld(&(bar)[XB_TMO])) break; if (_sp > XB_SPIN_CAP) { atomicAdd(&(bar)[XB_TMO], 1u); break; } } } } while (0)

struct XcdBarrier {
    unsigned* bar; unsigned x;
    volatile LAS unsigned* st;
};

__device__ __forceinline__ XcdBarrier xcd_barrier_post(unsigned* bar, volatile LAS unsigned* st) {
    XcdBarrier b; b.bar = bar; b.x = xb_xcc_id(); b.st = st;
    if (threadIdx.x == 0) (void)xb_add(&bar[XB_XCNT(b.x)], 1u);
    return b;
}
__device__ __forceinline__ void xcd_barrier_complete(unsigned* bar, unsigned x, unsigned& nloc, unsigned& nx) {
    const unsigned G = gridDim.x * gridDim.y * gridDim.z;
    unsigned sum, cnt, mine, sp = 0u;
    for (;;) {
        sum = 0u; cnt = 0u; mine = 0u;
#pragma unroll
        for (unsigned j = 0; j < 16; ++j) { const unsigned c = xb_ld(&bar[XB_XCNT(j)]); sum += c; cnt += (c > 0u) ? 1u : 0u; mine = (j == x) ? c : mine; }
        if (sum == G) break;
        __builtin_amdgcn_s_sleep(1);
        if ((++sp & 255u) == 0u) { if (xb_ld(&bar[XB_TMO])) break; if (sp > XB_SPIN_CAP) { atomicAdd(&bar[XB_TMO], 1u); break; } }
    }
    nloc = mine > 0u ? mine : 1u; nx = cnt > 0u ? cnt : 1u;
}

__device__ __forceinline__ void xcd_barrier(const XcdBarrier& b) {
    asm volatile("s_waitcnt vmcnt(0)" ::: "memory");
    __syncthreads();
    if (threadIdx.x == 0) {
        unsigned* bar = b.bar;
        __builtin_amdgcn_s_waitcnt(0);
        unsigned nloc = b.st[0], nx = b.st[1];
        if (nloc == 0u) { xcd_barrier_complete(bar, b.x, nloc, nx); b.st[0] = nloc; b.st[1] = nx; }
        const unsigned old = xb_add(&bar[XB_XSUB(b.x)], 1u);
        const unsigned gen = old / nloc;
        if (old + 1u == (gen + 1u) * nloc) {
            __builtin_amdgcn_fence(__ATOMIC_RELEASE, "agent");
            asm volatile("s_waitcnt vmcnt(0)" ::: "memory");
            const unsigned og = xb_add(&bar[XB_TOP], 1u);
            const unsigned tg = og / nx;
            if (og + 1u == (tg + 1u) * nx) xb_add(&bar[XB_TOPGEN], 1u);
            else XB_SPIN(xb_ld(&bar[XB_TOPGEN]) == tg, bar);
            __builtin_amdgcn_fence(__ATOMIC_ACQUIRE, "agent");
            xb_add(&bar[XB_XGEN(b.x)], 1u);
            asm volatile("s_waitcnt vmcnt(0)" ::: "memory");
        } else {
            XB_SPIN(xb_ld(&bar[XB_XGEN(b.x)]) == gen, bar);
            __builtin_amdgcn_fence(__ATOMIC_ACQUIRE, "agent");
            asm volatile("s_waitcnt vmcnt(0)" ::: "memory");
        }
    }
    __syncthreads();
}


constexpr int NWAVES = 8;
constexpr int BATCH = 16, SEQ = 2048, D = 1024, M = BATCH * SEQ;
constexpr int EVEN_IN = 3712, EVEN_PAD = 3840, ODD_IN = 2304;
constexpr int C_R = 0, C_K = 512, C_V = 1024, C_WLO = 1536, C_ALO = 1600, C_U = 1664, C_VG = 2176, C_Z0 = 2688;
constexpr int C_Q = 0, C_KC = 1024, C_VC = 1152, C_Z1 = 1280;
enum { I_X = 0, I_C, I_ADAW, I_ADAB, I_NORMG, I_EWIN, I_EMU, I_EW0, I_EWUP, I_EA0, I_EAUP, I_EKK, I_EKA, I_ERK, I_ELNXG, I_ELNXB, I_ESGLNG, I_ESGLNB, I_ESGW, I_ESGB, I_EWOUT, I_OWIN, I_OSINKS, I_OWOUT, I_FINALG, N_IN };

constexpr size_t MiB = 1u << 20;
constexpr size_t WS_CTL = 0, CTL_ZERO_BYTES = 64 * 1024;
constexpr size_t WS_MOD = 1 * MiB;
constexpr size_t WS_WIN0 = 2 * MiB, WS_WOUT0 = 10 * MiB, WS_WIN1 = 12 * MiB, WS_WOUT1 = 17 * MiB;
constexpr size_t WS_XN = 32 * MiB, WS_MIX = 96 * MiB, WS_P = 160 * MiB, WS_YRAW = 400 * MiB, WS_BON = 464 * MiB, WS_END = 507 * MiB;
constexpr size_t WS_RING = 400 * MiB;
constexpr size_t WS_ROWSS = 22 * MiB, WS_BIAS3 = 25 * MiB;
constexpr size_t WS_WUT = 20 * MiB, WS_AUT = 21 * MiB;
constexpr int CW_BAR = 4096;

constexpr int RING_BYTES = 131072, LDS_BYTES = 147456, LDSCTL_OFF = LDS_BYTES - 512, MISC_OFF = LDSCTL_OFF;

__device__ __forceinline__ float bf2f(unsigned short h) { return __builtin_bit_cast(float, (unsigned)h << 16); }
__device__ __forceinline__ float bflo(unsigned w) { return __builtin_bit_cast(float, w << 16); }
__device__ __forceinline__ float bfhi(unsigned w) { return __builtin_bit_cast(float, w & 0xffff0000u); }
__device__ __forceinline__ float wave_sum(float v) {
#pragma unroll
    for (int o = 1; o < 64; o <<= 1) v += __shfl_xor(v, o);
    return v;
}
__device__ __forceinline__ float siluf(float x) { return x / (1.f + __expf(-x)); }
#define DPP_ADD(x, ctrl) x += __builtin_bit_cast(float, __builtin_amdgcn_update_dpp(0, __builtin_bit_cast(int, x), ctrl, 0xF, 0xF, true))
__device__ __forceinline__ float row_sum16(float x) { DPP_ADD(x, 0xB1); DPP_ADD(x, 0x4E); DPP_ADD(x, 0x124); DPP_ADD(x, 0x128); return x; }
__device__ __forceinline__ float wave_sum_fast(float x) { x = row_sum16(x);
    const int xi = __builtin_bit_cast(int, x);
    return (__builtin_bit_cast(float, __builtin_amdgcn_readlane(xi, 0)) + __builtin_bit_cast(float, __builtin_amdgcn_readlane(xi, 16))) + (__builtin_bit_cast(float, __builtin_amdgcn_readlane(xi, 32)) + __builtin_bit_cast(float, __builtin_amdgcn_readlane(xi, 48))); }

struct Args { const float* in[N_IN]; float* out; unsigned char* ws; int ph_lo, ph_hi; };

__device__ __forceinline__ void p0_transpose_item(const float* W, int K, int N, bf16* WT, LAS float* scr, int item, int lane) {
    const int nblk = N / 32, kb = item / nblk, nb = item % nblk, k0 = 64 * kb, n0 = 32 * nb;
#pragma unroll 8
    for (int i = 0; i < 32; ++i) { const int kk = 2 * i + (lane >> 5); scr[kk * 33 + (lane & 31)] = W[(size_t)(k0 + kk) * N + n0 + (lane & 31)]; }
    LDS_WAIT(); asm volatile("" ::: "memory");
    const int c = lane & 7;
#pragma unroll
    for (int j = 0; j < 4; ++j) { const int n = (lane >> 3) + 8 * j; const LAS float* s = scr + (8 * c) * 33 + n;
        v4u o; o.x = pk2(s[0 * 33], s[1 * 33]); o.y = pk2(s[2 * 33], s[3 * 33]); o.z = pk2(s[4 * 33], s[5 * 33]); o.w = pk2(s[6 * 33], s[7 * 33]);
        *(GAS v4u*)(WT + (size_t)(n0 + n) * K + k0 + 8 * c) = o; }
    LDS_WAIT(); asm volatile("" ::: "memory");
}
__device__ __forceinline__ void phase0(const Args& a, LAS unsigned char* lds, int tid, int lane, int wave, int vcu, int G) {
    unsigned char* ws = a.ws;
    if (vcu < 96) {
        LAS float* condT = (LAS float*)lds;
        LAS float* part = (LAS float*)(lds + 65536);
        const float* c = a.in[I_C];
        for (int idx = tid; idx < 16384; idx += 512) { const int b = idx >> 10, k = idx & 1023; condT[k * 16 + b] = siluf(c[idx]); }
        __syncthreads();
        for (int it = vcu; it < 96; it += G) {
            const int l = it / 48, n0 = (it % 48) * 64;
            const float* W = a.in[I_ADAW] + (size_t)l * 1024 * 3072 + n0 + lane;
            float acc[16];
#pragma unroll
            for (int b = 0; b < 16; ++b) acc[b] = 0.f;
            const int kbeg = wave * 128;
#pragma unroll 32
            for (int k = kbeg; k < kbeg + 128; ++k) {
                const float w = W[(size_t)k * 3072];
                const LAS f32x4* cv = (const LAS f32x4*)(condT + k * 16);
                const f32x4 c0 = cv[0], c1 = cv[1], c2 = cv[2], c3 = cv[3];
                acc[0] += c0[0] * w; acc[1] += c0[1] * w; acc[2] += c0[2] * w; acc[3] += c0[3] * w;
                acc[4] += c1[0] * w; acc[5] += c1[1] * w; acc[6] += c1[2] * w; acc[7] += c1[3] * w;
                acc[8] += c2[0] * w; acc[9] += c2[1] * w; acc[10] += c2[2] * w; acc[11] += c2[3] * w;
                acc[12] += c3[0] * w; acc[13] += c3[1] * w; acc[14] += c3[2] * w; acc[15] += c3[3] * w;
            }
#pragma unroll
            for (int b = 0; b < 16; ++b) part[(wave * 16 + b) * 64 + lane] = acc[b];
            __syncthreads();
            float* mod = (float*)(ws + WS_MOD);
#pragma unroll
            for (int q = 0; q < 2; ++q) { const int b = (tid >> 6) + 8 * q; float s = 0.f;
#pragma unroll
                for (int w8 = 0; w8 < 8; ++w8) s += part[(w8 * 16 + b) * 64 + lane];
                mod[(size_t)(l * 16 + b) * 3072 + n0 + lane] = s + a.in[I_ADAB][l * 3072 + n0 + lane]; }
            __syncthreads();
        }
    }
    __syncthreads();
    LAS float* scr = (LAS float*)(lds + wave * 16384);
    const bool split = (G > 128);
    if (split && vcu < 96) return;
    const int gw = (split ? vcu - 96 : vcu) * NWAVES + wave, NGW = (split ? G - 96 : G) * NWAVES;
    constexpr int I0 = (D / 64) * (EVEN_IN / 32), I1 = (D / 64) * (D / 32), I2 = (D / 64) * (ODD_IN / 32), I3 = I1, IZ = EVEN_PAD - EVEN_IN;
    for (int it = gw; it < I0 + I1 + I2 + I3 + IZ; it += NGW) {
        int r = it;
        if (r < I0) { p0_transpose_item(a.in[I_EWIN], D, EVEN_IN, (bf16*)(ws + WS_WIN0), scr, r, lane); continue; } r -= I0;
        if (r < I1) { p0_transpose_item(a.in[I_EWOUT], D, D, (bf16*)(ws + WS_WOUT0), scr, r, lane); continue; } r -= I1;
        if (r < I2) { p0_transpose_item(a.in[I_OWIN], D, ODD_IN, (bf16*)(ws + WS_WIN1), scr, r, lane); continue; } r -= I2;
        if (r < I3) { p0_transpose_item(a.in[I_OWOUT], D, D, (bf16*)(ws + WS_WOUT1), scr, r, lane); continue; } r -= I3;
        { GAS v4u* o = (GAS v4u*)((bf16*)(ws + WS_WIN0) + (size_t)(EVEN_IN + r) * D); const v4u z = {0u, 0u, 0u, 0u}; o[lane] = z; o[lane + 64] = z; }
    }
    for (int idx = gw * 64 + lane; idx < 512 * 64; idx += NGW * 64) { const int n = idx >> 6, m = idx & 63;
        ((bf16*)(ws + WS_WUT))[idx] = (bf16)f2bf(a.in[I_EWUP][m * 512 + n]); ((bf16*)(ws + WS_AUT))[idx] = (bf16)f2bf(a.in[I_EAUP][m * 512 + n]); }
}

__device__ __forceinline__ void phase_adaln_rows(const float* xin, const float* g, const float* modl, bf16* XN, int lane, int wave, int vcu, int G) {
    const int gw = vcu * NWAVES + wave, NGW = G * NWAVES;
    for (int r0 = gw * 16; r0 < M; r0 += NGW * 16) {
        const int b = r0 >> 11;
        f32x4 gs[4], sh[4];
#pragma unroll
        for (int j = 0; j < 4; ++j) { const int c = 4 * lane + 256 * j;
            const f32x4 gg = *(const f32x4*)(g + c), sc = *(const f32x4*)(modl + (size_t)b * 3072 + 1024 + c);
            gs[j] = gg * (sc + 1.0f); sh[j] = *(const f32x4*)(modl + (size_t)b * 3072 + c); }
        f32x4 nx[4];
        { const GAS f32x4* xr = (const GAS f32x4*)(xin + (size_t)r0 * D) + lane;
#pragma unroll
          for (int j = 0; j < 4; ++j) nx[j] = xr[64 * j]; }
        for (int r = r0; r < r0 + 16; ++r) {
            f32x4 v[4];
#pragma unroll
            for (int j = 0; j < 4; ++j) v[j] = nx[j];
            if (r + 1 < r0 + 16) { const GAS f32x4* xr = (const GAS f32x4*)(xin + (size_t)(r + 1) * D) + lane;
#pragma unroll
                for (int j = 0; j < 4; ++j) nx[j] = xr[64 * j]; }
            float s = 0.f;
#pragma unroll
            for (int j = 0; j < 4; ++j) s += (v[j].x * v[j].x + v[j].y * v[j].y) + (v[j].z * v[j].z + v[j].w * v[j].w);
            const float rs = 1.0f / sqrtf(wave_sum_fast(s) * (1.f / D) + 1e-6f);
            GAS unsigned long long* o8 = (GAS unsigned long long*)(XN + (size_t)r * D) + lane;
#pragma unroll
            for (int j = 0; j < 4; ++j) { const f32x4 o = v[j] * rs * gs[j] + sh[j];
                o8[64 * j] = (unsigned long long)pk2(o.x, o.y) | ((unsigned long long)pk2(o.z, o.w) << 32); }
        }
    }
}
__device__ __forceinline__ void phase_bias3(const Args& a, LAS unsigned char* lds, int tid, int lane, int wave, int vcu, int G) {
    if (vcu >= ODD_IN / 64) return;
    LAS float* shT = (LAS float*)lds;
    LAS float* part = (LAS float*)(lds + 65536);
    const float* mod1 = (const float*)(a.ws + WS_MOD) + 16 * 3072;
    __syncthreads();
    for (int idx = tid; idx < 16384; idx += 512) { const int b = idx >> 10, k = idx & 1023; shT[k * 16 + b] = mod1[(size_t)b * 3072 + k]; }
    __syncthreads();
    for (int it = vcu; it < ODD_IN / 64; it += G) {
        const int n0 = it * 64; const float* W = a.in[I_OWIN] + n0 + lane;
        float acc[16];
#pragma unroll
        for (int b = 0; b < 16; ++b) acc[b] = 0.f;
        const int kbeg = wave * 128;
#pragma unroll 32
        for (int k = kbeg; k < kbeg + 128; ++k) {
            const float w = W[(size_t)k * ODD_IN];
            const LAS f32x4* cv = (const LAS f32x4*)(shT + k * 16);
            const f32x4 c0 = cv[0], c1 = cv[1], c2 = cv[2], c3 = cv[3];
            acc[0] += c0[0] * w; acc[1] += c0[1] * w; acc[2] += c0[2] * w; acc[3] += c0[3] * w;
            acc[4] += c1[0] * w; acc[5] += c1[1] * w; acc[6] += c1[2] * w; acc[7] += c1[3] * w;
            acc[8] += c2[0] * w; acc[9] += c2[1] * w; acc[10] += c2[2] * w; acc[11] += c2[3] * w;
            acc[12] += c3[0] * w; acc[13] += c3[1] * w; acc[14] += c3[2] * w; acc[15] += c3[3] * w;
        }
#pragma unroll
        for (int b = 0; b < 16; ++b) part[(wave * 16 + b) * 64 + lane] = acc[b];
        __syncthreads();
        float* bias3 = (float*)(a.ws + WS_BIAS3);
#pragma unroll
        for (int q = 0; q < 2; ++q) { const int b = (tid >> 6) + 8 * q; float s = 0.f;
#pragma unroll
            for (int w8 = 0; w8 < 8; ++w8) s += part[(w8 * 16 + b) * 64 + lane];
            bias3[(size_t)b * ODD_IN + n0 + lane] = s; }
        __syncthreads();
    }
}
__device__ __forceinline__ void phase_final_rows(float* xio, const float* g, int lane, int wave, int vcu, int G) {
    const int gw = vcu * NWAVES + wave, NGW = G * NWAVES;
    f32x4 gs[4];
#pragma unroll
    for (int j = 0; j < 4; ++j) gs[j] = *(const f32x4*)(g + 4 * lane + 256 * j);
    for (int r = gw; r < M; r += NGW) {
        GAS f32x4* xr = (GAS f32x4*)(xio + (size_t)r * D) + lane;
        f32x4 v[4]; float s = 0.f;
#pragma unroll
        for (int j = 0; j < 4; ++j) { v[j] = xr[64 * j]; s += (v[j].x * v[j].x + v[j].y * v[j].y) + (v[j].z * v[j].z + v[j].w * v[j].w); }
        const float rs = 1.0f / sqrtf(wave_sum(s) * (1.f / D) + 1e-6f);
#pragma unroll
        for (int j = 0; j < 4; ++j) xr[64 * j] = v[j] * rs * gs[j];
    }
}

__device__ __forceinline__ void phase_rwkv(const Args& a, LAS unsigned char* lds, int tid, int lane, int wave, int vcu, int G) {
    const bf16* P = (const bf16*)(a.ws + WS_P); bf16* MIX = (bf16*)(a.ws + WS_MIX);
    LAS float* WUP = (LAS float*)lds;
    LAS float* AUP = WUP + 4096;
    LAS float* TW = AUP + 4096;
    LAS float* AL = TW + 2048;
    LAS float* Rr = AL + 2048;
    LAS float* KR = Rr + 2048;
    LAS float* Vv = KR + 2048;
    LAS float* Wd = Vv + 2048;
    LAS float* KK = Wd + 2048;
    LAS float* Bb = KK + 2048;
    LAS float* Yy = Bb + 2048;
    LAS float* BON = Yy + 2048;
    for (int unit = vcu; unit < BATCH * 8; unit += G) {
        const int b = unit >> 3, h = unit & 7;
        __syncthreads();
        for (int idx = tid; idx < 4096; idx += 512) { const int m = idx >> 6, j = idx & 63; WUP[idx] = a.in[I_EWUP][m * 512 + h * 64 + j]; AUP[idx] = a.in[I_EAUP][m * 512 + h * 64 + j]; }
        float S[8];
#pragma unroll
        for (int j = 0; j < 8; ++j) S[j] = 0.f;
        const int hj = h * 64 + lane;
        const float w0 = a.in[I_EW0][hj], a0 = a.in[I_EA0][hj], k_k = a.in[I_EKK][hj], k_a = a.in[I_EKA][hj], r_k = a.in[I_ERK][hj], lng = a.in[I_ELNXG][hj], lnb = a.in[I_ELNXB][hj];
        for (int ck = 0; ck < SEQ / 32; ++ck) {
            const int t0 = ck * 32;
            { const int i = tid >> 4, sub = tid & 15; const int t = t0 + i; const bf16* pc = P + (size_t)(b * SEQ + t) * EVEN_PAD; const bf16* pp = pc - EVEN_PAD; const bool hasp = t > 0;
#pragma unroll
              for (int grp = 0; grp < 5; ++grp) {
                  const int col = (grp == 0 ? C_R + h * 64 : grp == 1 ? C_K + h * 64 : grp == 2 ? C_V + h * 64 : grp == 3 ? C_WLO : C_ALO) + 4 * sub;
                  const uint2 cu = *(const uint2*)(pc + col); uint2 pu = {0u, 0u}; if (hasp) pu = *(const uint2*)(pp + col);
                  const f32x4 mu = *(const f32x4*)(a.in[I_EMU] + col);
                  float cv[4] = {bflo(cu.x), bfhi(cu.x), bflo(cu.y), bfhi(cu.y)}, pv[4] = {bflo(pu.x), bfhi(pu.x), bflo(pu.y), bfhi(pu.y)};
                  f32x4 xs;
#pragma unroll
                  for (int e = 0; e < 4; ++e) xs[e] = cv[e] + mu[e] * (pv[e] - cv[e]);
                  if (grp == 3) { xs[0] = tanhf(xs[0]); xs[1] = tanhf(xs[1]); xs[2] = tanhf(xs[2]); xs[3] = tanhf(xs[3]); }
                  LAS float* dst = (grp == 0 ? Rr : grp == 1 ? KR : grp == 2 ? Vv : grp == 3 ? TW : AL) + i * 64 + 4 * sub;
                  *(LAS f32x4*)dst = xs;
              } }
            __syncthreads();
            { float accw[4] = {0.f, 0.f, 0.f, 0.f}, acca[4] = {0.f, 0.f, 0.f, 0.f};
              for (int m4 = 0; m4 < 16; ++m4) {
                  f32x4 tw[4], al[4];
#pragma unroll
                  for (int q = 0; q < 4; ++q) { tw[q] = *(const LAS f32x4*)(TW + (wave + 8 * q) * 64 + 4 * m4); al[q] = *(const LAS f32x4*)(AL + (wave + 8 * q) * 64 + 4 * m4); }
#pragma unroll
                  for (int e = 0; e < 4; ++e) { const float wu = WUP[(4 * m4 + e) * 64 + lane], au = AUP[(4 * m4 + e) * 64 + lane];
#pragma unroll
                      for (int q = 0; q < 4; ++q) { accw[q] += tw[q][e] * wu; acca[q] += al[q][e] * au; } }
              }
#pragma unroll
              for (int q = 0; q < 4; ++q) { const int i = wave + 8 * q;
                  const float wv = w0 + accw[q];
                  const float nx = -wv; const float sp = fmaxf(nx, 0.f) + log1pf(__expf(-fabsf(nx)));
                  const float wl = -sp - 0.5f; const float decay = __expf(-__expf(wl));
                  const float av = 1.f / (1.f + __expf(-(a0 + acca[q])));
                  const float kraw = KR[i * 64 + lane]; const float kkv = kraw * k_k;
                  const float ss = wave_sum(kkv * kkv); const float kk = kkv / fmaxf(sqrtf(ss), 1e-12f);
                  const float kp = kraw * (1.f + (av - 1.f) * k_a);
                  const float bon = wave_sum(Rr[i * 64 + lane] * kp * r_k);
                  Wd[i * 64 + lane] = decay; KR[i * 64 + lane] = kp; KK[i * 64 + lane] = kk; Bb[i * 64 + lane] = kk * av; if (lane == 0) BON[i] = bon; } }
            __syncthreads();
            { const int row = wave * 8 + (lane >> 3), c8 = (lane & 7) * 8;
              for (int i = 0; i < 32; ++i) {
                  const f32x4 k0 = *(const LAS f32x4*)(KK + i * 64 + c8), k1 = *(const LAS f32x4*)(KK + i * 64 + c8 + 4);
                  const f32x4 w0v = *(const LAS f32x4*)(Wd + i * 64 + c8), w1v = *(const LAS f32x4*)(Wd + i * 64 + c8 + 4);
                  const f32x4 b0 = *(const LAS f32x4*)(Bb + i * 64 + c8), b1 = *(const LAS f32x4*)(Bb + i * 64 + c8 + 4);
                  const f32x4 p0 = *(const LAS f32x4*)(KR + i * 64 + c8), p1 = *(const LAS f32x4*)(KR + i * 64 + c8 + 4);
                  const f32x4 r0 = *(const LAS f32x4*)(Rr + i * 64 + c8), r1 = *(const LAS f32x4*)(Rr + i * 64 + c8 + 4);
                  const float vv = Vv[i * 64 + row];
                  float sa = (S[0] * k0[0] + S[1] * k0[1]) + (S[2] * k0[2] + S[3] * k0[3]) + (S[4] * k1[0] + S[5] * k1[1]) + (S[6] * k1[2] + S[7] * k1[3]);
                  sa += __shfl_xor(sa, 1); sa += __shfl_xor(sa, 2); sa += __shfl_xor(sa, 4); sa = -sa;
                  S[0] = S[0] * w0v[0] + sa * b0[0] + vv * p0[0]; S[1] = S[1] * w0v[1] + sa * b0[1] + vv * p0[1];
                  S[2] = S[2] * w0v[2] + sa * b0[2] + vv * p0[2]; S[3] = S[3] * w0v[3] + sa * b0[3] + vv * p0[3];
                  S[4] = S[4] * w1v[0] + sa * b1[0] + vv * p1[0]; S[5] = S[5] * w1v[1] + sa * b1[1] + vv * p1[1];
                  S[6] = S[6] * w1v[2] + sa * b1[2] + vv * p1[2]; S[7] = S[7] * w1v[3] + sa * b1[3] + vv * p1[3];
                  float y = (S[0] * r0[0] + S[1] * r0[1]) + (S[2] * r0[2] + S[3] * r0[3]) + (S[4] * r1[0] + S[5] * r1[1]) + (S[6] * r1[2] + S[7] * r1[3]);
                  y += __shfl_xor(y, 1); y += __shfl_xor(y, 2); y += __shfl_xor(y, 4);
                  if ((lane & 7) == 0) Yy[i * 64 + row] = y;
              } }
            __syncthreads();
#pragma unroll
            for (int q = 0; q < 4; ++q) { const int i = wave * 4 + q; const size_t rowg = (size_t)(b * SEQ + t0 + i);
                const float y = Yy[i * 64 + lane]; const float mean = wave_sum(y) * (1.f / 64.f); const float d = y - mean; const float var = wave_sum(d * d) * (1.f / 64.f);
                const float o = d * (1.0f / sqrtf(var + 64e-5f)) * lng + lnb + BON[i] * Vv[i * 64 + lane];
                const float z = bf2f(P[rowg * EVEN_PAD + C_Z0 + hj]);
                MIX[rowg * D + hj] = (bf16)f2bf(o * siluf(z)); }
            __syncthreads();
        }
    }
}

typedef unsigned u32x2 __attribute__((ext_vector_type(2)));
__device__ __forceinline__ void split_bf(float x, unsigned& hi, unsigned& lo) { hi = f2bf(x); lo = f2bf(x - __builtin_bit_cast(float, hi << 16)); }
__device__ __forceinline__ float fast_tanh(float x) { const float t = __expf(2.f * x); return 1.f - 2.f * __builtin_amdgcn_rcpf(t + 1.f); }
__device__ __forceinline__ void phase_rwkv2(const Args& a, LAS unsigned char* lds, int tid, int lane, int wave, int vcu, int G) {
    const bf16* P = (const bf16*)(a.ws + WS_P); float* YRAW = (float*)(a.ws + WS_YRAW); float* BONG = (float*)(a.ws + WS_BON);
    LAS float* Rr = (LAS float*)lds;
    LAS float* KR = Rr + 2048;
    LAS float* KK = KR + 2048;
    LAS float* Wd = KK + 2048;
    LAS float* Bb = Wd + 2048;
    LAS float* Vv = (LAS float*)(lds + 40960);
    LAS float* Yy = (LAS float*)(lds + 45056);
    LAS bf16* TWh = (LAS bf16*)(lds + 49152);
    LAS bf16* TWl = TWh + 32 * 72;
    LAS bf16* ALh = TWl + 32 * 72;
    LAS bf16* ALl = ALh + 32 * 72;
    LAS bf16* WUh = (LAS bf16*)(lds + 67584);
    LAS bf16* WUl = WUh + 64 * 72;
    LAS bf16* AUh = WUl + 64 * 72;
    LAS bf16* AUl = AUh + 64 * 72;
    for (int unit = vcu; unit < BATCH * 16; unit += G) {
        const int bh = unit >> 1, half = unit & 1, b = bh >> 3, h = bh & 7;
        __syncthreads();
        for (int idx = tid; idx < 4096; idx += 512) { const int m = idx >> 6, j = idx & 63; unsigned hi, lo;
            split_bf(a.in[I_EWUP][m * 512 + h * 64 + j], hi, lo); WUh[j * 72 + m] = (bf16)hi; WUl[j * 72 + m] = (bf16)lo;
            split_bf(a.in[I_EAUP][m * 512 + h * 64 + j], hi, lo); AUh[j * 72 + m] = (bf16)hi; AUl[j * 72 + m] = (bf16)lo; }
        float S[4] = {0.f, 0.f, 0.f, 0.f};
        const int hj = h * 64 + lane;
        const float w0 = a.in[I_EW0][hj], a0 = a.in[I_EA0][hj], k_k = a.in[I_EKK][hj], k_a = a.in[I_EKA][hj], r_k = a.in[I_ERK][hj];
        const int c4 = (lane & 15) * 4, rowl = wave * 4 + (lane >> 4);
        const int i1 = tid >> 4, sub = tid & 15;
        const int col0 = C_R + h * 64 + 4 * sub, col1 = C_K + h * 64 + 4 * sub, col2 = C_V + h * 64 + 4 * sub, col3 = C_WLO + 4 * sub, col4 = C_ALO + 4 * sub;
        const f32x4 mu0 = *(const f32x4*)(a.in[I_EMU] + col0), mu1 = *(const f32x4*)(a.in[I_EMU] + col1), mu2 = *(const f32x4*)(a.in[I_EMU] + col2), mu3 = *(const f32x4*)(a.in[I_EMU] + col3), mu4 = *(const f32x4*)(a.in[I_EMU] + col4);
        const bf16* prow = P + (size_t)(b * SEQ + i1) * EVEN_PAD;
        u32x2 c0v, c1v, c2v, c3v, c4v, p0v, p1v, p2v, p3v, p4v;
#define RW_PREFETCH(t0_) do { const bf16* pc_ = prow + (size_t)(t0_) * EVEN_PAD; \
            c0v = *(const u32x2*)(pc_ + col0); c1v = *(const u32x2*)(pc_ + col1); c2v = *(const u32x2*)(pc_ + col2); c3v = *(const u32x2*)(pc_ + col3); c4v = *(const u32x2*)(pc_ + col4); \
            if ((t0_) + i1 > 0) { const bf16* pp_ = pc_ - EVEN_PAD; p0v = *(const u32x2*)(pp_ + col0); p1v = *(const u32x2*)(pp_ + col1); p2v = *(const u32x2*)(pp_ + col2); p3v = *(const u32x2*)(pp_ + col3); p4v = *(const u32x2*)(pp_ + col4); } \
            else { p0v = (u32x2){0u, 0u}; p1v = p0v; p2v = p0v; p3v = p0v; p4v = p0v; } } while (0)
#define RW_XS(cv_, pv_, mu_) ({ f32x4 x_; const float a0_ = bflo(cv_.x), a1_ = bfhi(cv_.x), a2_ = bflo(cv_.y), a3_ = bfhi(cv_.y); \
            x_[0] = a0_ + mu_[0] * (bflo(pv_.x) - a0_); x_[1] = a1_ + mu_[1] * (bfhi(pv_.x) - a1_); x_[2] = a2_ + mu_[2] * (bflo(pv_.y) - a2_); x_[3] = a3_ + mu_[3] * (bfhi(pv_.y) - a3_); x_; })
        RW_PREFETCH(0);
        for (int ck = 0; ck < SEQ / 32; ++ck) {
            const int t0 = ck * 32;
            { *(LAS f32x4*)(Rr + i1 * 64 + 4 * sub) = RW_XS(c0v, p0v, mu0);
              *(LAS f32x4*)(KR + i1 * 64 + 4 * sub) = RW_XS(c1v, p1v, mu1);
              { const f32x4 xv = RW_XS(c2v, p2v, mu2); if ((sub >> 3) == half) *(LAS f32x4*)(Vv + i1 * 32 + 4 * (sub & 7)) = xv; }
              { f32x4 xs = RW_XS(c3v, p3v, mu3); xs[0] = fast_tanh(xs[0]); xs[1] = fast_tanh(xs[1]); xs[2] = fast_tanh(xs[2]); xs[3] = fast_tanh(xs[3]);
                unsigned h0, l0, h1, l1, h2, l2, h3, l3; split_bf(xs[0], h0, l0); split_bf(xs[1], h1, l1); split_bf(xs[2], h2, l2); split_bf(xs[3], h3, l3);
                u32x2 hv, lv; hv.x = h0 | (h1 << 16); hv.y = h2 | (h3 << 16); lv.x = l0 | (l1 << 16); lv.y = l2 | (l3 << 16);
                *(LAS u32x2*)(TWh + i1 * 72 + 4 * sub) = hv; *(LAS u32x2*)(TWl + i1 * 72 + 4 * sub) = lv; }
              { const f32x4 xs = RW_XS(c4v, p4v, mu4);
                unsigned h0, l0, h1, l1, h2, l2, h3, l3; split_bf(xs[0], h0, l0); split_bf(xs[1], h1, l1); split_bf(xs[2], h2, l2); split_bf(xs[3], h3, l3);
                u32x2 hv, lv; hv.x = h0 | (h1 << 16); hv.y = h2 | (h3 << 16); lv.x = l0 | (l1 << 16); lv.y = l2 | (l3 << 16);
                *(LAS u32x2*)(ALh + i1 * 72 + 4 * sub) = hv; *(LAS u32x2*)(ALl + i1 * 72 + 4 * sub) = lv; } }
            if (ck + 1 < SEQ / 32) RW_PREFETCH(t0 + 32);
            __syncthreads();
            { const int mi = wave >> 2, ni = wave & 3, fr = lane & 15, fq = lane >> 4;
              f32x4 accw = {0.f, 0.f, 0.f, 0.f}, acca = {0.f, 0.f, 0.f, 0.f};
#pragma unroll
              for (int ks = 0; ks < 2; ++ks) { const int ao = (16 * mi + fr) * 72 + 32 * ks + 8 * fq, bo = (16 * ni + fr) * 72 + 32 * ks + 8 * fq;
                  const bf16x8 ah = *(const LAS bf16x8*)(TWh + ao), al = *(const LAS bf16x8*)(TWl + ao), bh_ = *(const LAS bf16x8*)(WUh + bo), bl = *(const LAS bf16x8*)(WUl + bo);
                  accw = __builtin_amdgcn_mfma_f32_16x16x32_bf16(ah, bh_, accw, 0, 0, 0); accw = __builtin_amdgcn_mfma_f32_16x16x32_bf16(ah, bl, accw, 0, 0, 0); accw = __builtin_amdgcn_mfma_f32_16x16x32_bf16(al, bh_, accw, 0, 0, 0);
                  const bf16x8 ch = *(const LAS bf16x8*)(ALh + ao), cl = *(const LAS bf16x8*)(ALl + ao), dh = *(const LAS bf16x8*)(AUh + bo), dl = *(const LAS bf16x8*)(AUl + bo);
                  acca = __builtin_amdgcn_mfma_f32_16x16x32_bf16(ch, dh, acca, 0, 0, 0); acca = __builtin_amdgcn_mfma_f32_16x16x32_bf16(ch, dl, acca, 0, 0, 0); acca = __builtin_amdgcn_mfma_f32_16x16x32_bf16(cl, dh, acca, 0, 0, 0); }
#pragma unroll
              for (int rg = 0; rg < 4; ++rg) { Wd[(16 * mi + 4 * fq + rg) * 64 + 16 * ni + fr] = accw[rg]; Bb[(16 * mi + 4 * fq + rg) * 64 + 16 * ni + fr] = acca[rg]; } }
            __syncthreads();
#pragma unroll
            for (int q = 0; q < 4; ++q) { const int i = wave + 8 * q;
                const float nx = -(w0 + Wd[i * 64 + lane]); const float sp = fmaxf(nx, 0.f) + __logf(1.f + __expf(-fabsf(nx)));
                const float decay = __expf(-__expf(-sp - 0.5f));
                const float av = __builtin_amdgcn_rcpf(1.f + __expf(-(a0 + Bb[i * 64 + lane])));
                const float kraw = KR[i * 64 + lane]; const float kkv = kraw * k_k;
                const float ss = wave_sum_fast(kkv * kkv); const float kk = kkv * __builtin_amdgcn_rsqf(fmaxf(ss, 1e-24f));
                const float kp = kraw * (1.f + (av - 1.f) * k_a);
                const float bon = wave_sum_fast(Rr[i * 64 + lane] * kp * r_k);
                Wd[i * 64 + lane] = decay; KR[i * 64 + lane] = kp; KK[i * 64 + lane] = kk; Bb[i * 64 + lane] = kk * av;
                if (half == 0 && lane == 0) BONG[(size_t)(b * SEQ + t0 + i) * 8 + h] = bon; }
            __syncthreads();
            { f32x4 kk4 = *(const LAS f32x4*)(KK + c4), w4 = *(const LAS f32x4*)(Wd + c4), b4 = *(const LAS f32x4*)(Bb + c4), k4 = *(const LAS f32x4*)(KR + c4), r4 = *(const LAS f32x4*)(Rr + c4);
              float vv = Vv[rowl];
#pragma unroll 4
              for (int i = 0; i < 32; ++i) {
                const int in = (i + 1) & 31;
                const f32x4 nkk = *(const LAS f32x4*)(KK + in * 64 + c4), nw = *(const LAS f32x4*)(Wd + in * 64 + c4), nb = *(const LAS f32x4*)(Bb + in * 64 + c4), nk = *(const LAS f32x4*)(KR + in * 64 + c4), nr = *(const LAS f32x4*)(Rr + in * 64 + c4);
                const float nv = Vv[in * 32 + rowl];
                float sa = (S[0] * kk4[0] + S[1] * kk4[1]) + (S[2] * kk4[2] + S[3] * kk4[3]);
                const float p0 = S[0] * w4[0] + vv * k4[0], p1 = S[1] * w4[1] + vv * k4[1], p2 = S[2] * w4[2] + vv * k4[2], p3 = S[3] * w4[3] + vv * k4[3];
                sa = -row_sum16(sa);
                S[0] = sa * b4[0] + p0; S[1] = sa * b4[1] + p1; S[2] = sa * b4[2] + p2; S[3] = sa * b4[3] + p3;
                float y = (S[0] * r4[0] + S[1] * r4[1]) + (S[2] * r4[2] + S[3] * r4[3]);
                y = row_sum16(y);
                Yy[i * 32 + rowl] = y;
                kk4 = nkk; w4 = nw; b4 = nb; k4 = nk; r4 = nr; vv = nv;
              } }
            __syncthreads();
            for (int idx = tid; idx < 1024; idx += 512) { const int i = idx >> 5, rl = idx & 31; YRAW[(size_t)(b * SEQ + t0 + i) * 512 + h * 64 + half * 32 + rl] = Yy[idx]; }
        }
#undef RW_PREFETCH
#undef RW_XS
    }
}
__device__ __forceinline__ void phase_finish(const Args& a, int lane, int wave, int vcu, int G) {
    const bf16* P = (const bf16*)(a.ws + WS_P); bf16* MIX = (bf16*)(a.ws + WS_MIX); const float* YRAW = (const float*)(a.ws + WS_YRAW); const float* BONG = (const float*)(a.ws + WS_BON);
    const int gw = vcu * NWAVES + wave, NGW = G * NWAVES; const int c0 = 8 * lane;
    const f32x4 g0 = *(const f32x4*)(a.in[I_ELNXG] + c0), g1 = *(const f32x4*)(a.in[I_ELNXG] + c0 + 4), e0 = *(const f32x4*)(a.in[I_ELNXB] + c0), e1 = *(const f32x4*)(a.in[I_ELNXB] + c0 + 4);
    const f32x4 m0 = *(const f32x4*)(a.in[I_EMU] + C_V + c0), m1 = *(const f32x4*)(a.in[I_EMU] + C_V + c0 + 4);
    for (int row = gw; row < M; row += NGW) {
        const f32x4 y0 = *(const f32x4*)(YRAW + (size_t)row * 512 + c0), y1 = *(const f32x4*)(YRAW + (size_t)row * 512 + c0 + 4);
        float y[8] = {y0[0], y0[1], y0[2], y0[3], y1[0], y1[1], y1[2], y1[3]};
        float s = 0.f;
#pragma unroll
        for (int e = 0; e < 8; ++e) s += y[e];
        s += __shfl_xor(s, 1); s += __shfl_xor(s, 2); s += __shfl_xor(s, 4); const float mean = s * (1.f / 64.f); float q = 0.f;
#pragma unroll
        for (int e = 0; e < 8; ++e) { y[e] -= mean; q += y[e] * y[e]; }
        q += __shfl_xor(q, 1); q += __shfl_xor(q, 2); q += __shfl_xor(q, 4); const float rstd = 1.0f / sqrtf(q * (1.f / 64.f) + 64e-5f);
        const bf16* pc = P + (size_t)row * EVEN_PAD; const v4u cu = *(const v4u*)(pc + C_V + c0); v4u pu = {0u, 0u, 0u, 0u}; if ((row & (SEQ - 1)) != 0) pu = *(const v4u*)(pc - EVEN_PAD + C_V + c0);
        const v4u zu = *(const v4u*)(pc + C_Z0 + c0);
        const float cv[8] = {bflo(cu.x), bfhi(cu.x), bflo(cu.y), bfhi(cu.y), bflo(cu.z), bfhi(cu.z), bflo(cu.w), bfhi(cu.w)};
        const float pv[8] = {bflo(pu.x), bfhi(pu.x), bflo(pu.y), bfhi(pu.y), bflo(pu.z), bfhi(pu.z), bflo(pu.w), bfhi(pu.w)};
        const float zz[8] = {bflo(zu.x), bfhi(zu.x), bflo(zu.y), bfhi(zu.y), bflo(zu.z), bfhi(zu.z), bflo(zu.w), bfhi(zu.w)};
        const float mu[8] = {m0[0], m0[1], m0[2], m0[3], m1[0], m1[1], m1[2], m1[3]}, gg[8] = {g0[0], g0[1], g0[2], g0[3], g1[0], g1[1], g1[2], g1[3]}, ee[8] = {e0[0], e0[1], e0[2], e0[3], e1[0], e1[1], e1[2], e1[3]};
        const float bon = BONG[(size_t)row * 8 + (lane >> 3)];
        float o[8];
#pragma unroll
        for (int e = 0; e < 8; ++e) { const float v = cv[e] + mu[e] * (pv[e] - cv[e]); o[e] = (y[e] * rstd * gg[e] + ee[e] + bon * v) * siluf(zz[e]); }
        v4u w; w.x = pk2(o[0], o[1]); w.y = pk2(o[2], o[3]); w.z = pk2(o[4], o[5]); w.w = pk2(o[6], o[7]);
        *(v4u*)(MIX + (size_t)row * D + c0) = w;
    }
}
__device__ __forceinline__ void phase_gmlp(const Args& a, LAS unsigned char* lds, int tid, int lane, int wave, int vcu, int G) {
    const bf16* P = (const bf16*)(a.ws + WS_P); bf16* MIX = (bf16*)(a.ws + WS_MIX);
    LAS float* WS = (LAS float*)lds;
    LAS float* VLN = (LAS float*)(lds + 128 * 129 * 4);
    int gload = -1;
    for (int u = vcu; u < BATCH * 16 * 8; u += G) {
        const int b = u >> 7, ck = (u >> 3) & 15, g = u & 7;
        __syncthreads();
        if (g != gload) { for (int idx = tid; idx < 16384; idx += 512) WS[(idx >> 7) * 129 + (idx & 127)] = a.in[I_ESGW][(size_t)g * 16384 + idx]; gload = g; }
        const int i = tid >> 2, sub = tid & 3; const size_t rowg = (size_t)(b * SEQ + ck * 128 + i);
        { const v4u q0 = *(const v4u*)(P + rowg * EVEN_PAD + C_VG + g * 64 + sub * 16), q1 = *(const v4u*)(P + rowg * EVEN_PAD + C_VG + g * 64 + sub * 16 + 8);
          float v[16] = {bflo(q0.x), bfhi(q0.x), bflo(q0.y), bfhi(q0.y), bflo(q0.z), bfhi(q0.z), bflo(q0.w), bfhi(q0.w), bflo(q1.x), bfhi(q1.x), bflo(q1.y), bfhi(q1.y), bflo(q1.z), bfhi(q1.z), bflo(q1.w), bfhi(q1.w)};
          float s = 0.f;
#pragma unroll
          for (int e = 0; e < 16; ++e) s += v[e];
          s += __shfl_xor(s, 1); s += __shfl_xor(s, 2); const float mean = s * (1.f / 64.f); float q = 0.f;
#pragma unroll
          for (int e = 0; e < 16; ++e) { v[e] -= mean; q += v[e] * v[e]; }
          q += __shfl_xor(q, 1); q += __shfl_xor(q, 2); const float rstd = 1.0f / sqrtf(q * (1.f / 64.f) + 1e-5f);
#pragma unroll
          for (int e = 0; e < 16; ++e) VLN[i * 64 + sub * 16 + e] = v[e] * rstd * a.in[I_ESGLNG][g * 64 + sub * 16 + e] + a.in[I_ESGLNB][g * 64 + sub * 16 + e]; }
        __syncthreads();
        float acc[16];
#pragma unroll
        for (int e = 0; e < 16; ++e) acc[e] = 0.f;
        const int smax = wave * 16 + 16;
        for (int s = 0; s < smax; ++s) {
            const float w = (s <= i) ? WS[i * 129 + s] : 0.f;
            const f32x4 v0 = *(const LAS f32x4*)(VLN + s * 64 + sub * 16), v1 = *(const LAS f32x4*)(VLN + s * 64 + sub * 16 + 4), v2 = *(const LAS f32x4*)(VLN + s * 64 + sub * 16 + 8), v3 = *(const LAS f32x4*)(VLN + s * 64 + sub * 16 + 12);
#pragma unroll
            for (int e = 0; e < 4; ++e) { acc[e] += w * v0[e]; acc[4 + e] += w * v1[e]; acc[8 + e] += w * v2[e]; acc[12 + e] += w * v3[e]; }
        }
        const float bs = a.in[I_ESGB][g * 128 + i];
        const v4u u0 = *(const v4u*)(P + rowg * EVEN_PAD + C_U + g * 64 + sub * 16), u1 = *(const v4u*)(P + rowg * EVEN_PAD + C_U + g * 64 + sub * 16 + 8);
        const v4u z0 = *(const v4u*)(P + rowg * EVEN_PAD + C_Z0 + 512 + g * 64 + sub * 16), z1 = *(const v4u*)(P + rowg * EVEN_PAD + C_Z0 + 512 + g * 64 + sub * 16 + 8);
        const float uu[16] = {bflo(u0.x), bfhi(u0.x), bflo(u0.y), bfhi(u0.y), bflo(u0.z), bfhi(u0.z), bflo(u0.w), bfhi(u0.w), bflo(u1.x), bfhi(u1.x), bflo(u1.y), bfhi(u1.y), bflo(u1.z), bfhi(u1.z), bflo(u1.w), bfhi(u1.w)};
        const float zz[16] = {bflo(z0.x), bfhi(z0.x), bflo(z0.y), bfhi(z0.y), bflo(z0.z), bfhi(z0.z), bflo(z0.w), bfhi(z0.w), bflo(z1.x), bfhi(z1.x), bflo(z1.y), bfhi(z1.y), bflo(z1.z), bfhi(z1.z), bflo(z1.w), bfhi(z1.w)};
        float o[16];
#pragma unroll
        for (int e = 0; e < 16; ++e) o[e] = uu[e] * (acc[e] + bs) * siluf(zz[e]);
        v4u w0, w1; w0.x = pk2(o[0], o[1]); w0.y = pk2(o[2], o[3]); w0.z = pk2(o[4], o[5]); w0.w = pk2(o[6], o[7]); w1.x = pk2(o[8], o[9]); w1.y = pk2(o[10], o[11]); w1.z = pk2(o[12], o[13]); w1.w = pk2(o[14], o[15]);
        *(v4u*)(MIX + rowg * D + 512 + g * 64 + sub * 16) = w0; *(v4u*)(MIX + rowg * D + 512 + g * 64 + sub * 16 + 8) = w1;
    }
}

__device__ __forceinline__ void phase_swa(const Args& a, LAS unsigned char* lds, int tid, int lane, int wave, int vcu, int G) {
    const bf16* P = (const bf16*)(a.ws + WS_P); bf16* MIX = (bf16*)(a.ws + WS_MIX);
    LAS unsigned* KB = (LAS unsigned*)lds;
    LAS unsigned* VB = KB + 256 * 33;
    for (int u = vcu; u < BATCH * 16 * 2; u += G) {
        const int b = u >> 5, n = (u >> 1) & 15, kvh = u & 1;
        __syncthreads();
        { const int kr = tid >> 1, half = tid & 1; const int tk = n * 128 - 128 + kr;
          v4u kq[4], vq[4];
#pragma unroll
          for (int e = 0; e < 4; ++e) { kq[e] = (v4u){0u, 0u, 0u, 0u}; vq[e] = kq[e]; }
          if (tk >= 0) { const bf16* pr = P + (size_t)(b * SEQ + tk) * ODD_IN;
#pragma unroll
              for (int e = 0; e < 4; ++e) { kq[e] = *(const v4u*)(pr + C_KC + kvh * 64 + half * 32 + e * 8); vq[e] = *(const v4u*)(pr + C_VC + kvh * 64 + half * 32 + e * 8); } }
#pragma unroll
          for (int e = 0; e < 4; ++e) { LAS unsigned* kd = KB + kr * 33 + half * 16 + e * 4; kd[0] = kq[e].x; kd[1] = kq[e].y; kd[2] = kq[e].z; kd[3] = kq[e].w;
              LAS unsigned* vd = VB + kr * 33 + half * 16 + e * 4; vd[0] = vq[e].x; vd[1] = vq[e].y; vd[2] = vq[e].z; vd[3] = vq[e].w; } }
        __syncthreads();
        for (int pass = 0; pass < 2; ++pass) {
            const int gq = (tid >> 7) + 4 * pass, qi = tid & 127, h = kvh * 8 + gq; const size_t rowg = (size_t)(b * SEQ + n * 128 + qi);
            float q[64], o[64];
#pragma unroll
            for (int e = 0; e < 8; ++e) { const v4u w = *(const v4u*)(P + rowg * ODD_IN + C_Q + h * 64 + e * 8);
                q[8 * e + 0] = bflo(w.x) * 0.125f; q[8 * e + 1] = bfhi(w.x) * 0.125f; q[8 * e + 2] = bflo(w.y) * 0.125f; q[8 * e + 3] = bfhi(w.y) * 0.125f;
                q[8 * e + 4] = bflo(w.z) * 0.125f; q[8 * e + 5] = bfhi(w.z) * 0.125f; q[8 * e + 6] = bflo(w.w) * 0.125f; q[8 * e + 7] = bfhi(w.w) * 0.125f; }
#pragma unroll
            for (int e = 0; e < 64; ++e) o[e] = 0.f;
            const float slope = exp2f(-0.5f * (float)(h + 1));
            float mrun = a.in[I_OSINKS][h], lrun = 1.f;
            for (int j = 0; j < 128; ++j) {
                const int kr = qi + 1 + j; const bool valid = (n > 0) || (kr >= 128);
                const LAS unsigned* kp = KB + kr * 33;
                float s0 = 0.f, s1 = 0.f;
#pragma unroll
                for (int e = 0; e < 32; ++e) { const unsigned w = kp[e]; s0 += q[2 * e] * bflo(w); s1 += q[2 * e + 1] * bfhi(w); }
                const float s = (s0 + s1) - slope * (float)(127 - j);
                const float mn = valid ? fmaxf(mrun, s) : mrun;
                const float alpha = __expf(mrun - mn); const float p = valid ? __expf(s - mn) : 0.f;
                lrun = lrun * alpha + p; mrun = mn;
                const LAS unsigned* vp = VB + kr * 33;
#pragma unroll
                for (int e = 0; e < 32; ++e) { const unsigned w = vp[e]; o[2 * e] = o[2 * e] * alpha + p * bflo(w); o[2 * e + 1] = o[2 * e + 1] * alpha + p * bfhi(w); }
            }
            const float il = 1.f / lrun;
#pragma unroll
            for (int e = 0; e < 8; ++e) { const v4u zw = *(const v4u*)(P + rowg * ODD_IN + C_Z1 + h * 64 + e * 8);
                v4u w; w.x = pk2(o[8 * e + 0] * il * siluf(bflo(zw.x)), o[8 * e + 1] * il * siluf(bfhi(zw.x))); w.y = pk2(o[8 * e + 2] * il * siluf(bflo(zw.y)), o[8 * e + 3] * il * siluf(bfhi(zw.y)));
                w.z = pk2(o[8 * e + 4] * il * siluf(bflo(zw.z)), o[8 * e + 5] * il * siluf(bfhi(zw.z))); w.w = pk2(o[8 * e + 6] * il * siluf(bflo(zw.w)), o[8 * e + 7] * il * siluf(bfhi(zw.w)));
                *(v4u*)(MIX + rowg * D + h * 64 + e * 8) = w; }
        }
    }
}


typedef float f32x16 __attribute__((ext_vector_type(16)));
__device__ __forceinline__ int crow(int r, int hi) { return (r & 3) + 8 * (r >> 2) + 4 * hi; }
typedef float f32x2_t __attribute__((ext_vector_type(2))); typedef __bf16 bf16x2_t __attribute__((ext_vector_type(2)));
__device__ __forceinline__ unsigned cvtpk(float lo, float hi) { f32x2_t v = {lo, hi}; bf16x2_t b = __builtin_convertvector(v, bf16x2_t); return __builtin_bit_cast(unsigned, b); }
__device__ __forceinline__ void phase_swa2(const Args& a, LAS unsigned char* lds, int tid, int lane, int wave, int vcu, int G) {
    const bf16* P = (const bf16*)(a.ws + WS_P); bf16* MIX = (bf16*)(a.ws + WS_MIX);
    LAS bf16* Kl = (LAS bf16*)lds;
    LAS bf16* Vt = (LAS bf16*)(lds + 36864);
    const int l31 = lane & 31, hi = lane >> 5;
    for (int u = vcu; u < BATCH * 16 * 2; u += G) {
        const int b = u >> 5, n = (u >> 1) & 15, kvh = u & 1;
        __syncthreads();
        { const int key = tid >> 1, half = tid & 1; const int tk = n * 128 - 128 + key;
          v4u kq[4];
#pragma unroll
          for (int e = 0; e < 4; ++e) kq[e] = (v4u){0u, 0u, 0u, 0u};
          if (tk >= 0) { const bf16* pr = P + (size_t)(b * SEQ + tk) * ODD_IN + C_KC + kvh * 64 + half * 32;
#pragma unroll
              for (int e = 0; e < 4; ++e) kq[e] = *(const v4u*)(pr + e * 8); }
#pragma unroll
          for (int e = 0; e < 4; ++e) *(LAS v4u*)(Kl + key * 72 + half * 32 + e * 8) = kq[e]; }
        { const int key = tid & 255, dh = tid >> 8; const int tk = n * 128 - 128 + key;
          v4u vq[4];
#pragma unroll
          for (int e = 0; e < 4; ++e) vq[e] = (v4u){0u, 0u, 0u, 0u};
          if (tk >= 0) { const bf16* pr = P + (size_t)(b * SEQ + tk) * ODD_IN + C_VC + kvh * 64 + dh * 32;
#pragma unroll
              for (int e = 0; e < 4; ++e) vq[e] = *(const v4u*)(pr + e * 8); }
#pragma unroll
          for (int e = 0; e < 4; ++e) { LAS bf16* vd = Vt + (dh * 32 + e * 8) * 260 + key;
              vd[0 * 260] = (bf16)(vq[e].x & 0xffffu); vd[1 * 260] = (bf16)(vq[e].x >> 16); vd[2 * 260] = (bf16)(vq[e].y & 0xffffu); vd[3 * 260] = (bf16)(vq[e].y >> 16);
              vd[4 * 260] = (bf16)(vq[e].z & 0xffffu); vd[5 * 260] = (bf16)(vq[e].z >> 16); vd[6 * 260] = (bf16)(vq[e].w & 0xffffu); vd[7 * 260] = (bf16)(vq[e].w >> 16); } }
        __syncthreads();
        const int h = kvh * 8 + wave;
        const float slope = exp2f(-0.5f * (float)(h + 1)), sink = a.in[I_OSINKS][h];
#pragma unroll 1
        for (int i = 0; i < 4; ++i) {
            const size_t rowq = (size_t)(b * SEQ + n * 128 + 32 * i + l31);
            bf16x8 qf[4];
#pragma unroll
            for (int ks = 0; ks < 4; ++ks) qf[ks] = *(const bf16x8*)(P + rowq * ODD_IN + C_Q + h * 64 + 16 * ks + 8 * hi);
            f32x16 st[5];
#pragma unroll
            for (int tt = 0; tt < 5; ++tt) { f32x16 acc = {0.f, 0.f, 0.f, 0.f, 0.f, 0.f, 0.f, 0.f, 0.f, 0.f, 0.f, 0.f, 0.f, 0.f, 0.f, 0.f};
#pragma unroll
                for (int ks = 0; ks < 4; ++ks) { const bf16x8 kf = *(const LAS bf16x8*)(Kl + (32 * (i + tt) + l31) * 72 + 16 * ks + 8 * hi);
                    acc = __builtin_amdgcn_mfma_f32_32x32x16_bf16(kf, qf[ks], acc, 0, 0, 0); }
                st[tt] = acc; }
            int lbv = l31 - 4 * hi; float sbv = -slope * (float)(l31 + 128 - 4 * hi);
            asm volatile("" : "+v"(lbv), "+v"(sbv));
            float mx = sink;
#pragma unroll
            for (int tt = 0; tt < 5; ++tt) { const bool tile_ok = (n > 0) || (i + tt >= 4);
#pragma unroll
                for (int r = 0; r < 16; ++r) { const int cr = (r & 3) + 8 * (r >> 2);
                    float s = fmaf(st[tt][r], 0.125f, sbv); s = fmaf(slope, (float)(32 * tt + cr), s);
                    if (tt == 0) s = (cr > lbv) ? s : -INFINITY;
                    if (tt == 4) s = (cr <= lbv) ? s : -INFINITY;
                    s = tile_ok ? s : -INFINITY;
                    st[tt][r] = s; mx = fmaxf(mx, s); } }
            { auto rr = __builtin_amdgcn_permlane32_swap(__float_as_uint(mx), __float_as_uint(mx), false, false); mx = fmaxf(__uint_as_float(rr[0]), __uint_as_float(rr[1])); }
            float ls = 0.f;
#pragma unroll
            for (int tt = 0; tt < 5; ++tt)
#pragma unroll
                for (int r = 0; r < 16; ++r) { const float p = __expf(st[tt][r] - mx); st[tt][r] = p; ls += p; }
            { auto rr = __builtin_amdgcn_permlane32_swap(__float_as_uint(ls), __float_as_uint(ls), false, false); ls = __uint_as_float(rr[0]) + __uint_as_float(rr[1]); }
            const float inv = 1.f / (ls + __expf(sink - mx));
            f32x16 o[2];
#pragma unroll
            for (int dt = 0; dt < 2; ++dt) o[dt] = (f32x16){0.f, 0.f, 0.f, 0.f, 0.f, 0.f, 0.f, 0.f, 0.f, 0.f, 0.f, 0.f, 0.f, 0.f, 0.f, 0.f};
#pragma unroll
            for (int tt = 0; tt < 5; ++tt)
#pragma unroll
                for (int s2 = 0; s2 < 2; ++s2) {
                    v4u pw; pw.x = cvtpk(st[tt][8 * s2 + 0] * inv, st[tt][8 * s2 + 1] * inv); pw.y = cvtpk(st[tt][8 * s2 + 2] * inv, st[tt][8 * s2 + 3] * inv);
                    pw.z = cvtpk(st[tt][8 * s2 + 4] * inv, st[tt][8 * s2 + 5] * inv); pw.w = cvtpk(st[tt][8 * s2 + 6] * inv, st[tt][8 * s2 + 7] * inv);
                    const bf16x8 pa = __builtin_bit_cast(bf16x8, pw);
                    const int kb = 32 * (i + tt) + 16 * s2 + 4 * hi;
#pragma unroll
                    for (int dt = 0; dt < 2; ++dt) { const LAS bf16* vp = Vt + (dt * 32 + l31) * 260 + kb;
                        const u32x2 v0 = *(const LAS u32x2*)vp, v1 = *(const LAS u32x2*)(vp + 8);
                        v4u vw; vw.x = v0.x; vw.y = v0.y; vw.z = v1.x; vw.w = v1.y;
                        o[dt] = __builtin_amdgcn_mfma_f32_32x32x16_bf16(pa, __builtin_bit_cast(bf16x8, vw), o[dt], 0, 0, 0); } }
#pragma unroll
            for (int dt = 0; dt < 2; ++dt)
#pragma unroll
                for (int r = 0; r < 16; ++r) { const size_t row = (size_t)(b * SEQ + n * 128 + 32 * i + crow(r, hi)); const int d = h * 64 + dt * 32 + l31;
                    const float z = bf2f(P[row * ODD_IN + C_Z1 + d]);
                    MIX[row * D + d] = (bf16)f2bf(o[dt][r] * siluf(z)); if ((r & 3) == 3) asm volatile("" ::: "memory"); }
        }
    }
}

__device__ __forceinline__ void phase_gmlp2(const Args& a, LAS unsigned char* lds, int tid, int lane, int wave, int vcu, int G) {
    const bf16* P = (const bf16*)(a.ws + WS_P); bf16* MIX = (bf16*)(a.ws + WS_MIX);
    LAS bf16* Wl = (LAS bf16*)lds;
    LAS bf16* Vn = (LAS bf16*)(lds + 34816);
    LAS float* Ot = (LAS float*)(lds + 52224);
    const int l31 = lane & 31, hi = lane >> 5;
    const bool paired = (G == 256); const int n_units = paired ? ((vcu & 1) ? 16 : 0) : 8;
#define GM_UNIT(it_) ((!paired || (it_) < 8) ? vcu + G * (it_) : (vcu - 1) + 256 * ((it_) - 8))
    const int i = tid >> 2, sub = tid & 3;
    int gload = -1;
    v4u nv0, nv1, nu0, nu1, nz0, nz1;
#define GM_LOAD(u_) do { const int b_ = (u_) >> 7, ck_ = ((u_) >> 3) & 15, g_ = (u_) & 7; const bf16* pr_ = P + (size_t)(b_ * SEQ + ck_ * 128 + i) * EVEN_PAD + g_ * 64 + sub * 16; \
        nv0 = *(const v4u*)(pr_ + C_VG); nv1 = *(const v4u*)(pr_ + C_VG + 8); nu0 = *(const v4u*)(pr_ + C_U); nu1 = *(const v4u*)(pr_ + C_U + 8); nz0 = *(const v4u*)(pr_ + C_Z0 + 512); nz1 = *(const v4u*)(pr_ + C_Z0 + 512 + 8); } while (0)
    if (n_units > 0 && GM_UNIT(0) < BATCH * 16 * 8) GM_LOAD(GM_UNIT(0));
    for (int it = 0; it < n_units; ++it) {
        const int u = GM_UNIT(it);
        if (u >= BATCH * 16 * 8) break;
        const int b = u >> 7, ck = (u >> 3) & 15, g = u & 7;
        const v4u q0 = nv0, q1 = nv1, u0 = nu0, u1 = nu1, z0 = nz0, z1 = nz1;
        __syncthreads();
        if (g != gload) { for (int idx = tid; idx < 16384; idx += 512) { const int t = idx >> 7, s = idx & 127; const float w = a.in[I_ESGW][(size_t)g * 16384 + idx]; Wl[t * 136 + s] = (bf16)f2bf(s <= t ? w : 0.f); } gload = g; }
        { float v[16] = {bflo(q0.x), bfhi(q0.x), bflo(q0.y), bfhi(q0.y), bflo(q0.z), bfhi(q0.z), bflo(q0.w), bfhi(q0.w), bflo(q1.x), bfhi(q1.x), bflo(q1.y), bfhi(q1.y), bflo(q1.z), bfhi(q1.z), bflo(q1.w), bfhi(q1.w)};
          float s = 0.f;
#pragma unroll
          for (int e = 0; e < 16; ++e) s += v[e];
          DPP_ADD(s, 0xB1); DPP_ADD(s, 0x4E); const float mean = s * (1.f / 64.f); float q = 0.f;
#pragma unroll
          for (int e = 0; e < 16; ++e) { v[e] -= mean; q += v[e] * v[e]; }
          DPP_ADD(q, 0xB1); DPP_ADD(q, 0x4E); const float rstd = 1.0f / sqrtf(q * (1.f / 64.f) + 1e-5f);
#pragma unroll
          for (int e = 0; e < 16; ++e) Vn[(sub * 16 + e) * 136 + i] = (bf16)f2bf(v[e] * rstd * a.in[I_ESGLNG][g * 64 + sub * 16 + e] + a.in[I_ESGLNB][g * 64 + sub * 16 + e]); }
        if (it + 1 < n_units && GM_UNIT(it + 1) < BATCH * 16 * 8) GM_LOAD(GM_UNIT(it + 1));
        __syncthreads();
        { const int ti = wave >> 1, dt = wave & 1;
          f32x16 acc = {0.f, 0.f, 0.f, 0.f, 0.f, 0.f, 0.f, 0.f, 0.f, 0.f, 0.f, 0.f, 0.f, 0.f, 0.f, 0.f};
          const LAS bf16* ap = Wl + (32 * ti + l31) * 136 + 8 * hi; const LAS bf16* bp = Vn + (32 * dt + l31) * 136 + 8 * hi;
          for (int ks = 0; ks < 2 * ti + 2; ++ks) acc = __builtin_amdgcn_mfma_f32_32x32x16_bf16(*(const LAS bf16x8*)(ap + 16 * ks), *(const LAS bf16x8*)(bp + 16 * ks), acc, 0, 0, 0);
#pragma unroll
          for (int r = 0; r < 16; ++r) Ot[(32 * ti + crow(r, hi)) * 68 + 32 * dt + l31] = acc[r]; }
        __syncthreads();
        { const float bs = a.in[I_ESGB][g * 128 + i]; const size_t rowg = (size_t)(b * SEQ + ck * 128 + i);
          float mx[16];
#pragma unroll
          for (int e4 = 0; e4 < 4; ++e4) { const f32x4 x = *(const LAS f32x4*)(Ot + i * 68 + sub * 16 + 4 * e4); mx[4 * e4] = x[0]; mx[4 * e4 + 1] = x[1]; mx[4 * e4 + 2] = x[2]; mx[4 * e4 + 3] = x[3]; }
          const unsigned uw[8] = {u0.x, u0.y, u0.z, u0.w, u1.x, u1.y, u1.z, u1.w}, zw[8] = {z0.x, z0.y, z0.z, z0.w, z1.x, z1.y, z1.z, z1.w};
          unsigned ow[8];
#pragma unroll
          for (int e2 = 0; e2 < 8; ++e2) ow[e2] = cvtpk(bflo(uw[e2]) * (mx[2 * e2] + bs) * siluf(bflo(zw[e2])), bfhi(uw[e2]) * (mx[2 * e2 + 1] + bs) * siluf(bfhi(zw[e2])));
          bf16* mp = MIX + rowg * D + 512 + g * 64 + sub * 16;
          *(v4u*)mp = (v4u){ow[0], ow[1], ow[2], ow[3]}; *(v4u*)(mp + 8) = (v4u){ow[4], ow[5], ow[6], ow[7]}; }
    }
#undef GM_UNIT
#undef GM_LOAD
}
constexpr int RW_CHB = 13632;
constexpr int RW_O_AB = 0, RW_O_RB = 2304, RW_O_CH3 = 4608, RW_O_VT = 8704, RW_O_LAK = 11264, RW_O_GRK = 11776, RW_O_GRB = 12288, RW_O_TT = 12800, RW_O_GAM = 13312, RW_O_BON = 13568;
constexpr int RW_O_Y = 8 * RW_CHB, RW_YS = 68, RW_O_PAR = RW_O_Y + 128 * RW_YS * 4;
static_assert(RW_O_PAR + 12 * 64 * 4 <= LDSCTL_OFF, "rwkv LDS map");
__device__ __forceinline__ bf16x8 mkfrag(u32x2 lo, u32x2 hi) { v4u w; w.x = lo.x; w.y = lo.y; w.z = hi.x; w.w = hi.y; return __builtin_bit_cast(bf16x8, w); }
__device__ __forceinline__ u32x2 pack4(float a, float b, float c, float d) { u32x2 r; r.x = cvtpk(a, b); r.y = cvtpk(c, d); return r; }
#define DPP_SHR_ADD(x, n) x += __builtin_bit_cast(float, __builtin_amdgcn_update_dpp(0, __builtin_bit_cast(int, x), 0x110 + (n), 0xF, 0xF, true))
constexpr int RW_SLOT = 8 * RW_CHB;
constexpr int RW_NSLOT_A = 1230;
constexpr int CW_RWFLAG = 8192;
__device__ __forceinline__ void phase_rwkv3(const Args& a, LAS unsigned char* lds, int tid, int lane_, int wave, int unit, int role) {
    const bf16* P = (const bf16*)(a.ws + WS_P); bf16* MIX = (bf16*)(a.ws + WS_MIX);
    const bf16* WUT = (const bf16*)(a.ws + WS_WUT); const bf16* AUT = (const bf16*)(a.ws + WS_AUT);
    const int b = unit >> 3, h = unit & 7;
    const int c_ = lane_ & 15, g_ = lane_ >> 4;
    LAS float* PAR = (LAS float*)(lds + RW_O_PAR);
    LAS float* MUL = PAR + 7 * 64;
    LAS float* YB = (LAS float*)(lds + RW_O_Y);
    __syncthreads();
    if (tid < 448) { const int p = tid >> 6, j = tid & 63; const int src = (p == 0 ? I_EW0 : p == 1 ? I_EA0 : p == 2 ? I_EKK : p == 3 ? I_EKA : p == 4 ? I_ERK : p == 5 ? I_ELNXG : I_ELNXB); PAR[tid] = a.in[src][h * 64 + j]; }
    if (tid < 320) { const int p = tid >> 6, j = tid & 63; const int col = (p == 0 ? C_R + h * 64 : p == 1 ? C_K + h * 64 : p == 2 ? C_V + h * 64 : p == 3 ? C_WLO : C_ALO) + j; MUL[tid] = a.in[I_EMU][col]; }
    f32x4 S[4];
#pragma unroll
    for (int jt = 0; jt < 4; ++jt) S[jt] = (f32x4){0.f, 0.f, 0.f, 0.f};
    const u32x2 z2 = {0u, 0u};
    u32x2 rc[4], kc[4], vc[4]; v4u cw[2], ca[2];
#define RW_LOADS(bt_) do { int cq_ = c_, gq_ = g_; asm volatile("" : "+v"(cq_), "+v"(gq_)); const int tl_ = (bt_) * 128 + wave * 16 + cq_; \
        const bf16* q_ = P + (size_t)(b * SEQ + tl_) * EVEN_PAD + h * 64 + 4 * gq_; const bf16* w_ = P + (size_t)(b * SEQ + tl_) * EVEN_PAD + C_WLO + 8 * gq_; \
        _Pragma("unroll") for (int ni = 0; ni < 4; ++ni) { rc[ni] = *(const u32x2*)(q_ + C_R + 16 * ni); kc[ni] = *(const u32x2*)(q_ + C_K + 16 * ni); vc[ni] = *(const u32x2*)(q_ + C_V + 16 * ni); } \
        _Pragma("unroll") for (int ks = 0; ks < 2; ++ks) { cw[ks] = *(const v4u*)(w_ + 32 * ks); ca[ks] = *(const v4u*)(w_ + 64 + 32 * ks); } } while (0)
#define DPP_PREV(old_, cur_) ((unsigned)__builtin_amdgcn_update_dpp((int)(old_), (int)(cur_), 0x111, 0xF, 0xF, false))
    RW_LOADS(role);
    __syncthreads();
    gu32* flags = (gu32*)(a.ws + WS_CTL) + CW_RWFLAG + unit * 16;
    for (int bt = 0; bt < SEQ / 128; ++bt) {
        v4u zr0, zr1;
        const bool prim_batch = (bt & 1) == 0;
        if (role == 1 && prim_batch) continue;
        const bool mine = (role == 1) || prim_batch;
        unsigned char* slot = a.ws + WS_RING + (size_t)(unit * 8 + (bt >> 1)) * RW_SLOT;
        if (mine) {
        {   int c = c_, g = g_; asm volatile("" : "+v"(c), "+v"(g));
            LAS unsigned char* cb = lds + wave * RW_CHB;
            u32x2 rp[4], kp_[4], vp[4]; v4u pw[2], pa[2];
            { const int tl = bt * 128 + wave * 16 + c;
#pragma unroll
              for (int ni = 0; ni < 4; ++ni) { rp[ni] = z2; kp_[ni] = z2; vp[ni] = z2; }
              pw[0] = (v4u){0u, 0u, 0u, 0u}; pw[1] = pw[0]; pa[0] = pw[0]; pa[1] = pw[0];
              if (c == 0 && tl > 0) { const bf16* qp = P + (size_t)(b * SEQ + tl - 1) * EVEN_PAD + h * 64 + 4 * g; const bf16* wp = P + (size_t)(b * SEQ + tl - 1) * EVEN_PAD + C_WLO + 8 * g;
#pragma unroll
                  for (int ni = 0; ni < 4; ++ni) { rp[ni] = *(const u32x2*)(qp + C_R + 16 * ni); kp_[ni] = *(const u32x2*)(qp + C_K + 16 * ni); vp[ni] = *(const u32x2*)(qp + C_V + 16 * ni); }
#pragma unroll
                  for (int ks = 0; ks < 2; ++ks) { pw[ks] = *(const v4u*)(wp + 32 * ks); pa[ks] = *(const v4u*)(wp + 64 + 32 * ks); } }
#pragma unroll
              for (int ni = 0; ni < 4; ++ni) { rp[ni].x = DPP_PREV(rp[ni].x, rc[ni].x); rp[ni].y = DPP_PREV(rp[ni].y, rc[ni].y); kp_[ni].x = DPP_PREV(kp_[ni].x, kc[ni].x); kp_[ni].y = DPP_PREV(kp_[ni].y, kc[ni].y);
                  vp[ni].x = DPP_PREV(vp[ni].x, vc[ni].x); vp[ni].y = DPP_PREV(vp[ni].y, vc[ni].y); }
#pragma unroll
              for (int ks = 0; ks < 2; ++ks) { pw[ks].x = DPP_PREV(pw[ks].x, cw[ks].x); pw[ks].y = DPP_PREV(pw[ks].y, cw[ks].y); pw[ks].z = DPP_PREV(pw[ks].z, cw[ks].z); pw[ks].w = DPP_PREV(pw[ks].w, cw[ks].w);
                  pa[ks].x = DPP_PREV(pa[ks].x, ca[ks].x); pa[ks].y = DPP_PREV(pa[ks].y, ca[ks].y); pa[ks].z = DPP_PREV(pa[ks].z, ca[ks].z); pa[ks].w = DPP_PREV(pa[ks].w, ca[ks].w); } }
            bf16x8 wfr[4], afr[4];
#pragma unroll
            for (int ni = 0; ni < 4; ++ni) { const size_t wo = (size_t)(h * 64 + 16 * ni + c) * 64 + 8 * g; wfr[ni] = *(const bf16x8*)(WUT + wo); afr[ni] = *(const bf16x8*)(AUT + wo); }
            float kraw[16]; float ssq = 0.f;
#pragma unroll
            for (int ni = 0; ni < 4; ++ni) { const int jl = 16 * ni + 4 * g; const f32x4 mk = *(const LAS f32x4*)(MUL + 64 + jl); const f32x4 kkp = *(const LAS f32x4*)(PAR + 2 * 64 + jl);
                const float cf[4] = {bflo(kc[ni].x), bfhi(kc[ni].x), bflo(kc[ni].y), bfhi(kc[ni].y)}, pf[4] = {bflo(kp_[ni].x), bfhi(kp_[ni].x), bflo(kp_[ni].y), bfhi(kp_[ni].y)};
#pragma unroll
                for (int e = 0; e < 4; ++e) { const float k = cf[e] + mk[e] * (pf[e] - cf[e]); kraw[ni * 4 + e] = k; const float kv = k * kkp[e]; ssq += kv * kv; } }
            ssq += __shfl_xor(ssq, 16); ssq += __shfl_xor(ssq, 32);
            const float rs = __builtin_amdgcn_rsqf(fmaxf(ssq, 1e-24f));
            f32x4 accw[4], acca[4];
#pragma unroll
            for (int ni = 0; ni < 4; ++ni) { accw[ni] = (f32x4){0.f, 0.f, 0.f, 0.f}; acca[ni] = accw[ni]; }
#pragma unroll
            for (int ks = 0; ks < 2; ++ks) { const int mb = 32 * ks + 8 * g;
                const f32x4 mw0 = *(const LAS f32x4*)(MUL + 192 + mb), mw1 = *(const LAS f32x4*)(MUL + 192 + mb + 4), ma0 = *(const LAS f32x4*)(MUL + 256 + mb), ma1 = *(const LAS f32x4*)(MUL + 256 + mb + 4);
                const v4u cwv = cw[ks], cav = ca[ks], pwv = pw[ks], pav = pa[ks];
                const float cwf[8] = {bflo(cwv.x), bfhi(cwv.x), bflo(cwv.y), bfhi(cwv.y), bflo(cwv.z), bfhi(cwv.z), bflo(cwv.w), bfhi(cwv.w)}, pwf[8] = {bflo(pwv.x), bfhi(pwv.x), bflo(pwv.y), bfhi(pwv.y), bflo(pwv.z), bfhi(pwv.z), bflo(pwv.w), bfhi(pwv.w)};
                const float caf[8] = {bflo(cav.x), bfhi(cav.x), bflo(cav.y), bfhi(cav.y), bflo(cav.z), bfhi(cav.z), bflo(cav.w), bfhi(cav.w)}, paf[8] = {bflo(pav.x), bfhi(pav.x), bflo(pav.y), bfhi(pav.y), bflo(pav.z), bfhi(pav.z), bflo(pav.w), bfhi(pav.w)};
                const float mwf[8] = {mw0[0], mw0[1], mw0[2], mw0[3], mw1[0], mw1[1], mw1[2], mw1[3]}, maf[8] = {ma0[0], ma0[1], ma0[2], ma0[3], ma1[0], ma1[1], ma1[2], ma1[3]};
                float tw[8], al[8];
#pragma unroll
                for (int e = 0; e < 8; ++e) { tw[e] = fast_tanh(cwf[e] + mwf[e] * (pwf[e] - cwf[e])); al[e] = caf[e] + maf[e] * (paf[e] - caf[e]); }
                v4u bwv, bav; bwv.x = cvtpk(tw[0], tw[1]); bwv.y = cvtpk(tw[2], tw[3]); bwv.z = cvtpk(tw[4], tw[5]); bwv.w = cvtpk(tw[6], tw[7]);
                bav.x = cvtpk(al[0], al[1]); bav.y = cvtpk(al[2], al[3]); bav.z = cvtpk(al[4], al[5]); bav.w = cvtpk(al[6], al[7]);
                const bf16x8 bw = __builtin_bit_cast(bf16x8, bwv), ba = __builtin_bit_cast(bf16x8, bav);
#pragma unroll
                for (int ni = 0; ni < 4; ++ni) { accw[ni] = __builtin_amdgcn_mfma_f32_16x16x32_bf16(wfr[ni], bw, accw[ni], 0, 0, 0); acca[ni] = __builtin_amdgcn_mfma_f32_16x16x32_bf16(afr[ni], ba, acca[ni], 0, 0, 0); }
                if (ks == 0) {
#pragma unroll
                    for (int ni = 0; ni < 4; ++ni) { const size_t wo = (size_t)(h * 64 + 16 * ni + c) * 64 + 32 + 8 * g; wfr[ni] = *(const bf16x8*)(WUT + wo); afr[ni] = *(const bf16x8*)(AUT + wo); } } }
            { int lq = lane_; asm volatile("" : "+v"(lq)); const bf16* zp = P + (size_t)(b * SEQ + bt * 128 + wave * 16 + (lq >> 2)) * EVEN_PAD + C_Z0 + h * 64 + 16 * (lq & 3);
              zr0 = *(const v4u*)zp; zr1 = *(const v4u*)(zp + 8); }
            u32x2 fA[4], fR[4], fB[4], fK[4]; float bon = 0.f;
#pragma unroll
            for (int ni = 0; ni < 4; ++ni) { const int jl = 16 * ni + 4 * g;
                const f32x4 mr = *(const LAS f32x4*)(MUL + jl), mv = *(const LAS f32x4*)(MUL + 128 + jl);
                const f32x4 w0 = *(const LAS f32x4*)(PAR + jl), a0 = *(const LAS f32x4*)(PAR + 64 + jl), kkp = *(const LAS f32x4*)(PAR + 128 + jl), kap = *(const LAS f32x4*)(PAR + 192 + jl), rkp = *(const LAS f32x4*)(PAR + 256 + jl);
                const float rcf[4] = {bflo(rc[ni].x), bfhi(rc[ni].x), bflo(rc[ni].y), bfhi(rc[ni].y)}, rpf[4] = {bflo(rp[ni].x), bfhi(rp[ni].x), bflo(rp[ni].y), bfhi(rp[ni].y)};
                const float vcf[4] = {bflo(vc[ni].x), bfhi(vc[ni].x), bflo(vc[ni].y), bfhi(vc[ni].y)}, vpf[4] = {bflo(vp[ni].x), bfhi(vp[ni].x), bflo(vp[ni].y), bfhi(vp[ni].y)};
                float Av[4], Rv[4], Kv[4], Bv[4], Vq[4]; f32x4 gam;
#pragma unroll
                for (int e = 0; e < 4; ++e) {
                    const float r = rcf[e] + mr[e] * (rpf[e] - rcf[e]); const float vv = vcf[e] + mv[e] * (vpf[e] - vcf[e]);
                    Vq[e] = vv;
                    const float lw = -0.60653066f * __builtin_amdgcn_rcpf(1.f + __expf(-(w0[e] + accw[ni][e])));
                    const float av = __builtin_amdgcn_rcpf(1.f + __expf(-(a0[e] + acca[ni][e])));
                    const float k = kraw[ni * 4 + e]; const float kk = k * kkp[e] * rs; const float kp = k * (1.f + (av - 1.f) * kap[e]);
                    bon += r * kp * rkp[e];
                    float cum = lw; DPP_SHR_ADD(cum, 1); DPP_SHR_ADD(cum, 2); DPP_SHR_ADD(cum, 4); DPP_SHR_ADD(cum, 8);
                    const float eg = __expf(cum), ieg = __builtin_amdgcn_rcpf(eg);
                    const float egm = __builtin_bit_cast(float, __builtin_amdgcn_update_dpp(0x3f800000, __builtin_bit_cast(int, eg), 0x111, 0xF, 0xF, false));
                    Av[e] = -kk * egm; Rv[e] = r * eg; Kv[e] = kp * ieg; Bv[e] = kk * av * ieg; gam[e] = eg; }
                fA[ni] = pack4(Av[0], Av[1], Av[2], Av[3]); fR[ni] = pack4(Rv[0], Rv[1], Rv[2], Rv[3]); fK[ni] = pack4(Kv[0], Kv[1], Kv[2], Kv[3]); fB[ni] = pack4(Bv[0], Bv[1], Bv[2], Bv[3]);
                *(LAS u32x2*)(cb + RW_O_VT + (c * 64 + jl) * 2) = pack4(Vq[0], Vq[1], Vq[2], Vq[3]);
                if (c == 15) *(LAS f32x4*)(cb + RW_O_GAM + jl * 4) = gam;
                *(LAS u32x2*)(cb + RW_O_AB + (c * 72 + jl) * 2) = fA[ni]; *(LAS u32x2*)(cb + RW_O_RB + (c * 72 + jl) * 2) = fR[ni];
                LAS bf16* c3 = (LAS bf16*)(cb + RW_O_CH3) + ((ni * 16 + 4 * g) * 4 + (c >> 2)) * 8 + (c & 3);
                c3[0] = (bf16)(fB[ni].x & 0xffffu); c3[32] = (bf16)(fB[ni].x >> 16); c3[64] = (bf16)(fB[ni].y & 0xffffu); c3[96] = (bf16)(fB[ni].y >> 16);
                c3[4] = (bf16)(fK[ni].x & 0xffffu); c3[36] = (bf16)(fK[ni].x >> 16); c3[68] = (bf16)(fK[ni].y & 0xffffu); c3[100] = (bf16)(fK[ni].y >> 16); }
            bon += __shfl_xor(bon, 16); bon += __shfl_xor(bon, 32);
            if (g == 0) ((LAS float*)(cb + RW_O_BON))[c] = bon;
            f32x4 Lab = {0.f, 0.f, 0.f, 0.f}, Lak = Lab, Grk = Lab, Grb = Lab;
#pragma unroll
            for (int p = 0; p < 2; ++p) { const bf16x8 xa = mkfrag(fA[2 * p], fA[2 * p + 1]), xr = mkfrag(fR[2 * p], fR[2 * p + 1]), xb = mkfrag(fB[2 * p], fB[2 * p + 1]), xk = mkfrag(fK[2 * p], fK[2 * p + 1]);
                Lab = __builtin_amdgcn_mfma_f32_16x16x32_bf16(xa, xb, Lab, 0, 0, 0); Lak = __builtin_amdgcn_mfma_f32_16x16x32_bf16(xa, xk, Lak, 0, 0, 0);
                Grk = __builtin_amdgcn_mfma_f32_16x16x32_bf16(xr, xk, Grk, 0, 0, 0); Grb = __builtin_amdgcn_mfma_f32_16x16x32_bf16(xr, xb, Grb, 0, 0, 0); }
            LAS float* LT = YB + wave * 256;
            { f32x4 lt;
#pragma unroll
              for (int e = 0; e < 4; ++e) { const int tr = 4 * g + e; const bool st = c < tr, inc = c <= tr;
                  lt[e] = st ? Lab[e] : 0.f;
                  ((LAS bf16*)(cb + RW_O_LAK))[tr * 16 + c] = (bf16)f2bf(st ? Lak[e] : 0.f);
                  ((LAS bf16*)(cb + RW_O_GRK))[tr * 16 + c] = (bf16)f2bf(inc ? Grk[e] : 0.f);
                  ((LAS bf16*)(cb + RW_O_GRB))[tr * 16 + c] = (bf16)f2bf(inc ? Grb[e] : 0.f); }
              *(LAS f32x4*)(LT + c * 16 + 4 * g) = lt; }
            float Tr[16];
#pragma unroll
            for (int u = 0; u < 16; ++u) Tr[u] = (u == c) ? 1.f : 0.f;
#pragma unroll
            for (int u = 14; u >= 0; --u) { float lrow[16];
#pragma unroll
                for (int q = 0; q < 4; ++q) { const f32x4 x = *(const LAS f32x4*)(LT + u * 16 + 4 * q); lrow[4 * q] = x[0]; lrow[4 * q + 1] = x[1]; lrow[4 * q + 2] = x[2]; lrow[4 * q + 3] = x[3]; }
                float acc = 0.f;
#pragma unroll
                for (int s = u + 1; s < 16; ++s) acc += Tr[s] * lrow[s];
                Tr[u] = (u < c) ? acc : Tr[u]; }
            if (g == 0) { v4u t0v, t1v; t0v.x = cvtpk(Tr[0], Tr[1]); t0v.y = cvtpk(Tr[2], Tr[3]); t0v.z = cvtpk(Tr[4], Tr[5]); t0v.w = cvtpk(Tr[6], Tr[7]);
                t1v.x = cvtpk(Tr[8], Tr[9]); t1v.y = cvtpk(Tr[10], Tr[11]); t1v.z = cvtpk(Tr[12], Tr[13]); t1v.w = cvtpk(Tr[14], Tr[15]);
                *(LAS v4u*)(cb + RW_O_TT + c * 32) = t0v; *(LAS v4u*)(cb + RW_O_TT + c * 32 + 16) = t1v; }
        }
        } else {
            { int lq = lane_; asm volatile("" : "+v"(lq)); const bf16* zp = P + (size_t)(b * SEQ + bt * 128 + wave * 16 + (lq >> 2)) * EVEN_PAD + C_Z0 + h * 64 + 16 * (lq & 3);
              zr0 = *(const v4u*)zp; zr1 = *(const v4u*)(zp + 8); }
            if (tid == 0) { unsigned sp = 0; while (__hip_atomic_load(flags + bt, __ATOMIC_RELAXED, __HIP_MEMORY_SCOPE_AGENT) == 0u && ++sp < (1u << 24)) __builtin_amdgcn_s_sleep(2);
                __builtin_amdgcn_fence(__ATOMIC_ACQUIRE, "agent"); asm volatile("s_waitcnt vmcnt(0)" ::: "memory"); }
            __syncthreads();
            { const unsigned char* gsrc = slot; int tq = tid; asm volatile("" : "+v"(tq));
              v4u buf[7];
#pragma unroll
              for (int hh = 0; hh < 2; ++hh) {
#pragma unroll
                  for (int k = 0; k < 7; ++k) { const int i = tq + 512 * (7 * hh + k); if (i < RW_SLOT / 16) buf[k] = *(const v4u*)(gsrc + (size_t)i * 16); }
#pragma unroll
                  for (int k = 0; k < 7; ++k) { const int i = tq + 512 * (7 * hh + k); if (i < RW_SLOT / 16) *(LAS v4u*)(lds + i * 16) = buf[k]; } } }
        }
        __syncthreads();
        if (role == 1) {
            unsigned char* gdst = slot; int tq = tid; asm volatile("" : "+v"(tq));
            const __amdgpu_buffer_rsrc_t srs = __builtin_amdgcn_make_buffer_rsrc(gdst, 0, RW_SLOT, 0x00020000);
#pragma unroll
            for (int k = 0; k < 14; ++k) { const int i = tq + 512 * k; if (i < RW_SLOT / 16) __builtin_amdgcn_raw_buffer_store_b128(*(const LAS v4u*)(lds + i * 16), srs, (unsigned)(i * 16), 0,   16); }
            asm volatile("s_waitcnt vmcnt(0)" ::: "memory");
            if (bt + 2 < SEQ / 128) RW_LOADS(bt + 2);
            __syncthreads();
            if (tid == 0) __hip_atomic_store(flags + bt, 1u, __ATOMIC_RELAXED, __HIP_MEMORY_SCOPE_AGENT);
            continue;
        }
        if (mine && bt + 2 < SEQ / 128) RW_LOADS(bt + 2);
        if (wave < 4) {
            int c = c_, g = g_; asm volatile("" : "+v"(c), "+v"(g));
#pragma unroll 1
            for (int ch = 0; ch < 8; ++ch) { LAS unsigned char* cb = lds + ch * RW_CHB;
                u32x2 vfr; { const LAS bf16* vp_ = (const LAS bf16*)(cb + RW_O_VT) + (4 * g) * 64 + 16 * wave + c; vfr.x = (unsigned)vp_[0] | ((unsigned)vp_[64] << 16); vfr.y = (unsigned)vp_[128] | ((unsigned)vp_[192] << 16); }
                u32x2 sb[4];
#pragma unroll
                for (int jt = 0; jt < 4; ++jt) sb[jt] = pack4(S[jt][0], S[jt][1], S[jt][2], S[jt][3]);
                f32x4 acc1 = {0.f, 0.f, 0.f, 0.f}, accY = acc1;
#pragma unroll
                for (int jt = 0; jt < 4; ++jt) { const u32x2 a1 = *(const LAS u32x2*)(cb + RW_O_AB + (c * 72 + 16 * jt + 4 * g) * 2), aY = *(const LAS u32x2*)(cb + RW_O_RB + (c * 72 + 16 * jt + 4 * g) * 2);
                    u32x2 a1x = z2, aYx = z2, bx = z2;
                    if (jt == 0) { a1x = *(const LAS u32x2*)(cb + RW_O_LAK + (c * 16 + 4 * g) * 2); aYx = *(const LAS u32x2*)(cb + RW_O_GRK + (c * 16 + 4 * g) * 2); bx = vfr; }
                    const bf16x8 bf = mkfrag(sb[jt], bx);
                    acc1 = __builtin_amdgcn_mfma_f32_16x16x32_bf16(mkfrag(a1, a1x), bf, acc1, 0, 0, 0);
                    accY = __builtin_amdgcn_mfma_f32_16x16x32_bf16(mkfrag(aY, aYx), bf, accY, 0, 0, 0); }
                const u32x2 rb = pack4(acc1[0], acc1[1], acc1[2], acc1[3]);
                f32x4 accU = {0.f, 0.f, 0.f, 0.f};
                accU = __builtin_amdgcn_mfma_f32_16x16x32_bf16(mkfrag(*(const LAS u32x2*)(cb + RW_O_TT + (c * 16 + 4 * g) * 2), z2), mkfrag(rb, z2), accU, 0, 0, 0);
                const u32x2 ub = pack4(accU[0], accU[1], accU[2], accU[3]);
                accY = __builtin_amdgcn_mfma_f32_16x16x32_bf16(mkfrag(*(const LAS u32x2*)(cb + RW_O_GRB + (c * 16 + 4 * g) * 2), z2), mkfrag(ub, z2), accY, 0, 0, 0);
#pragma unroll
                for (int e = 0; e < 4; ++e) YB[(ch * 16 + 4 * g + e) * RW_YS + 16 * wave + c] = accY[e];
                const bf16x8 b3 = mkfrag(ub, vfr);
#pragma unroll
                for (int jt = 0; jt < 4; ++jt) { const bf16x8 a3 = *(const LAS bf16x8*)(cb + RW_O_CH3 + (((jt * 16 + c) * 4 + g) * 8) * 2);
                    S[jt] = __builtin_amdgcn_mfma_f32_16x16x32_bf16(a3, b3, S[jt], 0, 0, 0);
                    S[jt] = S[jt] * *(const LAS f32x4*)(cb + RW_O_GAM + (16 * jt + 4 * g) * 4); }
            }
        }
        __syncthreads();

        {   int lane = lane_; asm volatile("" : "+v"(lane));
            LAS unsigned char* cb = lds + wave * RW_CHB; const int tt = lane >> 2, q16 = 16 * (lane & 3);
            float y[16];
#pragma unroll
            for (int e4 = 0; e4 < 4; ++e4) { const f32x4 x = *(const LAS f32x4*)(YB + (wave * 16 + tt) * RW_YS + q16 + 4 * e4); y[4 * e4] = x[0]; y[4 * e4 + 1] = x[1]; y[4 * e4 + 2] = x[2]; y[4 * e4 + 3] = x[3]; }
            float s = 0.f;
#pragma unroll
            for (int e = 0; e < 16; ++e) s += y[e];
            DPP_ADD(s, 0xB1); DPP_ADD(s, 0x4E); const float mean = s * (1.f / 64.f); float qq = 0.f;
#pragma unroll
            for (int e = 0; e < 16; ++e) { y[e] -= mean; qq += y[e] * y[e]; }
            DPP_ADD(qq, 0xB1); DPP_ADD(qq, 0x4E); const float rstd = __builtin_amdgcn_rsqf(qq * (1.f / 64.f) + 64e-5f);
            const float bonv = ((const LAS float*)(cb + RW_O_BON))[tt];
            const v4u vq0 = *(const LAS v4u*)(cb + RW_O_VT + (tt * 64 + q16) * 2), vq1 = *(const LAS v4u*)(cb + RW_O_VT + (tt * 64 + q16 + 8) * 2);
            const unsigned vw[8] = {vq0.x, vq0.y, vq0.z, vq0.w, vq1.x, vq1.y, vq1.z, vq1.w}, zw[8] = {zr0.x, zr0.y, zr0.z, zr0.w, zr1.x, zr1.y, zr1.z, zr1.w};
            unsigned ow[8];
#pragma unroll
            for (int e2 = 0; e2 < 8; ++e2) { const f32x2_t lg = *(const LAS f32x2_t*)(PAR + 5 * 64 + q16 + 2 * e2), lb = *(const LAS f32x2_t*)(PAR + 6 * 64 + q16 + 2 * e2);
                const float o0 = (y[2 * e2] * rstd * lg[0] + lb[0] + bonv * bflo(vw[e2])) * siluf(bflo(zw[e2])), o1 = (y[2 * e2 + 1] * rstd * lg[1] + lb[1] + bonv * bfhi(vw[e2])) * siluf(bfhi(zw[e2]));
                ow[e2] = cvtpk(o0, o1); }
            bf16* mp = MIX + (size_t)(b * SEQ + bt * 128 + wave * 16 + tt) * D + h * 64 + q16;
            *(v4u*)mp = (v4u){ow[0], ow[1], ow[2], ow[3]}; *(v4u*)(mp + 8) = (v4u){ow[4], ow[5], ow[6], ow[7]};
        }
        __syncthreads();
    }
#undef RW_LOADS
#undef DPP_PREV
}
__global__ void __launch_bounds__(NWAVES * 64, 2) mk_fwd(Args args) {
    extern __shared__ __attribute__((aligned(16))) unsigned char lds_raw[];
    LAS unsigned char* lds = (LAS unsigned char*)lds_raw;
    volatile LAS unsigned* MISC = (volatile LAS unsigned*)(lds + MISC_OFF);
    const int tid = threadIdx.x, lane = tid & 63, wave = __builtin_amdgcn_readfirstlane(tid >> 6);
    const int G = gridDim.x; const int bx = blockIdx.x; const int vcu = (G % 8 == 0) ? (bx % 8) * (G / 8) + bx / 8 : bx;
    unsigned char* ws = args.ws;
    gu32* ctl = (gu32*)(ws + WS_CTL);
    for (int u = tid; u < (LDS_BYTES - LDSCTL_OFF) / 4; u += NWAVES * 64) ((LAS unsigned*)(lds + LDSCTL_OFF))[u] = 0u;
    __syncthreads();
    XcdBarrier bar = xcd_barrier_post((unsigned*)(ctl + CW_BAR), MISC + 8);
    const int lo = args.ph_lo, hi = args.ph_hi;
#define IN(k) (lo <= (k) && (k) < hi)
#define GRID_BAR() xcd_barrier(bar)
    float* mod = (float*)(ws + WS_MOD);
    bf16* XN = (bf16*)(ws + WS_XN); bf16* MIX = (bf16*)(ws + WS_MIX); bf16* P = (bf16*)(ws + WS_P);

    if (IN(0)) { phase0(args, lds, tid, lane, wave, vcu, G); GRID_BAR(); }
    if (IN(1)) { phase_adaln_rows(args.in[I_X], args.in[I_NORMG], mod, XN, lane, wave, vcu, G); GRID_BAR(); }
    if (IN(2)) {
        pg8::Gemm g{XN, (const bf16*)(ws + WS_WIN0), M, EVEN_PAD, D}; pg8::StaticOrder S; S.init(M, EVEN_PAD, G, (int)blockIdx.x);
        pg8::EpiBf16 E{P, EVEN_PAD};
        pg8::gemm_phase<pg8::EpiBf16, pg8::StaticOrder, PG8_ALIGN, PG8_SP2>(lds, g, S, E);
        if (G == 256) { if (blockIdx.x >= 128) phase_bias3(args, lds, tid, lane, wave, (int)blockIdx.x - 128, 128); }
        else phase_bias3(args, lds, tid, lane, wave, vcu, G);
        GRID_BAR();
    }
    if (IN(3)) { if (G == 256) phase_rwkv3(args, lds, tid, lane, wave, vcu >> 1, vcu & 1); phase_gmlp2(args, lds, tid, lane, wave, vcu, G); GRID_BAR(); }
    if (IN(4)) {
        pg8::Gemm g{MIX, (const bf16*)(ws + WS_WOUT0), M, D, D}; pg8::StaticOrder S; S.init(M, D, G, (int)blockIdx.x);
        pg8::EpiResGateNext E{args.in[I_X], args.out, mod + 2048, args.in[I_NORMG] + D, mod + 16 * 3072 + 1024, XN, (float*)(ws + WS_ROWSS)};
        pg8::gemm_phase<pg8::EpiResGateNext, pg8::StaticOrder, PG8_ALIGN, PG8_SP2>(lds, g, S, E);
        GRID_BAR();
    }
    if (IN(6)) {
        pg8::Gemm g{XN, (const bf16*)(ws + WS_WIN1), M, ODD_IN, D}; pg8::StaticOrder S; S.init(M, ODD_IN, G, (int)blockIdx.x);
        pg8::EpiBf16RowScale E{P, ODD_IN, (const float*)(ws + WS_ROWSS), (const float*)(ws + WS_BIAS3)};
        pg8::gemm_phase<pg8::EpiBf16RowScale, pg8::StaticOrder, PG8_ALIGN, PG8_SP2>(lds, g, S, E);
        GRID_BAR();
    }
    if (IN(7)) { phase_swa2(args, lds, tid, lane, wave, vcu, G); GRID_BAR(); }
    if (IN(8)) {
        pg8::Gemm g{MIX, (const bf16*)(ws + WS_WOUT1), M, D, D}; pg8::StaticOrder S; S.init(M, D, G, (int)blockIdx.x);
        pg8::EpiResGate E{args.out, args.out, mod + 16 * 3072 + 2048};
        pg8::gemm_phase<pg8::EpiResGate, pg8::StaticOrder, PG8_ALIGN, PG8_SP2>(lds, g, S, E);
        GRID_BAR();
    }
    if (IN(9)) { phase_final_rows(args.out, args.in[I_FINALG], lane, wave, vcu, G); }
#undef IN
#undef GRID_BAR
}

extern "C" void kernel_launch(void* const* d_in, const int* in_sizes, int n_in, void* d_out, int out_size, void* d_ws, size_t ws_size, hipStream_t stream) {
    static int grid = 0;
    if (grid == 0) {
        if (n_in != N_IN || in_sizes[0] != M * D || out_size != M * D || ws_size < WS_END) { fprintf(stderr, "kernel_launch: unexpected shapes (n_in %d, in0 %d, out %d, ws %zu); nothing launched\n", n_in, n_in > 0 ? in_sizes[0] : -1, out_size, ws_size); grid = -1; return; }
        int dev = 0, cus = 0, per_cu = 0;
        if (hipGetDevice(&dev) != hipSuccess || hipDeviceGetAttribute(&cus, hipDeviceAttributeMultiprocessorCount, dev) != hipSuccess) { grid = -1; return; }
        if (hipFuncSetAttribute((const void*)mk_fwd, hipFuncAttributeMaxDynamicSharedMemorySize, LDS_BYTES) != hipSuccess) { fprintf(stderr, "kernel_launch: hipFuncSetAttribute failed\n"); grid = -1; return; }
        if (hipOccupancyMaxActiveBlocksPerMultiprocessor(&per_cu, (const void*)mk_fwd, NWAVES * 64, LDS_BYTES) != hipSuccess || per_cu < 1) fprintf(stderr, "kernel_launch: note: occupancy query reports %d\n", per_cu);
        (void)hipGetLastError();
        grid = cus;
    }
    if (grid < 0) return;
    if (hipMemsetAsync((char*)d_ws + WS_CTL, 0, CTL_ZERO_BYTES, stream) != hipSuccess) { fprintf(stderr, "kernel_launch: memset failed\n"); return; }
    Args a{};
    for (int i = 0; i < N_IN; ++i) a.in[i] = (const float*)d_in[i];
    a.out = (float*)d_out; a.ws = (unsigned char*)d_ws; a.ph_lo = 0; a.ph_hi = 10;
    hipLaunchKernelGGL(mk_fwd, dim3(grid), dim3(NWAVES * 64), LDS_BYTES, stream, a);
}
```
